# Optimizing an MI355X kernel written in HIP

```python
import math
import jax, jax.numpy as jnp
from jax import lax
import numpy as np

D_MODEL = 2048
BATCH = 2
SEQ = 16384
DEPTH = 1

MEM_LEN = 256
D_ATTN = D_MODEL // 2
D_POOL = D_MODEL - D_ATTN
DIFF_HEAD_DIM = 128
N_DIFF_HEADS = D_ATTN // (2 * DIFF_HEAD_DIM)
D_IN = 3 * D_ATTN + D_POOL
POOL_WINDOWS = (2, 4, 8, 16)
N_POOL_GROUPS = len(POOL_WINDOWS)
POOL_GROUP_DIM = D_POOL // N_POOL_GROUPS
N_XATTN_HEADS = 4
XATTN_HEAD_DIM = D_MODEL // N_XATTN_HEADS
D_FF = -(-8 * D_MODEL // (3 * 256)) * 256
Q_BLOCK = 128
EPS = 1e-6
NEG_INF = -1e30

kernel_name = "hymba_diffattn_pool_hybrid"


def _lambda_init(layer_idx):
    return 0.8 - 0.6 * math.exp(-0.3 * layer_idx)


def _rmsnorm(x, g):
    x32 = x.astype(jnp.float32)
    y = x32 * lax.rsqrt(jnp.mean(x32 * x32, axis=-1, keepdims=True) + EPS)
    return (y * g.astype(jnp.float32)).astype(x.dtype)


def _diff_attention(q, k, v, lam):
    B, S, H, _, d = q.shape
    nb = S // Q_BLOCK
    qh = q.transpose(0, 2, 3, 1, 4)
    kh = k.transpose(0, 2, 3, 1, 4)
    vh = v.transpose(0, 2, 1, 3)
    qb = qh.reshape(B, H, 2, nb, Q_BLOCK, d).transpose(3, 0, 1, 2, 4, 5)
    kpos = jnp.arange(S)
    scale = d ** -0.5

    def block(args):
        i, qi = args
        qpos = i * Q_BLOCK + jnp.arange(Q_BLOCK)
        s = jnp.einsum('bhmqd,bhmkd->bhmqk', qi, kh).astype(jnp.float32) * scale
        s = jnp.where(kpos[None, :] <= qpos[:, None], s, NEG_INF)
        p = jax.nn.softmax(s, axis=-1)
        wgt = p[:, :, 0] - lam * p[:, :, 1]
        return jnp.einsum('bhqk,bhkd->bhqd', wgt.astype(vh.dtype), vh)

    o = lax.map(block, (jnp.arange(nb), qb))
    return o.transpose(1, 0, 3, 2, 4).reshape(B, S, H, 2 * d)


def _multiscale_pool(u, w, scale):
    B, S, C = u.shape
    u32 = u.astype(jnp.float32)
    cs = jnp.concatenate([jnp.zeros((B, 1, C), jnp.float32), jnp.cumsum(u32, axis=1)], axis=1)
    csg = cs.reshape(B, S + 1, N_POOL_GROUPS, POOL_GROUP_DIM)
    ug = u32.reshape(B, S, N_POOL_GROUPS, POOL_GROUP_DIM)
    t = jnp.arange(S)
    outs = []
    for g, wl in enumerate(POOL_WINDOWS):
        upper = csg[:, 1:, g]
        lower = jnp.concatenate([jnp.zeros((B, wl - 1, POOL_GROUP_DIM), jnp.float32),
                                 csg[:, :S - wl + 1, g]], axis=1)
        cnt = jnp.minimum(t + 1, wl).astype(jnp.float32)[None, :, None]
        outs.append((upper - lower) / cnt - ug[:, :, g])
    pooled = jnp.stack(outs, axis=2).astype(u.dtype)
    mixed = jnp.einsum('bsgc,gcd->bsgd', pooled, w)
    return mixed.reshape(B, S, C) * scale


def _cross_attention(h, m, wq, wkv, wo):
    B, S, _ = h.shape
    M = m.shape[1]
    q = (h @ wq).reshape(B, S, N_XATTN_HEADS, XATTN_HEAD_DIM)
    kv = (m @ wkv).reshape(B, M, 2, N_XATTN_HEADS, XATTN_HEAD_DIM)
    k, v = kv[:, :, 0], kv[:, :, 1]
    s = jnp.einsum('bshd,bmhd->bhsm', q, k).astype(jnp.float32) * (XATTN_HEAD_DIM ** -0.5)
    p = jax.nn.softmax(s, axis=-1).astype(v.dtype)
    o = jnp.einsum('bhsm,bmhd->bshd', p, v).reshape(B, S, D_MODEL)
    return o @ wo


def _swiglu(h, w_gate, w_up, w_down):
    return (jax.nn.silu(h @ w_gate) * (h @ w_up)) @ w_down


def setup_inputs(seed: int = 0) -> dict:
    key = jax.random.key(seed)
    ks = jax.random.split(key, 24)

    def nrm(k, shape, s):
        return jax.random.normal(k, shape, jnp.float32) * s

    def gain(k, shape):
        return 1.0 + 0.02 * jax.random.normal(k, shape, jnp.float32)

    return {
        "x": nrm(ks[0], (BATCH, SEQ, D_MODEL), 1.0),
        "mem": nrm(ks[1], (BATCH, MEM_LEN, D_MODEL), 1.0),
        "norm_mix": gain(ks[2], (DEPTH, D_MODEL)),
        "w_in": nrm(ks[3], (DEPTH, D_MODEL, D_IN), D_MODEL ** -0.5),
        "lambda_q1": nrm(ks[4], (DEPTH, DIFF_HEAD_DIM), 0.1),
        "lambda_k1": nrm(ks[5], (DEPTH, DIFF_HEAD_DIM), 0.1),
        "lambda_q2": nrm(ks[6], (DEPTH, DIFF_HEAD_DIM), 0.1),
        "lambda_k2": nrm(ks[7], (DEPTH, DIFF_HEAD_DIM), 0.1),
        "subln": gain(ks[8], (DEPTH, 2 * DIFF_HEAD_DIM)),
        "pool_w": nrm(ks[9], (DEPTH, N_POOL_GROUPS, POOL_GROUP_DIM, POOL_GROUP_DIM), POOL_GROUP_DIM ** -0.5),
        "pool_scale": gain(ks[10], (DEPTH, D_POOL)),
        "w_o": nrm(ks[11], (DEPTH, D_MODEL, D_MODEL), D_MODEL ** -0.5),
        "norm_xattn": gain(ks[12], (DEPTH, D_MODEL)),
        "norm_mem": gain(ks[13], (DEPTH, D_MODEL)),
        "wq_x": nrm(ks[14], (DEPTH, D_MODEL, D_MODEL), D_MODEL ** -0.5),
        "wkv_x": nrm(ks[15], (DEPTH, D_MODEL, 2 * D_MODEL), D_MODEL ** -0.5),
        "wo_x": nrm(ks[16], (DEPTH, D_MODEL, D_MODEL), D_MODEL ** -0.5),
        "norm_ffn": gain(ks[17], (DEPTH, D_MODEL)),
        "w_gate": nrm(ks[18], (DEPTH, D_MODEL, D_FF), D_MODEL ** -0.5),
        "w_up": nrm(ks[19], (DEPTH, D_MODEL, D_FF), D_MODEL ** -0.5),
        "w_down": nrm(ks[20], (DEPTH, D_FF, D_MODEL), D_FF ** -0.5),
        "norm_final": gain(ks[21], (D_MODEL,)),
    }


def reference(x, mem, norm_mix, w_in, lambda_q1, lambda_k1, lambda_q2, lambda_k2,
              subln, pool_w, pool_scale, w_o, norm_xattn, norm_mem, wq_x, wkv_x,
              wo_x, norm_ffn, w_gate, w_up, w_down, norm_final):
    B, S, _ = x.shape
    for l in range(DEPTH):
        lam_init = _lambda_init(l)
        h = _rmsnorm(x, norm_mix[l])
        proj = h @ w_in[l]
        q = proj[..., :D_ATTN].reshape(B, S, N_DIFF_HEADS, 2, DIFF_HEAD_DIM)
        k = proj[..., D_ATTN:2 * D_ATTN].reshape(B, S, N_DIFF_HEADS, 2, DIFF_HEAD_DIM)
        v = proj[..., 2 * D_ATTN:3 * D_ATTN].reshape(B, S, N_DIFF_HEADS, 2 * DIFF_HEAD_DIM)
        u = proj[..., 3 * D_ATTN:]
        lam = (jnp.exp(jnp.sum(lambda_q1[l].astype(jnp.float32) * lambda_k1[l].astype(jnp.float32)))
               - jnp.exp(jnp.sum(lambda_q2[l].astype(jnp.float32) * lambda_k2[l].astype(jnp.float32)))
               + lam_init)
        o_attn = _diff_attention(q, k, v, lam)
        o_attn = (_rmsnorm(o_attn, subln[l]) * (1.0 - lam_init)).reshape(B, S, D_ATTN)
        o_pool = _multiscale_pool(u, pool_w[l], pool_scale[l])
        x = x + jnp.concatenate([o_attn, o_pool], axis=-1) @ w_o[l]
        hx = _rmsnorm(x, norm_xattn[l])
        m = _rmsnorm(mem, norm_mem[l])
        x = x + _cross_attention(hx, m, wq_x[l], wkv_x[l], wo_x[l])
        hf = _rmsnorm(x, norm_ffn[l])
        x = x + _swiglu(hf, w_gate[l], w_up[l], w_down[l])
    return _rmsnorm(x, norm_final)
```

```cpp
#include <hip/hip_runtime.h>
#include <hip/hip_bf16.h>
#include <hip/hip_cooperative_groups.h>
#include <cstdio>
#include <cstdint>
namespace cg = cooperative_groups;

#ifndef PROBE_DUP
#define PROBE_DUP -1
#endif
#ifndef PROBE_SEAMS
#define PROBE_SEAMS 0
#endif
#ifndef MK_PER_PHASE
#define MK_PER_PHASE 0
#endif

constexpr int BATCH = 2, SEQ = 16384, DM = 2048, MEM = 256, DIN = 4096, DFF = 5632;
constexpr int M = BATCH * SEQ;
constexpr float EPS = 1e-6f;
constexpr float LAM_INIT = 0.2f;

namespace pg8 {
#define PG8_LAS __attribute__((address_space(3)))
typedef unsigned short bf16_t;
typedef short bf16x8 __attribute__((ext_vector_type(8)));
typedef float f32x4 __attribute__((ext_vector_type(4)));
typedef unsigned u32x4 __attribute__((ext_vector_type(4)));
constexpr int BM = 256, BK = 64, HALF = 128, HTB = HALF * BK * 2, STAGE_BYTES = 8 * HTB, NXCD = 8, WGM = 8;

__host__ __device__ __forceinline__ int lds_byte(int r, int c) { const int st = (r >> 4) * 2 + (c >> 5), rr = r & 15, cc = c & 31, ob = rr * 64 + cc * 2; return st * 1024 + (ob ^ (((ob >> 9) & 1) << 5)); }
__host__ __device__ __forceinline__ void stage_rc(int b, int& R, int& C) { const int st = b / 1024, sb = b % 1024, swz = sb ^ (((sb >> 9) & 1) << 5); R = (st >> 1) * 16 + swz / 64; C = (st & 1) * 32 + (swz % 64) / 2; }
__host__ __device__ __forceinline__ int perm32(int rho) { const int n = rho >> 4, i = rho & 15; return 8 * (i >> 2) + 4 * n + (i & 3); }

struct Unit { int pm, pn, z; };
struct Gemm { const bf16_t* A; const bf16_t* Bt; int lda, ldb, K, ZH; long sAb, sAh, sBb, sBh; };

struct StaticOrder {
    int nM, nN, nwg, G, c;
    __device__ void init(int Mr, int N, int G_, int c_) { nM = Mr / BM; nN = N / BM; nwg = nM * nN; G = G_; c = c_; }
    __device__ bool next(int i, Unit& u) const {
        const long L = (long)i * G + c; if (L >= nwg) return false;
        int wgid = (int)L; { const int q = nwg / NXCD, r = nwg % NXCD, xcd = wgid % NXCD, off = wgid / NXCD; wgid = (xcd < r ? xcd * (q + 1) : r * (q + 1) + (xcd - r) * q) + off; }
        const int nig = WGM * nN, gid = wgid / nig, fm = gid * WGM, gsz = (nM - fm) < WGM ? (nM - fm) : WGM;
        u.pm = fm + ((wgid % nig) % gsz); u.pn = (wgid % nig) / gsz; u.z = 0; return true;
    }
};
struct BatchOrder {
    int nM, nN, nwg, G, c;
    __device__ void init(int Mr, int N, int Z, int G_, int c_) { nM = Mr / BM; nN = N / BM; nwg = nM * nN * Z; G = G_; c = c_; }
    __device__ bool next(int i, Unit& u) const {
        const long L = (long)i * G + c; if (L >= nwg) return false;
        int l = (int)L; u.pn = l % nN; l /= nN; u.pm = l % nM; u.z = l / nM; return true;
    }
};

__device__ __forceinline__ unsigned cvt_pk_bf16(float lo, float hi) { unsigned r; asm volatile("v_cvt_pk_bf16_f32 %0, %1, %2" : "=v"(r) : "v"(lo), "v"(hi)); return r; }

typedef f32x4 Acc[2][2][4][2];

struct EpiBf16 {
    static constexpr bool PERM = true;
    bf16_t* O; int ldc, ZH; long sOb, sOh; const float* cscale; int nsc;
    __device__ __forceinline__ void operator()(Acc& acc, const Unit& u, int wr, int wc, int fr, int fq, PG8_LAS unsigned char*) const {
        const int row0 = u.pm * BM + wr * 64 + fr, col0 = u.pn * BM + wc * 32 + 8 * fq;
        bf16_t* base = O + (size_t)(u.z / ZH) * sOb + (size_t)(u.z % ZH) * sOh;
        f32x4 sv[2][2];
#pragma unroll
        for (int bj = 0; bj < 2; ++bj)
#pragma unroll
            for (int n = 0; n < 2; ++n) sv[bj][n] = cscale ? *(const f32x4*)(cscale + (size_t)u.z * nsc + col0 + bj * HALF + 4 * n) : (f32x4){1.f, 1.f, 1.f, 1.f};
#pragma unroll
        for (int ai = 0; ai < 2; ++ai)
#pragma unroll
            for (int m = 0; m < 4; ++m) { bf16_t* rowp = base + (size_t)(row0 + ai * HALF + m * 16) * ldc + col0;
#pragma unroll
                for (int bj = 0; bj < 2; ++bj) { f32x4 v0 = acc[ai][bj][m][0] * sv[bj][0], v1 = acc[ai][bj][m][1] * sv[bj][1];
                    u32x4 w; w.x = cvt_pk_bf16(v0[0], v0[1]); w.y = cvt_pk_bf16(v0[2], v0[3]); w.z = cvt_pk_bf16(v1[0], v1[1]); w.w = cvt_pk_bf16(v1[2], v1[3]);
                    *(u32x4*)(rowp + bj * HALF) = w; } }
    }
};
template <bool BASE_BF16, bool OUT_BF16> struct EpiResX {
    static constexpr bool PERM = true;
    const void* base; void* out; int ldc;
    __device__ __forceinline__ void operator()(Acc& acc, const Unit& u, int wr, int wc, int fr, int fq, PG8_LAS unsigned char*) const {
        const int col0 = u.pn * BM + wc * 32 + 8 * fq;
#pragma unroll
        for (int ai = 0; ai < 2; ++ai)
#pragma unroll
            for (int m = 0; m < 4; ++m) { const int r = ai * HALF + wr * 64 + m * 16 + fr; const size_t off = (size_t)(u.pm * BM + r) * ldc + col0;
                f32x4 bs[2][2];
#pragma unroll
                for (int bj = 0; bj < 2; ++bj) {
                    if constexpr (BASE_BF16) { const u32x4 w = *(const u32x4*)((const bf16_t*)base + off + bj * HALF);
                        bs[bj][0] = (f32x4){__builtin_bit_cast(float, w.x << 16), __builtin_bit_cast(float, w.x & 0xffff0000u), __builtin_bit_cast(float, w.y << 16), __builtin_bit_cast(float, w.y & 0xffff0000u)};
                        bs[bj][1] = (f32x4){__builtin_bit_cast(float, w.z << 16), __builtin_bit_cast(float, w.z & 0xffff0000u), __builtin_bit_cast(float, w.w << 16), __builtin_bit_cast(float, w.w & 0xffff0000u)}; }
                    else { bs[bj][0] = *(const f32x4*)((const float*)base + off + bj * HALF); bs[bj][1] = *(const f32x4*)((const float*)base + off + bj * HALF + 4); } }
#pragma unroll
                for (int bj = 0; bj < 2; ++bj) { const f32x4 v0 = bs[bj][0] + acc[ai][bj][m][0], v1 = bs[bj][1] + acc[ai][bj][m][1];
                    if constexpr (OUT_BF16) { u32x4 w; w.x = cvt_pk_bf16(v0[0], v0[1]); w.y = cvt_pk_bf16(v0[2], v0[3]); w.z = cvt_pk_bf16(v1[0], v1[1]); w.w = cvt_pk_bf16(v1[2], v1[3]);
                        *(u32x4*)((bf16_t*)out + off + bj * HALF) = w; }
                    else { *(f32x4*)((float*)out + off + bj * HALF) = v0; *(f32x4*)((float*)out + off + bj * HALF + 4) = v1; } }
                asm volatile("" ::: "memory"); }
    }
};
struct EpiProj {
    static constexpr bool PERM = true;
    bf16_t* QKVH; bf16_t* U;
    __device__ __forceinline__ void operator()(Acc& acc, const Unit& u, int wr, int wc, int fr, int fq, PG8_LAS unsigned char*) const {
        const int row0 = u.pm * BM + wr * 64 + fr, b = (u.pm * BM) / SEQ, s0 = row0 - b * SEQ, cin = wc * 32 + 8 * fq;
#pragma unroll
        for (int ai = 0; ai < 2; ++ai)
#pragma unroll
            for (int m = 0; m < 4; ++m) {
#pragma unroll
                for (int bj = 0; bj < 2; ++bj) { const f32x4 v0 = acc[ai][bj][m][0], v1 = acc[ai][bj][m][1];
                    u32x4 w; w.x = cvt_pk_bf16(v0[0], v0[1]); w.y = cvt_pk_bf16(v0[2], v0[3]); w.z = cvt_pk_bf16(v1[0], v1[1]); w.w = cvt_pk_bf16(v1[2], v1[3]);
                    bf16_t* dst = (u.pn < 12) ? QKVH + ((size_t)(b * 24 + u.pn * 2 + bj) * SEQ + (s0 + ai * HALF + m * 16)) * 128 + cin
                                              : U + (size_t)(row0 + ai * HALF + m * 16) * 1024 + (u.pn - 12) * 256 + bj * HALF + cin;
                    *(u32x4*)dst = w; } }
    }
};
struct EpiResF32 {
    static constexpr bool PERM = false;
    const float* base; float* out; int ldc;
    __device__ __forceinline__ void operator()(Acc& acc, const Unit& u, int wr, int wc, int fr, int fq, PG8_LAS unsigned char*) const {
        const int col0 = u.pn * BM + wc * 32 + 4 * fq;
#pragma unroll
        for (int ai = 0; ai < 2; ++ai)
#pragma unroll
            for (int m = 0; m < 4; ++m) { const int r = ai * HALF + wr * 64 + m * 16 + fr; const size_t off = (size_t)(u.pm * BM + r) * ldc + col0;
                f32x4 bs[2][2];
#pragma unroll
                for (int bj = 0; bj < 2; ++bj)
#pragma unroll
                    for (int n = 0; n < 2; ++n) bs[bj][n] = *(const f32x4*)(base + off + bj * HALF + n * 16);
#pragma unroll
                for (int bj = 0; bj < 2; ++bj)
#pragma unroll
                    for (int n = 0; n < 2; ++n) *(f32x4*)(out + off + bj * HALF + n * 16) = bs[bj][n] + acc[ai][bj][m][n];
                asm volatile("" ::: "memory"); }
    }
};
struct EpiSwiGLU {
    static constexpr bool PERM = true;
    bf16_t* O; int ldc;
    __device__ __forceinline__ void operator()(Acc& acc, const Unit& u, int wr, int wc, int fr, int fq, PG8_LAS unsigned char*) const {
        const int row0 = u.pm * BM + wr * 64 + fr, col0 = u.pn * HALF + wc * 32 + 8 * fq;
#pragma unroll
        for (int ai = 0; ai < 2; ++ai)
#pragma unroll
            for (int m = 0; m < 4; ++m) { bf16_t* rowp = O + (size_t)(row0 + ai * HALF + m * 16) * ldc + col0;
                float h[8];
#pragma unroll
                for (int n = 0; n < 2; ++n)
#pragma unroll
                    for (int e = 0; e < 4; ++e) { const float gt = acc[ai][0][m][n][e], up = acc[ai][1][m][n][e];
                        const float sg = __builtin_amdgcn_rcpf(1.f + __builtin_amdgcn_exp2f(-1.4426950408889634f * gt));
                        h[n * 4 + e] = gt * sg * up; }
                u32x4 w; w.x = cvt_pk_bf16(h[0], h[1]); w.y = cvt_pk_bf16(h[2], h[3]); w.z = cvt_pk_bf16(h[4], h[5]); w.w = cvt_pk_bf16(h[6], h[7]);
                *(u32x4*)rowp = w; }
    }
};
struct EpiSoftmax {
    static constexpr bool PERM = true;
    bf16_t* O; long sOz; float sc2;
    __device__ __forceinline__ void operator()(Acc& acc, const Unit& u, int wr, int wc, int fr, int fq, PG8_LAS unsigned char* xl) const {
        PG8_LAS float* MX = (PG8_LAS float*)xl;
        PG8_LAS float* SMv = (PG8_LAS float*)(xl + 4096);
#pragma unroll
        for (int ai = 0; ai < 2; ++ai)
#pragma unroll
            for (int m = 0; m < 4; ++m) { float mx = -3.0e38f;
#pragma unroll
                for (int bj = 0; bj < 2; ++bj)
#pragma unroll
                    for (int n = 0; n < 2; ++n) { f32x4 s = acc[ai][bj][m][n] * sc2; acc[ai][bj][m][n] = s; mx = fmaxf(mx, fmaxf(fmaxf(s[0], s[1]), fmaxf(s[2], s[3]))); }
                mx = fmaxf(mx, __shfl_xor(mx, 16)); mx = fmaxf(mx, __shfl_xor(mx, 32));
                if (fq == 0) MX[(ai * HALF + wr * 64 + m * 16 + fr) * 4 + wc] = mx; }
        asm volatile("s_waitcnt lgkmcnt(0)" ::: "memory"); __builtin_amdgcn_s_barrier(); asm volatile("" ::: "memory");
#pragma unroll
        for (int ai = 0; ai < 2; ++ai)
#pragma unroll
            for (int m = 0; m < 4; ++m) { const int r = ai * HALF + wr * 64 + m * 16 + fr;
                const f32x4 q = *(const PG8_LAS f32x4*)(MX + r * 4); const float rm = fmaxf(fmaxf(q[0], q[1]), fmaxf(q[2], q[3]));
                float sm = 0.f;
#pragma unroll
                for (int bj = 0; bj < 2; ++bj)
#pragma unroll
                    for (int n = 0; n < 2; ++n) { f32x4 s = acc[ai][bj][m][n];
#pragma unroll
                        for (int e = 0; e < 4; ++e) { s[e] = __builtin_amdgcn_exp2f(s[e] - rm); sm += s[e]; }
                        acc[ai][bj][m][n] = s; }
                sm += __shfl_xor(sm, 16); sm += __shfl_xor(sm, 32);
                if (fq == 0) SMv[r * 4 + wc] = sm; }
        asm volatile("s_waitcnt lgkmcnt(0)" ::: "memory"); __builtin_amdgcn_s_barrier(); asm volatile("" ::: "memory");
        const int row0 = u.pm * BM + wr * 64 + fr, col0 = wc * 32 + 8 * fq;
        bf16_t* base = O + (size_t)u.z * sOz;
#pragma unroll
        for (int ai = 0; ai < 2; ++ai)
#pragma unroll
            for (int m = 0; m < 4; ++m) { const int r = ai * HALF + wr * 64 + m * 16 + fr;
                const f32x4 q = *(const PG8_LAS f32x4*)(SMv + r * 4); const float inv = 1.0f / ((q[0] + q[1]) + (q[2] + q[3]));
                bf16_t* rowp = base + (size_t)(row0 + ai * HALF + m * 16) * 256 + col0;
#pragma unroll
                for (int bj = 0; bj < 2; ++bj) { const f32x4 v0 = acc[ai][bj][m][0] * inv, v1 = acc[ai][bj][m][1] * inv;
                    u32x4 w; w.x = cvt_pk_bf16(v0[0], v0[1]); w.y = cvt_pk_bf16(v0[2], v0[3]); w.z = cvt_pk_bf16(v1[0], v1[1]); w.w = cvt_pk_bf16(v1[2], v1[3]);
                    *(u32x4*)(rowp + bj * HALF) = w; } }
    }
};

template <class Epi, class Sched, bool ALIGN_EPI>
__device__ __forceinline__ void gemm_phase(PG8_LAS unsigned char* lds, PG8_LAS unsigned char* xl, const Gemm g, const Sched& S, const Epi& E) {
    const int tid = threadIdx.x, wid = __builtin_amdgcn_readfirstlane(tid >> 6), lane = tid & 63, wr = wid >> 2, wc = wid & 3, fr = lane & 15, fq = lane >> 4;
    const int K = g.K, nt = K / BK;
    unsigned voffA[2], voffB[2];
#pragma unroll
    for (int i = 0; i < 2; ++i) { int R, C; stage_rc(tid * 16 + i * 8192, R, C); const int Rb = Epi::PERM ? ((R & ~31) + perm32(R & 31)) : R;
        voffA[i] = (unsigned)(R * g.lda + C) * 2u; voffB[i] = (unsigned)(Rb * g.ldb + C) * 2u; }
    const size_t kstep = (size_t)(BK * 2);
    const size_t hstepA = (size_t)HALF * g.lda * 2, hstepB = (size_t)HALF * g.ldb * 2;
    const unsigned ldsw = (unsigned)wid * 1024u;
    const int aoff = lds_byte(wr * 64 + fr, fq * 8), boff = lds_byte(wc * 32 + fr, fq * 8);
#define PG8_APTR(u_) ((const char*)g.A + 2 * ((size_t)((u_).z / g.ZH) * g.sAb + (size_t)((u_).z % g.ZH) * g.sAh) + (size_t)(u_).pm * 2 * hstepA)
#define PG8_BPTR(u_) ((const char*)g.Bt + 2 * ((size_t)((u_).z / g.ZH) * g.sBb + (size_t)((u_).z % g.ZH) * g.sBh) + (size_t)(u_).pn * 2 * hstepB)
#define PG8_SA(b, h) (((b) * 2 + (h)) * HTB)
#define PG8_SB(b, h) ((4 + (b) * 2 + (h)) * HTB)
#define PG8_STAGE(bufoff, gbase, voff) do { _Pragma("unroll") for (int _i = 0; _i < 2; ++_i) \
        __builtin_amdgcn_global_load_lds((const unsigned*)((const char*)(gbase) + (voff)[_i]), (PG8_LAS unsigned*)(lds + (bufoff) + ldsw + _i * 8192), 16, 0, 0); } while (0)
#define PG8_LDA(dst, b, h) do { _Pragma("unroll") for (int m = 0; m < 4; ++m) _Pragma("unroll") for (int k = 0; k < 2; ++k) dst[m][k] = *(const PG8_LAS bf16x8*)(lds + PG8_SA(b, h) + aoff + m * 2048 + k * 1024); } while (0)
#define PG8_LDB(dst, b, h) do { _Pragma("unroll") for (int n = 0; n < 2; ++n) _Pragma("unroll") for (int k = 0; k < 2; ++k) dst[n][k] = *(const PG8_LAS bf16x8*)(lds + PG8_SB(b, h) + boff + n * 2048 + k * 1024); } while (0)
#define PG8_MMA(ai, bj, At, Bt) do { __builtin_amdgcn_s_setprio(1); _Pragma("unroll") for (int m = 0; m < 4; ++m) _Pragma("unroll") for (int n = 0; n < 2; ++n) _Pragma("unroll") for (int k = 0; k < 2; ++k) \
        acc[ai][bj][m][n] = __builtin_amdgcn_mfma_f32_16x16x32_bf16(Bt[n][k], At[m][k], acc[ai][bj][m][n], 0, 0, 0); __builtin_amdgcn_s_setprio(0); } while (0)
#define PG8_WAIT_V(n) asm volatile("s_waitcnt vmcnt(" #n ")" ::: "memory")
#define PG8_WAIT_L(n) asm volatile("s_waitcnt lgkmcnt(" #n ")" ::: "memory")
#define PG8_BAR __builtin_amdgcn_s_barrier()
#define PG8_SCHED __builtin_amdgcn_sched_barrier(0)
    Unit cur, nxt; int ui = 0;
    if (!S.next(0, cur)) return;
    Acc acc;
#pragma unroll
    for (int a = 0; a < 2; ++a)
#pragma unroll
        for (int b = 0; b < 2; ++b)
#pragma unroll
            for (int m = 0; m < 4; ++m)
#pragma unroll
                for (int n = 0; n < 2; ++n) acc[a][b][m][n] = (f32x4){0.f, 0.f, 0.f, 0.f};
    bf16x8 At[4][2], B0[2][2], B1[2][2];
    const char* cA = PG8_APTR(cur); const char* cB = PG8_BPTR(cur);
    PG8_STAGE(PG8_SB(0, 0), cB, voffB); PG8_STAGE(PG8_SB(0, 1), cB + hstepB, voffB); PG8_STAGE(PG8_SA(0, 0), cA, voffA); PG8_STAGE(PG8_SA(0, 1), cA + hstepA, voffA);
    if (wr == 1) PG8_BAR;
    PG8_WAIT_V(2); PG8_BAR;
    PG8_STAGE(PG8_SB(1, 0), cB + kstep, voffB); PG8_STAGE(PG8_SA(1, 0), cA + kstep, voffA); PG8_STAGE(PG8_SB(1, 1), cB + hstepB + kstep, voffB);
    PG8_WAIT_V(6); PG8_BAR;
    for (;;) {
        const bool has_next = S.next(ui + 1, nxt);
        const char* nA = has_next ? PG8_APTR(nxt) : cA; const char* nB = has_next ? PG8_BPTR(nxt) : cB;
        for (int t = 0; t < nt; t += 2) {
            const bool last = (t == nt - 2);
            const char* a1 = cA + (size_t)(t + 1) * kstep;
            const char* a2 = last ? nA : cA + (size_t)(t + 2) * kstep; const char* b2 = last ? nB : cB + (size_t)(t + 2) * kstep;
            const char* a3 = a2 + kstep; const char* b3 = b2 + kstep;
            PG8_LDB(B0, 0, 0); PG8_LDB(B1, 0, 1); PG8_SCHED; PG8_LDA(At, 0, 0); PG8_STAGE(PG8_SA(1, 1), a1 + hstepA, voffA);
            PG8_WAIT_V(8); PG8_WAIT_L(0); PG8_BAR; PG8_MMA(0, 0, At, B0); PG8_MMA(0, 1, At, B1); PG8_BAR; PG8_SCHED;
            PG8_LDA(At, 0, 1); PG8_STAGE(PG8_SB(0, 0), b2, voffB); PG8_STAGE(PG8_SB(0, 1), b2 + hstepB, voffB); PG8_STAGE(PG8_SA(0, 0), a2, voffA);
            PG8_WAIT_V(8); PG8_WAIT_L(0); PG8_BAR; PG8_MMA(1, 0, At, B0); PG8_MMA(1, 1, At, B1); PG8_BAR; PG8_SCHED;
            PG8_LDB(B0, 1, 0); PG8_LDB(B1, 1, 1); PG8_SCHED; PG8_LDA(At, 1, 0); PG8_STAGE(PG8_SA(0, 1), a2 + hstepA, voffA);
            PG8_WAIT_V(8); PG8_WAIT_L(0); PG8_BAR; PG8_MMA(0, 0, At, B0); PG8_MMA(0, 1, At, B1); PG8_BAR; PG8_SCHED;
            PG8_LDA(At, 1, 1); PG8_STAGE(PG8_SB(1, 0), b3, voffB); PG8_STAGE(PG8_SB(1, 1), b3 + hstepB, voffB); PG8_STAGE(PG8_SA(1, 0), a3, voffA);
            PG8_WAIT_V(8); PG8_WAIT_L(0); PG8_BAR; PG8_MMA(1, 0, At, B0); PG8_MMA(1, 1, At, B1); PG8_BAR; PG8_SCHED;
        }
        if constexpr (ALIGN_EPI) { if (wr == 0) PG8_BAR; }
        E(acc, cur, wr, wc, fr, fq, xl);
        if (!has_next) break;
#pragma unroll
        for (int a = 0; a < 2; ++a)
#pragma unroll
            for (int b = 0; b < 2; ++b)
#pragma unroll
                for (int m = 0; m < 4; ++m)
#pragma unroll
                    for (int n = 0; n < 2; ++n) acc[a][b][m][n] = (f32x4){0.f, 0.f, 0.f, 0.f};
        cur = nxt; cA = nA; cB = nB; ++ui;
        if constexpr (ALIGN_EPI) { if (wr == 1) PG8_BAR; }
    }
    PG8_WAIT_V(0);
    if constexpr (!ALIGN_EPI) { if (wr == 0) PG8_BAR; }
    PG8_BAR;
#undef PG8_APTR
#undef PG8_BPTR
#undef PG8_SA
#undef PG8_SB
#undef PG8_STAGE
#undef PG8_LDA
#undef PG8_LDB
#undef PG8_MMA
#undef PG8_WAIT_V
#undef PG8_WAIT_L
#undef PG8_BAR
#undef PG8_SCHED
}
}

namespace att {
constexpr int D = 128;
constexpr int PIN = DIN;
constexpr int POUT = 2048;
constexpr float SCALE = 0.08838834764831845f;
constexpr float THR = 8.f;
constexpr int NW = 8, QBLK = 32, KVBLK = 64, QB = NW * QBLK;
constexpr int SHM_V = KVBLK * D * 2, SHM_K = KVBLK * D * 2;
constexpr int LDS_BYTES = 2 * SHM_V + 2 * SHM_K + NW * 64 * 4;
using bf16 = __hip_bfloat16;
typedef short bf16x8 __attribute__((ext_vector_type(8)));
typedef short s16x4 __attribute__((ext_vector_type(4)));
typedef float f32x16 __attribute__((ext_vector_type(16)));
typedef float f32x4 __attribute__((ext_vector_type(4)));
typedef unsigned u32x4 __attribute__((ext_vector_type(4)));

#define KSWZ(row, colB) ((row) * 256 + ((colB) ^ (((row) & 7) << 4)))
#define SBAR() __builtin_amdgcn_sched_barrier(0)
__device__ __forceinline__ int v_st(int k, int c) { const int kk = (k & ~0xC) | ((k & 4) << 1) | ((k & 8) >> 1); return ((kk >> 3) * 4 + (c >> 5)) * 512 + ((kk & 7) * 32 + (c & 31)) * 2; }
__device__ __forceinline__ int v_rd_base(int lane) { return ((lane & 3) << 3) | (((lane >> 2) & 3) << 6) | (((lane >> 4) & 1) << 5) | (((lane >> 5) & 1) << 8); }
constexpr int v_rd_off(int d0, int ks, int half) { return d0 * 512 + ks * 4096 + half * 2048; }
__device__ __forceinline__ int crow(int r, int hi) { return (r & 3) + 8 * (r >> 2) + 4 * hi; }
__device__ __forceinline__ unsigned cvtpk(float lo, float hi) { unsigned r; asm volatile("v_cvt_pk_bf16_f32 %0, %1, %2" : "=v"(r) : "v"(lo), "v"(hi)); return r; }
__device__ __forceinline__ bf16x8 load8(const bf16* p) { return *reinterpret_cast<const bf16x8*>(p); }
__device__ __forceinline__ void mask_tile(f32x16& p0, f32x16& p1, int dq, unsigned W) {
    const float NEG = -__builtin_inff();
#pragma unroll
    for (int r = 0; r < 16; ++r) {
        const int c = (r & 3) + 8 * (r >> 2);
        if ((unsigned)(dq - c) >= W) p0[r] = NEG;
        if ((unsigned)(dq - c - 32) >= W) p1[r] = NEG;
    }
}
__device__ __forceinline__ void partialSM(f32x16& p0, f32x16& p1, float& m_reg, float& mn, float& alpha) {
    float pmax = p0[0]; for (int r = 1; r < 16; ++r) pmax = fmaxf(pmax, p0[r]); for (int r = 0; r < 16; ++r) pmax = fmaxf(pmax, p1[r]);
    { auto rr = __builtin_amdgcn_permlane32_swap(__float_as_uint(pmax), __float_as_uint(pmax), false, false);
      pmax = fmaxf(__uint_as_float(rr[0]), __uint_as_float(rr[1])); }
    constexpr float C2 = 1.4426950408889634f * SCALE;
    if (__builtin_expect(__all((pmax - m_reg) * SCALE <= THR), 1)) { mn = m_reg; alpha = 1.f; }
    else { mn = fmaxf(m_reg, pmax); alpha = __builtin_amdgcn_exp2f((m_reg - mn) * C2); m_reg = mn; }
    const float mnL = -mn * C2;
    for (int r = 0; r < 16; ++r) p0[r] = fmaf(p0[r], C2, mnL); for (int r = 0; r < 16; ++r) p1[r] = fmaf(p1[r], C2, mnL);
    for (int r = 0; r < 16; ++r) p0[r] = __builtin_amdgcn_exp2f(p0[r]);
}
__device__ __forceinline__ void finishSM(f32x16& p0, f32x16& p1, float alpha, float& l_reg, bf16x8& pa0, bf16x8& pa1, bf16x8& pa2, bf16x8& pa3) {
    for (int r = 0; r < 16; ++r) p1[r] = __builtin_amdgcn_exp2f(p1[r]);
    float ps = 0; for (int r = 0; r < 16; ++r) ps += p0[r]; for (int r = 0; r < 16; ++r) ps += p1[r];
    { auto rr = __builtin_amdgcn_permlane32_swap(__float_as_uint(ps), __float_as_uint(ps), false, false);
      ps = __uint_as_float(rr[0]) + __uint_as_float(rr[1]); }
    l_reg = l_reg * alpha + ps;
#define PK4(P, B_, OUT) do { unsigned a0 = cvtpk(P[B_+0], P[B_+1]), a1 = cvtpk(P[B_+2], P[B_+3]);                          \
        unsigned b0 = cvtpk(P[B_+4], P[B_+5]), b1 = cvtpk(P[B_+6], P[B_+7]);                                             \
        auto r0 = __builtin_amdgcn_permlane32_swap(a0, b0, false, false); auto r1 = __builtin_amdgcn_permlane32_swap(a1, b1, false, false); \
        u32x4 w = {r0[0], r1[0], r0[1], r1[1]}; OUT = *reinterpret_cast<bf16x8*>(&w); } while (0)
    PK4(p0, 0, pa0); PK4(p0, 8, pa1); PK4(p1, 0, pa2); PK4(p1, 8, pa3);
#undef PK4
}
template <int KB>
__device__ __forceinline__ void qkt(f32x16& p0, f32x16& p1, const char* K_lds, int r32, int hi, const bf16x8* qr) {
    p0 = f32x16{}; p1 = f32x16{};
    const char* kb[4];
#pragma unroll
    for (int dd = 0; dd < 4; ++dd) kb[dd] = K_lds + KB * SHM_K + KSWZ(r32, (dd * 16 + hi * 8) * 2);
#pragma unroll
    for (int d0 = 0; d0 < 8; ++d0) { const char* a = kb[d0 & 3] + (d0 >> 2) * 128;
        bf16x8 b0 = *reinterpret_cast<const bf16x8*>(a);
        bf16x8 b1 = *reinterpret_cast<const bf16x8*>(a + 32 * 256);
        p0 = __builtin_amdgcn_mfma_f32_32x32x16_bf16(b0, qr[d0], p0, 0, 0, 0);
        p1 = __builtin_amdgcn_mfma_f32_32x32x16_bf16(b1, qr[d0], p1, 0, 0, 0); }
}
template <int VB>
__device__ __forceinline__ void pv_tile(f32x16* o, int vb0, bf16x8 pa0, bf16x8 pa1, bf16x8 pa2, bf16x8 pa3) {
#define TRRD(dst, off) asm volatile("ds_read_b64_tr_b16 %0, %1 offset:%2" : "=&v"(dst) : "v"(vb0), "i"(off) : "memory")
#define PV_D0(d0) do { s16x4 l0, l1, l2, l3, h0, h1, h2, h3; constexpr int b_ = VB * SHM_V + v_rd_off(d0, 0, 0); \
        TRRD(l0, b_); TRRD(h0, b_ + 2048); TRRD(l1, b_ + 4096); TRRD(h1, b_ + 6144); TRRD(l2, b_ + 8192); TRRD(h2, b_ + 10240); TRRD(l3, b_ + 12288); TRRD(h3, b_ + 14336); \
        asm volatile("s_waitcnt lgkmcnt(0)" ::: "memory"); SBAR();   \
        o[d0] = __builtin_amdgcn_mfma_f32_32x32x16_bf16(pa0, (bf16x8){l0[0], l0[1], l0[2], l0[3], h0[0], h0[1], h0[2], h0[3]}, o[d0], 0, 0, 0);   \
        o[d0] = __builtin_amdgcn_mfma_f32_32x32x16_bf16(pa1, (bf16x8){l1[0], l1[1], l1[2], l1[3], h1[0], h1[1], h1[2], h1[3]}, o[d0], 0, 0, 0);   \
        o[d0] = __builtin_amdgcn_mfma_f32_32x32x16_bf16(pa2, (bf16x8){l2[0], l2[1], l2[2], l2[3], h2[0], h2[1], h2[2], h2[3]}, o[d0], 0, 0, 0);   \
        o[d0] = __builtin_amdgcn_mfma_f32_32x32x16_bf16(pa3, (bf16x8){l3[0], l3[1], l3[2], l3[3], h3[0], h3[1], h3[2], h3[3]}, o[d0], 0, 0, 0); } while (0)
    PV_D0(0); PV_D0(1); PV_D0(2); PV_D0(3);
#undef PV_D0
#undef TRRD
}

struct BlockRef { const bf16* Q; const bf16* K; const bf16* V; bf16* O; int P0; };
struct Seam { bf16x8 qr[8]; bf16x8 st_v0, st_v1, st_k0, st_k1; };
#define ROW(p, k0, rr) ((p) + (size_t)((k0) + (rr)) * PIN + sc)
#define VMW() asm volatile("s_waitcnt vmcnt(0)" ::: "memory")
#define VMWN(n) asm volatile("s_waitcnt vmcnt(%0)" :: "i"(n) : "memory")
#define SLOAD_H(Kp, Vp, k0) do { S.st_v0 = load8(ROW(Vp, k0, sr)); S.st_v1 = load8(ROW(Vp, k0, 32 + sr));              \
                         S.st_k0 = load8(ROW(Kp, k0, sr)); S.st_k1 = load8(ROW(Kp, k0, 32 + sr)); } while (0)
#define SWRITE_HK(bf) do { *(bf16x8*)(K_lds + (bf) * SHM_K + kws) = S.st_k0; *(bf16x8*)(K_lds + (bf) * SHM_K + kws + 32 * 256) = S.st_k1; } while (0)
#define SWRITE_HV(bf) do { *(bf16x8*)(V_lds + (bf) * SHM_V + vst0) = S.st_v0; *(bf16x8*)(V_lds + (bf) * SHM_V + vst1) = S.st_v1; } while (0)
#define SWRITE_H(bf) do { SWRITE_HV(bf); SWRITE_HK(bf); } while (0)
__device__ __forceinline__ void causal_prime(const BlockRef& cur, char* lds, Seam& S) {
    const int tid = threadIdx.x, wid = __builtin_amdgcn_readfirstlane(tid >> 6), lane = tid & 63, r32 = lane & 31, hi = lane >> 5;
    const int sr = tid >> 4, sc = (tid & 15) * 8, kws = KSWZ(sr, sc * 2); char* K_lds = lds + 2 * SHM_V;
    const int kb0 = 0;
    for (int d0 = 0; d0 < 8; ++d0) S.qr[d0] = load8(cur.Q + (size_t)(wid * QBLK + r32) * PIN + d0 * 16 + hi * 8);
    SLOAD_H(cur.K, cur.V, kb0); VMW(); SWRITE_HK(0);
    __syncthreads();
}
__device__ __forceinline__ void causal_block(const BlockRef& cur, const BlockRef& nxt, int skv, char* lds, Seam& S) {
    const int W = 1 << 30;
    const int tid = threadIdx.x, wid = __builtin_amdgcn_readfirstlane(tid >> 6), lane = tid & 63, r32 = lane & 31, hi = lane >> 5;
    const int j_lo = 0;
    int j_hi = (cur.P0 + QB - 1) / KVBLK + 1; if (j_hi > skv / KVBLK) j_hi = skv / KVBLK;
    const int NT = j_hi - j_lo;
    const int kbn = 0;
    const int qlo = cur.P0 + wid * QBLK, qm = qlo + r32 - 4 * hi;
    char* V_lds = lds; char* K_lds = lds + 2 * SHM_V;
    float* ws = (float*)(lds + 2 * SHM_V + 2 * SHM_K) + wid * 64; float* li_l = ws, * al_l = ws + 32;
    float m_reg = -1e30f, l_reg = 0; f32x16 o[4] = {};
    const int sr = tid >> 4, sc = (tid & 15) * 8, vst0 = v_st(sr, sc), vst1 = v_st(32 + sr, sc), kws = KSWZ(sr, sc * 2);
    const int vb0 = (int)(uintptr_t)V_lds + v_rd_base(lane);
    const bf16* Kh = cur.K; const bf16* Vh = cur.V;
#define RESC(a) do { if (__any((a) < 1.f)) { if (hi == 0) al_l[r32] = (a); asm volatile("s_waitcnt lgkmcnt(0)" ::: "memory");              \
                     for (int d_ = 0; d_ < 4; ++d_) for (int r = 0; r < 16; ++r) o[d_][r] *= al_l[crow(r, hi)]; } } while (0)
#define KBASE(t) ((j_lo + (t)) * KVBLK)
#define MASKT(P0_, P1_, t) do { const int kb_ = KBASE(t); if (kb_ + KVBLK - 1 > qlo) mask_tile(P0_, P1_, qm - kb_, (unsigned)W); } while (0)
    constexpr int NQL = 8;
#define SEAM_K0() do { VMWN(NQL); SWRITE_HK(0); SBAR(); } while (0)
    f32x16 pA0, pA1, pB0, pB1; float mnA, mnB, alA, alB; bf16x8 pa0, pa1, pa2, pa3;
    SWRITE_HV(0); SBAR();
    if (NT > 1) { SLOAD_H(Kh, Vh, KBASE(1)); }
    SBAR(); qkt<0>(pA0, pA1, K_lds, r32, hi, S.qr);
    MASKT(pA0, pA1, 0); partialSM(pA0, pA1, m_reg, mnA, alA);
    if (NT > 1) { VMW(); SWRITE_H(1); }
    __syncthreads();
#define HALF_STEP(PX0, PX1, mnX, alX, PY0, PY1, alY, t, KB, VB, SB) do {                                                      \
        SBAR(); qkt<KB>(PX0, PX1, K_lds, r32, hi, S.qr);                                                                      \
        finishSM(PY0, PY1, alY, l_reg, pa0, pa1, pa2, pa3); SBAR();                                                           \
        if ((t) + 1 < NT) { SLOAD_H(Kh, Vh, KBASE((t) + 1)); SBAR(); }                                                        \
        pv_tile<VB>(o, vb0, pa0, pa1, pa2, pa3); MASKT(PX0, PX1, (t)); partialSM(PX0, PX1, m_reg, mnX, alX);                  \
        __syncthreads();                                                                                                      \
        if ((t) + 1 < NT) { VMW(); SWRITE_H(SB); }                                                                            \
        RESC(alX); __syncthreads(); } while (0)
    for (int t = 1; t + 1 < NT; t += 2) {
        HALF_STEP(pB0, pB1, mnB, alB, pA0, pA1, alA, t, 1, 0, 0);
        HALF_STEP(pA0, pA1, mnA, alA, pB0, pB1, alB, t + 1, 0, 1, 1);
    }
    const bool even = (NT & 1) == 0;
    if (even) { SBAR(); qkt<1>(pB0, pB1, K_lds, r32, hi, S.qr); SBAR(); }
    SLOAD_H(nxt.K, nxt.V, kbn); SBAR();
#pragma unroll
    for (int d0 = 0; d0 < 8; ++d0) S.qr[d0] = load8(nxt.Q + (size_t)(wid * QBLK + r32) * PIN + d0 * 16 + hi * 8);
    SBAR();
    finishSM(pA0, pA1, alA, l_reg, pa0, pa1, pa2, pa3); SBAR();
    pv_tile<0>(o, vb0, pa0, pa1, pa2, pa3);
    if (even) { MASKT(pB0, pB1, NT - 1); partialSM(pB0, pB1, m_reg, mnB, alB); __syncthreads(); RESC(alB);
        finishSM(pB0, pB1, alB, l_reg, pa0, pa1, pa2, pa3); SBAR(); pv_tile<1>(o, vb0, pa0, pa1, pa2, pa3); }
    SBAR(); SEAM_K0();
    if (hi == 0) li_l[r32] = l_reg; asm volatile("s_waitcnt lgkmcnt(0)" ::: "memory");
    float rli[16];
#pragma unroll
    for (int r = 0; r < 16; ++r) rli[r] = __builtin_amdgcn_rcpf(li_l[crow(r, hi)]);
    bf16* Ow = cur.O + (size_t)(wid * QBLK) * POUT;
#pragma unroll
    for (int r = 0; r < 16; ++r) { const int orow = crow(r, hi);
#pragma unroll
        for (int d0 = 0; d0 < 4; ++d0) { const float v = o[d0][r] * rli[r];
            const float vn = __shfl_xor(v, 1);
            if ((r32 & 1) == 0) *(unsigned*)(Ow + (size_t)orow * POUT + d0 * 32 + r32) = cvtpk(v, vn); } }
    __syncthreads();
#undef RESC
#undef KBASE
#undef MASKT
#undef SEAM_K0
#undef HALF_STEP
}
#undef ROW
#undef VMW
#undef VMWN
#undef SLOAD_H
#undef SWRITE_HK
#undef SWRITE_HV
#undef SWRITE_H
#undef KSWZ
#undef SBAR

__device__ __forceinline__ BlockRef make_ref(int L, int pass, const bf16* PROJ, bf16* O16) {
    const int xcd = L & 7, kk = L >> 3, p = xcd * 4 + (kk >> 5), x = kk & 31;
    const int qb = pass ? 63 - x : x;
    const int b = p >> 4, h = (p >> 2) & 3, m = (p >> 1) & 1, vh = p & 1;
    const size_t rb = (size_t)b * SEQ;
    BlockRef r;
    r.Q = PROJ + (rb + (size_t)qb * QB) * PIN + (h * 2 + m) * 128;
    r.K = PROJ + rb * PIN + 1024 + (h * 2 + m) * 128;
    r.V = PROJ + rb * PIN + 2048 + h * 256 + vh * 128;
    r.O = O16 + (rb + (size_t)qb * QB) * POUT + (p & 15) * 128;
    r.P0 = qb * QB;
    return r;
}
__device__ __forceinline__ void attn_phase(char* lds, const bf16* PROJ, bf16* O16, int G, int w) {
    constexpr int total = 1024;
    int L = w; if (L >= total) return;
    int pass = 0;
    BlockRef cur = make_ref(L, 0, PROJ, O16);
    Seam S;
    causal_prime(cur, lds, S);
    for (;;) {
        const bool more_pass = pass == 0, more_item = L + G < total, last = !more_pass && !more_item;
        int passn, Ln;
        if (more_pass) { passn = 1; Ln = L; } else { passn = 0; Ln = more_item ? L + G : L; }
        const BlockRef nxt = last ? cur : make_ref(Ln, passn, PROJ, O16);
        causal_block(cur, nxt, SEQ, lds, S);
        if (last) break;
        cur = nxt; pass = passn; L = Ln;
    }
}
}


namespace att2 {
using namespace att;
constexpr int QB2 = 128;
constexpr int PH = 128;
constexpr long HSTR = (long)SEQ * PH;
constexpr int L_V = 0, L_K = 4 * SHM_V, L_WSF = L_K + 2 * SHM_K, L_XM = L_WSF + 2048, L_XP = L_XM + 2048, L_XL = L_XP + 32768, L_END = L_XL + 1024;
#define KSWZ2(row, colB) ((row) * 256 + ((colB) ^ (((row) & 7) << 4)))
#define SBAR2() __builtin_amdgcn_sched_barrier(0)
struct BlockRef2 { const bf16* Q; const bf16* K; const bf16* V; bf16* O; bf16* C; int P0; int fuse; };

__device__ __forceinline__ void block2(const BlockRef2& cur, char* lds, int wave, float lam, const float* subln) {
    const int lane = (int)__builtin_amdgcn_mbcnt_hi(~0u, __builtin_amdgcn_mbcnt_lo(~0u, 0u)), r32 = lane & 31, hi = lane >> 5, tid = wave * 64 + lane;
    const int rg = wave & 3, c = wave >> 2, pw = wave ^ 4;
    const int NT = (cur.P0 + QB2 - 1) / KVBLK + 1;
    const int qlo = cur.P0 + rg * QBLK, qm = qlo + r32 - 4 * hi;
    char* V_lds = lds + L_V; char* K_lds = lds + L_K;
    float* wsf = (float*)(lds + L_WSF) + wave * 64; float* li_l = wsf; float* al_l = wsf + 32;
    float* xm = (float*)(lds + L_XM);
    char* xp = lds + L_XP;
    float* xl = (float*)(lds + L_XL);
    const int sr = tid >> 4, sc = (tid & 15) * 8, vst0 = v_st(sr, sc), vst1 = v_st(32 + sr, sc), kws = KSWZ2(sr, sc * 2);
    const int vb0 = (int)(uintptr_t)V_lds + c * SHM_V + v_rd_base(lane);
    const bf16* Kh = cur.K; const bf16* Vh = cur.V;
    bf16x8 qr[8];
#pragma unroll
    for (int d0 = 0; d0 < 8; ++d0) qr[d0] = *reinterpret_cast<const bf16x8*>((const char*)(cur.Q + (size_t)(rg * QBLK) * PH) + (unsigned)(r32 * PH + hi * 8) * 2u + d0 * 32);
    bf16x8 sk0, sk1, sv00, sv01, sv10, sv11;
    unsigned voff = (unsigned)(sr * PH + sc) * 2u; asm volatile("" : "+v"(voff));
#define LD16(base_, byteoff_) (*reinterpret_cast<const bf16x8*>((const char*)(base_) + voff + (byteoff_)))
#define KLOAD(k0) do { const bf16* kb0_ = Kh + (size_t)(k0) * PH; const bf16* kb1_ = Kh + (size_t)((k0) + 32) * PH; sk0 = LD16(kb0_, 0); sk1 = LD16(kb1_, 0); } while (0)
#define VLOAD(k0) do { const bf16* vb0_ = Vh + (size_t)(k0) * PH; const bf16* vb1_ = Vh + (size_t)((k0) + 32) * PH; \
                       sv00 = LD16(vb0_, 0); sv01 = LD16(vb1_, 0); sv10 = LD16(vb0_ + HSTR, 0); sv11 = LD16(vb1_ + HSTR, 0); } while (0)
#define KWRITE(bf) do { *(bf16x8*)(K_lds + (bf) * SHM_K + kws) = sk0; *(bf16x8*)(K_lds + (bf) * SHM_K + kws + 32 * 256) = sk1; } while (0)
#define VWRITE(bf) do { *(bf16x8*)(V_lds + ((bf) * 2) * SHM_V + vst0) = sv00; *(bf16x8*)(V_lds + ((bf) * 2) * SHM_V + vst1) = sv01; \
                        *(bf16x8*)(V_lds + ((bf) * 2 + 1) * SHM_V + vst0) = sv10; *(bf16x8*)(V_lds + ((bf) * 2 + 1) * SHM_V + vst1) = sv11; } while (0)
    KLOAD(0); VLOAD(0); KWRITE(0); VWRITE(0);
    KLOAD(KVBLK); VLOAD(KVBLK); KWRITE(1); VWRITE(1);
    if (NT > 2) { KLOAD(2 * KVBLK); VLOAD(2 * KVBLK); }
    float m_reg = -1e30f, l_reg = 0.f; f32x16 o[4] = {};
    f32x16 pA, pB; float alA = 1.f, alB = 1.f; bf16x8 f0, f1;
    constexpr float C2 = 1.4426950408889634f * SCALE;
#define QKT2(P, KB) do { P = f32x16{}; const char* kq_ = K_lds + (KB) * SHM_K + c * (32 * 256); \
        _Pragma("unroll") for (int d0 = 0; d0 < 8; ++d0) { const bf16x8 b_ = *reinterpret_cast<const bf16x8*>(kq_ + KSWZ2(r32, (((d0) & 3) * 16 + hi * 8) * 2) + ((d0) >> 2) * 128); \
            P = __builtin_amdgcn_mfma_f32_32x32x16_bf16(b_, qr[d0], P, 0, 0, 0); } } while (0)
#define MASKMAX(P, t, par) do { const int kb_ = (t) * KVBLK + 32 * c; \
        if (kb_ + 31 > qlo) { const int dq_ = qm - kb_; const float NEG_ = -__builtin_inff(); \
            _Pragma("unroll") for (int r = 0; r < 16; ++r) { if (dq_ - ((r & 3) + 8 * (r >> 2)) < 0) P[r] = NEG_; } } \
        float pm_ = P[0]; _Pragma("unroll") for (int r = 1; r < 16; ++r) pm_ = fmaxf(pm_, P[r]); \
        { auto rr = __builtin_amdgcn_permlane32_swap(__float_as_uint(pm_), __float_as_uint(pm_), false, false); pm_ = fmaxf(__uint_as_float(rr[0]), __uint_as_float(rr[1])); } \
        pmx = pm_; if (hi == 0) xm[((par) * 8 + wave) * 32 + r32] = pm_; } while (0)
#define SOFTMAX(P, par, alX) do { const float pmax_ = fmaxf(pmx, xm[((par) * 8 + pw) * 32 + r32]); float mn_; \
        if (__builtin_expect(__all((pmax_ - m_reg) * SCALE <= THR), 1)) { mn_ = m_reg; alX = 1.f; } \
        else { mn_ = fmaxf(m_reg, pmax_); alX = __builtin_amdgcn_exp2f((m_reg - mn_) * C2); m_reg = mn_; } \
        const float mnL_ = -mn_ * C2; \
        _Pragma("unroll") for (int r = 0; r < 16; ++r) P[r] = __builtin_amdgcn_exp2f(fmaf(P[r], C2, mnL_)); } while (0)
#define PK4B(P, B_, OUT) do { unsigned a0 = cvtpk(P[B_+0], P[B_+1]), a1 = cvtpk(P[B_+2], P[B_+3]); unsigned b0 = cvtpk(P[B_+4], P[B_+5]), b1 = cvtpk(P[B_+6], P[B_+7]); \
        auto r0 = __builtin_amdgcn_permlane32_swap(a0, b0, false, false); auto r1 = __builtin_amdgcn_permlane32_swap(a1, b1, false, false); \
        u32x4 w = {r0[0], r1[0], r0[1], r1[1]}; OUT = *reinterpret_cast<bf16x8*>(&w); } while (0)
#define FINISH(P, alY, par) do { float ps_ = 0; _Pragma("unroll") for (int r = 0; r < 16; ++r) ps_ += P[r]; \
        { auto rr = __builtin_amdgcn_permlane32_swap(__float_as_uint(ps_), __float_as_uint(ps_), false, false); ps_ = __uint_as_float(rr[0]) + __uint_as_float(rr[1]); } \
        l_reg = l_reg * alY + ps_; PK4B(P, 0, f0); PK4B(P, 8, f1); \
        *(bf16x8*)(xp + (((par) * 8 + wave) * 2 + 0) * 1024 + lane * 16) = f0; *(bf16x8*)(xp + (((par) * 8 + wave) * 2 + 1) * 1024 + lane * 16) = f1; } while (0)
#define TRRD2(dst, off) asm volatile("ds_read_b64_tr_b16 %0, %1 offset:%2" : "=&v"(dst) : "v"(vb0), "i"(off) : "memory")
#define PV2_D0(VB, d0) do { s16x4 l0, l1, l2, l3, h0, h1, h2, h3; constexpr int b_ = (VB) * 2 * SHM_V + v_rd_off(d0, 0, 0); \
        TRRD2(l0, b_); TRRD2(h0, b_ + 2048); TRRD2(l1, b_ + 4096); TRRD2(h1, b_ + 6144); TRRD2(l2, b_ + 8192); TRRD2(h2, b_ + 10240); TRRD2(l3, b_ + 12288); TRRD2(h3, b_ + 14336); \
        asm volatile("s_waitcnt lgkmcnt(0)" ::: "memory"); SBAR2(); __builtin_amdgcn_s_setprio(1);  \
        o[d0] = __builtin_amdgcn_mfma_f32_32x32x16_bf16(pa0, (bf16x8){l0[0], l0[1], l0[2], l0[3], h0[0], h0[1], h0[2], h0[3]}, o[d0], 0, 0, 0);   \
        o[d0] = __builtin_amdgcn_mfma_f32_32x32x16_bf16(pa1, (bf16x8){l1[0], l1[1], l1[2], l1[3], h1[0], h1[1], h1[2], h1[3]}, o[d0], 0, 0, 0);   \
        o[d0] = __builtin_amdgcn_mfma_f32_32x32x16_bf16(pa2, (bf16x8){l2[0], l2[1], l2[2], l2[3], h2[0], h2[1], h2[2], h2[3]}, o[d0], 0, 0, 0);   \
        o[d0] = __builtin_amdgcn_mfma_f32_32x32x16_bf16(pa3, (bf16x8){l3[0], l3[1], l3[2], l3[3], h3[0], h3[1], h3[2], h3[3]}, o[d0], 0, 0, 0); __builtin_amdgcn_s_setprio(0); } while (0)
#define PVALL(VB, par) do { const bf16x8 g0_ = *(const bf16x8*)(xp + (((par) * 8 + pw) * 2 + 0) * 1024 + lane * 16), g1_ = *(const bf16x8*)(xp + (((par) * 8 + pw) * 2 + 1) * 1024 + lane * 16); \
        const bf16x8 pa0 = c ? g0_ : f0, pa1 = c ? g1_ : f1, pa2 = c ? f0 : g0_, pa3 = c ? f1 : g1_; \
        PV2_D0(VB, 0); PV2_D0(VB, 1); PV2_D0(VB, 2); PV2_D0(VB, 3); } while (0)
#define RESC2(a) do { if (__any((a) < 1.f)) { if (hi == 0) al_l[r32] = (a); asm volatile("s_waitcnt lgkmcnt(0)" ::: "memory");              \
                     for (int d_ = 0; d_ < 4; ++d_) for (int r = 0; r < 16; ++r) o[d_][r] *= al_l[crow(r, hi)]; } } while (0)
#define QKT2F(PX, KB, PY, alY, par) do { const char* kq_ = K_lds + (KB) * SHM_K + c * (32 * 256); bf16x8 kf_[8]; \
        _Pragma("unroll") for (int d0 = 0; d0 < 8; ++d0) kf_[d0] = *reinterpret_cast<const bf16x8*>(kq_ + KSWZ2(r32, (((d0) & 3) * 16 + hi * 8) * 2) + ((d0) >> 2) * 128); \
        PX = f32x16{}; float ps_ = 0.f; SBAR2(); __builtin_amdgcn_s_setprio(1); \
        PX = __builtin_amdgcn_mfma_f32_32x32x16_bf16(kf_[0], qr[0], PX, 0, 0, 0); SBAR2(); \
        _Pragma("unroll") for (int r = 0; r < 8; ++r) ps_ += PY[r]; SBAR2(); \
        PX = __builtin_amdgcn_mfma_f32_32x32x16_bf16(kf_[1], qr[1], PX, 0, 0, 0); SBAR2(); \
        _Pragma("unroll") for (int r = 8; r < 16; ++r) ps_ += PY[r]; \
        { auto rr = __builtin_amdgcn_permlane32_swap(__float_as_uint(ps_), __float_as_uint(ps_), false, false); ps_ = __uint_as_float(rr[0]) + __uint_as_float(rr[1]); } \
        l_reg = l_reg * alY + ps_; SBAR2(); \
        PX = __builtin_amdgcn_mfma_f32_32x32x16_bf16(kf_[2], qr[2], PX, 0, 0, 0); SBAR2(); \
        PK4B(PY, 0, f0); *(bf16x8*)(xp + (((par) * 8 + wave) * 2 + 0) * 1024 + lane * 16) = f0; SBAR2(); \
        PX = __builtin_amdgcn_mfma_f32_32x32x16_bf16(kf_[3], qr[3], PX, 0, 0, 0); SBAR2(); \
        PK4B(PY, 8, f1); *(bf16x8*)(xp + (((par) * 8 + wave) * 2 + 1) * 1024 + lane * 16) = f1; SBAR2(); \
        PX = __builtin_amdgcn_mfma_f32_32x32x16_bf16(kf_[4], qr[4], PX, 0, 0, 0); \
        PX = __builtin_amdgcn_mfma_f32_32x32x16_bf16(kf_[5], qr[5], PX, 0, 0, 0); \
        PX = __builtin_amdgcn_mfma_f32_32x32x16_bf16(kf_[6], qr[6], PX, 0, 0, 0); \
        PX = __builtin_amdgcn_mfma_f32_32x32x16_bf16(kf_[7], qr[7], PX, 0, 0, 0); __builtin_amdgcn_s_setprio(0); SBAR2(); } while (0)
#define SM_DECIDE(par, alX) do { const float pmax_ = fmaxf(pmx, xm[((par) * 8 + pw) * 32 + r32]); float mn_; \
        if (__builtin_expect(__all((pmax_ - m_reg) * SCALE <= THR), 1)) { mn_ = m_reg; alX = 1.f; } \
        else { mn_ = fmaxf(m_reg, pmax_); alX = __builtin_amdgcn_exp2f((m_reg - mn_) * C2); m_reg = mn_; } \
        mnL = -mn_ * C2; } while (0)
#define SM_EXP4(P, B_) do { _Pragma("unroll") for (int r = (B_); r < (B_) + 4; ++r) P[r] = __builtin_amdgcn_exp2f(fmaf(P[r], C2, mnL)); } while (0)
#define PVSM(VB, par, PX, parX, alX) do { const bf16x8 g0_ = *(const bf16x8*)(xp + (((par) * 8 + pw) * 2 + 0) * 1024 + lane * 16), g1_ = *(const bf16x8*)(xp + (((par) * 8 + pw) * 2 + 1) * 1024 + lane * 16); \
        SM_DECIDE(parX, alX); \
        const bf16x8 pa0 = c ? g0_ : f0, pa1 = c ? g1_ : f1, pa2 = c ? f0 : g0_, pa3 = c ? f1 : g1_; SBAR2(); \
        PV2_D0(VB, 0); SBAR2(); SM_EXP4(PX, 0); SBAR2(); PV2_D0(VB, 1); SBAR2(); SM_EXP4(PX, 4); SBAR2(); \
        PV2_D0(VB, 2); SBAR2(); SM_EXP4(PX, 8); SBAR2(); PV2_D0(VB, 3); SBAR2(); SM_EXP4(PX, 12); SBAR2(); } while (0)
    float pmx, mnL;
    __syncthreads();
    QKT2(pA, 0); MASKMAX(pA, 0, 0);
    __syncthreads();
    SOFTMAX(pA, 0, alA);
#define STEP2(PX, alX, PY, alY, t, KB, VB) do { \
        SBAR2(); QKT2F(PX, KB, PY, alY, VB); \
        MASKMAX(PX, t, KB); \
        __syncthreads(); \
        if ((t) + 1 < NT) { KWRITE(VB); if ((t) + 2 < NT) KLOAD(((t) + 2) * KVBLK); } \
        PVSM(VB, VB, PX, KB, alX); \
        __syncthreads(); \
        if ((t) + 1 < NT) { VWRITE(VB); if ((t) + 2 < NT) VLOAD(((t) + 2) * KVBLK); } \
        RESC2(alX); } while (0)
    for (int t = 1; t + 1 < NT; t += 2) {
        STEP2(pB, alB, pA, alA, t, 1, 0);
        STEP2(pA, alA, pB, alB, t + 1, 0, 1);
    }
    STEP2(pB, alB, pA, alA, NT - 1, 1, 0);
    FINISH(pB, alB, 1);
    if (hi == 0) xl[wave * 32 + r32] = l_reg;
    __syncthreads();
    PVALL(1, 1);
    l_reg += xl[pw * 32 + r32];
    if (hi == 0) li_l[r32] = l_reg; asm volatile("s_waitcnt lgkmcnt(0)" ::: "memory");
    float rli[16];
#pragma unroll
    for (int r = 0; r < 16; ++r) rli[r] = __builtin_amdgcn_rcpf(li_l[crow(r, hi)]);
    { char* stg = lds + (wave < 4 ? L_V + wave * 8192 : L_K + (wave - 4) * 8192);
      unsigned soff = (unsigned)(4 * hi * 256 + r32 * 2); asm volatile("" : "+v"(soff));
#pragma unroll
      for (int r = 0; r < 16; ++r) { const unsigned orow = (unsigned)((r & 3) + 8 * (r >> 2));
#pragma unroll
          for (int d0 = 0; d0 < 4; ++d0) *(bf16*)(stg + soff + orow * 256u + d0 * 64u) = __float2bfloat16(o[d0][r] * rli[r]); }
      asm volatile("s_waitcnt lgkmcnt(0)" ::: "memory");
      char* Ow = (char*)(cur.O + (size_t)(rg * QBLK) * POUT + c * 128);
      unsigned roff = (unsigned)((lane >> 4) * 256 + (lane & 15) * 16), goff = (unsigned)((lane >> 4) * (POUT * 2) + (lane & 15) * 16); asm volatile("" : "+v"(roff), "+v"(goff));
      if (!cur.fuse) {
#pragma unroll
        for (int i = 0; i < 8; ++i) { const u32x4 v = *(const u32x4*)(stg + roff + i * 1024u); *(u32x4*)(Ow + goff + (unsigned)i * (4u * POUT * 2u)) = v; }
      } else {
        const char* O1w = (const char*)Ow - 512;
        char* Cw = (char*)(cur.C + (size_t)(rg * QBLK) * POUT + c * 128);
        float d[8][8], ps[8];
#pragma unroll
        for (int i = 0; i < 8; ++i) { const u32x4 v2 = *(const u32x4*)(stg + roff + i * 1024u); const u32x4 v1 = *(const u32x4*)(O1w + goff + (unsigned)i * (4u * POUT * 2u));
            float q = 0.f;
#pragma unroll
            for (int e = 0; e < 4; ++e) { const float a = __builtin_bit_cast(float, v1[e] << 16) - lam * __builtin_bit_cast(float, v2[e] << 16);
                const float b2 = __builtin_bit_cast(float, v1[e] & 0xffff0000u) - lam * __builtin_bit_cast(float, v2[e] & 0xffff0000u);
                d[i][2 * e] = a; d[i][2 * e + 1] = b2; q += a * a + b2 * b2; }
            ps[i] = q; }
#pragma unroll
        for (int sh = 1; sh < 16; sh <<= 1) {
#pragma unroll
            for (int i = 0; i < 8; ++i) ps[i] += __shfl_xor(ps[i], sh); }
        float* xq = xm;
        if ((lane & 15) == 0) {
#pragma unroll
            for (int i = 0; i < 8; ++i) xq[wave * 32 + i * 4 + (lane >> 4)] = ps[i]; }
        __syncthreads();
        const f32x4 sg0 = *(const f32x4*)(subln + c * 128 + (lane & 15) * 8), sg1 = *(const f32x4*)(subln + c * 128 + (lane & 15) * 8 + 4);
#pragma unroll
        for (int i = 0; i < 8; ++i) { const float tot = ps[i] + xq[pw * 32 + i * 4 + (lane >> 4)];
            const float rs = rsqrtf(tot * (1.f / 256.f) + 1e-6f) * 0.8f;
            u32x4 w; w.x = cvtpk(d[i][0] * rs * sg0.x, d[i][1] * rs * sg0.y); w.y = cvtpk(d[i][2] * rs * sg0.z, d[i][3] * rs * sg0.w);
            w.z = cvtpk(d[i][4] * rs * sg1.x, d[i][5] * rs * sg1.y); w.w = cvtpk(d[i][6] * rs * sg1.z, d[i][7] * rs * sg1.w);
            *(u32x4*)(Cw + goff + (unsigned)i * (4u * POUT * 2u)) = w; }
      } }
    __syncthreads();
#undef LD16
#undef KLOAD
#undef VLOAD
#undef KWRITE
#undef VWRITE
#undef QKT2
#undef MASKMAX
#undef SOFTMAX
#undef PK4B
#undef FINISH
#undef TRRD2
#undef PV2_D0
#undef PVALL
#undef RESC2
#undef STEP2
#undef QKT2F
#undef SM_DECIDE
#undef SM_EXP4
#undef PVSM
}
__device__ __forceinline__ BlockRef2 make_ref2(int L, int pass, int m, const bf16* PROJ, bf16* O16, bf16* CONCAT) {
    const int p = L & 7, x = L >> 3;
    const int qb = pass ? 127 - x : x;
    const int b = p >> 2, h = p & 3;
    const size_t rb = (size_t)b * SEQ;
    BlockRef2 r;
    const bf16* hb = PROJ + (size_t)b * 24 * HSTR;
    r.Q = hb + (size_t)(h * 2 + m) * HSTR + (size_t)qb * QB2 * PH;
    r.K = hb + (size_t)(8 + h * 2 + m) * HSTR;
    r.V = hb + (size_t)(16 + h * 2) * HSTR;
    r.O = O16 + (rb + (size_t)qb * QB2) * POUT + h * 512 + m * 256;
    r.C = CONCAT + (rb + (size_t)qb * QB2) * POUT + h * 256;
    r.P0 = qb * QB2; r.fuse = m;
    return r;
}
__device__ __forceinline__ void attn_phase2(char* lds, const bf16* PROJ, bf16* O16, bf16* CONCAT, float lam, const float* subln, int G, int w, int wave) {
    for (int L = w; L < 512; L += G)
        for (int pass = 0; pass < 2; ++pass)
            for (int m = 0; m < 2; ++m) { const BlockRef2 cur = make_ref2(L, pass, m, PROJ, O16, CONCAT); block2(cur, lds, wave, lam, subln); }
}
#undef KSWZ2
#undef SBAR2
}

constexpr size_t MiB = 1u << 20;
constexpr size_t WS_WIN = 1 * MiB;
constexpr size_t WS_WO = 17 * MiB;
constexpr size_t WS_WQX = 25 * MiB;
constexpr size_t WS_WKV = 33 * MiB;
constexpr size_t WS_WOX = 49 * MiB;
constexpr size_t WS_WGU = 57 * MiB;
constexpr size_t WS_WDN = 101 * MiB;
constexpr size_t WS_WPOOL = 123 * MiB;
constexpr size_t WS_MN = 124 * MiB;
constexpr size_t WS_KX = 126 * MiB;
constexpr size_t WS_VXT = 128 * MiB;
constexpr size_t WS_HN = 144 * MiB;
constexpr size_t WS_PROJ = 272 * MiB;
constexpr size_t WS_O16 = 528 * MiB;
constexpr size_t WS_POOLED = 656 * MiB;
constexpr size_t WS_CONCAT = 720 * MiB;
constexpr size_t WS_QX = 272 * MiB;
constexpr size_t WS_PSC = 400 * MiB;
constexpr size_t WS_OX = 528 * MiB;
constexpr size_t WS_HID = 272 * MiB;
constexpr size_t WS_XB = 848 * MiB;
constexpr size_t WS_END = 976 * MiB;

constexpr int LDS_BYTES = 147456;
constexpr int XL_OFF = 131072;
constexpr int NPHASE = 14;

typedef unsigned short bf16r;
typedef float f32x4 __attribute__((ext_vector_type(4)));
typedef unsigned v4u __attribute__((ext_vector_type(4)));
typedef unsigned v2u __attribute__((ext_vector_type(2)));
#define LAS __attribute__((address_space(3)))

__device__ __forceinline__ unsigned f2bf(float f) { unsigned u = __builtin_bit_cast(unsigned, f); return (u + 0x7fffu + ((u >> 16) & 1u)) >> 16; }
__device__ __forceinline__ unsigned pk2(float lo, float hi) { return f2bf(lo) | (f2bf(hi) << 16); }
__device__ __forceinline__ float bf2f(unsigned short b) { return __builtin_bit_cast(float, (unsigned)b << 16); }
__device__ __forceinline__ float wave_sum(float v) {
#pragma unroll
    for (int o = 1; o < 64; o <<= 1) v += __shfl_xor(v, o);
    return v;
}

__device__ __forceinline__ void transpose_item(const float* W, int N, bf16r* WT, int ldt, int k0, int n0, int drow0, LAS float* scr, int lane) {
#pragma unroll 8
    for (int i = 0; i < 32; ++i) { const int kk = 2 * i + (lane >> 5); scr[kk * 33 + (lane & 31)] = W[(size_t)(k0 + kk) * N + n0 + (lane & 31)]; }
    asm volatile("s_waitcnt lgkmcnt(0)" ::: "memory");
    const int c = lane & 7;
#pragma unroll
    for (int j = 0; j < 4; ++j) { const int n = (lane >> 3) + 8 * j; const LAS float* s = scr + (8 * c) * 33 + n;
        v4u o; o.x = pk2(s[0 * 33], s[1 * 33]); o.y = pk2(s[2 * 33], s[3 * 33]); o.z = pk2(s[4 * 33], s[5 * 33]); o.w = pk2(s[6 * 33], s[7 * 33]);
        *(v4u*)(WT + (size_t)(drow0 + n) * ldt + k0 + 8 * c) = o; }
    asm volatile("s_waitcnt lgkmcnt(0)" ::: "memory");
}
__device__ __forceinline__ void rms_row_bf16(const float* xrow, const float* g, bf16r* orow, int lane) {
    const f32x4* xr = (const f32x4*)xrow + lane; const f32x4* gr = (const f32x4*)g + lane;
    f32x4 v[8]; float s = 0.f;
#pragma unroll
    for (int j = 0; j < 8; ++j) { v[j] = xr[64 * j]; s += (v[j].x * v[j].x + v[j].y * v[j].y) + (v[j].z * v[j].z + v[j].w * v[j].w); }
    const float rstd = rsqrtf(wave_sum(s) * (1.f / DM) + EPS);
    v2u* o8 = (v2u*)orow + lane;
#pragma unroll
    for (int j = 0; j < 8; ++j) { const f32x4 gg = gr[64 * j]; v2u w; w.x = pk2(v[j].x * rstd * gg.x, v[j].y * rstd * gg.y); w.y = pk2(v[j].z * rstd * gg.z, v[j].w * rstd * gg.w); o8[64 * j] = w; }
}
__device__ __forceinline__ void rms_rowb_bf16(const bf16r* xrow, const float* g, bf16r* orow, int lane) {
    const v4u* xr = (const v4u*)xrow + lane; const f32x4* gr = (const f32x4*)g + 2 * lane;
    float v[4][8]; float s = 0.f;
#pragma unroll
    for (int j = 0; j < 4; ++j) { const v4u w = xr[64 * j];
#pragma unroll
        for (int e = 0; e < 4; ++e) { v[j][2 * e] = __builtin_bit_cast(float, w[e] << 16); v[j][2 * e + 1] = __builtin_bit_cast(float, w[e] & 0xffff0000u); }
#pragma unroll
        for (int e = 0; e < 8; ++e) s += v[j][e] * v[j][e]; }
    const float rstd = rsqrtf(wave_sum(s) * (1.f / DM) + EPS);
    v4u* o8 = (v4u*)orow + lane;
#pragma unroll
    for (int j = 0; j < 4; ++j) { const f32x4 g0 = gr[128 * j], g1 = gr[128 * j + 1]; v4u w;
        w.x = pk2(v[j][0] * rstd * g0.x, v[j][1] * rstd * g0.y); w.y = pk2(v[j][2] * rstd * g0.z, v[j][3] * rstd * g0.w);
        w.z = pk2(v[j][4] * rstd * g1.x, v[j][5] * rstd * g1.y); w.w = pk2(v[j][6] * rstd * g1.z, v[j][7] * rstd * g1.w); o8[64 * j] = w; }
}
__device__ __forceinline__ void rms_rowb_f32(const bf16r* xrow, const float* g, float* orow, int lane) {
    const v4u* xr = (const v4u*)xrow + lane; const f32x4* gr = (const f32x4*)g + 2 * lane;
    float v[4][8]; float s = 0.f;
#pragma unroll
    for (int j = 0; j < 4; ++j) { const v4u w = xr[64 * j];
#pragma unroll
        for (int e = 0; e < 4; ++e) { v[j][2 * e] = __builtin_bit_cast(float, w[e] << 16); v[j][2 * e + 1] = __builtin_bit_cast(float, w[e] & 0xffff0000u); }
#pragma unroll
        for (int e = 0; e < 8; ++e) s += v[j][e] * v[j][e]; }
    const float rstd = rsqrtf(wave_sum(s) * (1.f / DM) + EPS);
    f32x4* o4 = (f32x4*)orow + 2 * lane;
#pragma unroll
    for (int j = 0; j < 4; ++j) { const f32x4 g0 = gr[128 * j], g1 = gr[128 * j + 1];
        o4[128 * j] = (f32x4){v[j][0] * rstd * g0.x, v[j][1] * rstd * g0.y, v[j][2] * rstd * g0.z, v[j][3] * rstd * g0.w};
        o4[128 * j + 1] = (f32x4){v[j][4] * rstd * g1.x, v[j][5] * rstd * g1.y, v[j][6] * rstd * g1.z, v[j][7] * rstd * g1.w}; }
}
template <int R> __device__ __forceinline__ void rms_rows_f32_to_bf16(const float* __restrict__ X, const float* __restrict__ g, bf16r* __restrict__ O, int m0, int lane) {
    f32x4 v[R][8]; float ss[R];
#pragma unroll
    for (int r = 0; r < R; ++r) { const f32x4* xr = (const f32x4*)(X + (size_t)(m0 + r) * DM) + lane;
#pragma unroll
        for (int j = 0; j < 8; ++j) v[r][j] = xr[64 * j]; }
#pragma unroll
    for (int r = 0; r < R; ++r) { float s = 0.f;
#pragma unroll
        for (int j = 0; j < 8; ++j) s += (v[r][j].x * v[r][j].x + v[r][j].y * v[r][j].y) + (v[r][j].z * v[r][j].z + v[r][j].w * v[r][j].w);
        ss[r] = s; }
#pragma unroll
    for (int o = 1; o < 64; o <<= 1) {
#pragma unroll
        for (int r = 0; r < R; ++r) ss[r] += __shfl_xor(ss[r], o); }
    const f32x4* gr = (const f32x4*)g + lane;
#pragma unroll
    for (int j = 0; j < 8; ++j) { const f32x4 gg = gr[64 * j];
#pragma unroll
        for (int r = 0; r < R; ++r) { const float rstd = rsqrtf(ss[r] * (1.f / DM) + EPS); v2u w;
            w.x = pk2(v[r][j].x * rstd * gg.x, v[r][j].y * rstd * gg.y); w.y = pk2(v[r][j].z * rstd * gg.z, v[r][j].w * rstd * gg.w);
            ((v2u*)(O + (size_t)(m0 + r) * DM) + lane)[64 * j] = w; } }
}
template <int R, bool OUT_F32> __device__ __forceinline__ void rms_rows_bf16(const bf16r* __restrict__ X, const float* __restrict__ g, void* __restrict__ O, int m0, int lane) {
    v4u w[R][4]; float ss[R];
#pragma unroll
    for (int r = 0; r < R; ++r) { const v4u* xr = (const v4u*)(X + (size_t)(m0 + r) * DM) + lane;
#pragma unroll
        for (int j = 0; j < 4; ++j) w[r][j] = xr[64 * j]; }
#pragma unroll
    for (int r = 0; r < R; ++r) { float s = 0.f;
#pragma unroll
        for (int j = 0; j < 4; ++j)
#pragma unroll
            for (int e = 0; e < 4; ++e) { const float a = __builtin_bit_cast(float, w[r][j][e] << 16), b = __builtin_bit_cast(float, w[r][j][e] & 0xffff0000u); s += a * a + b * b; }
        ss[r] = s; }
#pragma unroll
    for (int o = 1; o < 64; o <<= 1) {
#pragma unroll
        for (int r = 0; r < R; ++r) ss[r] += __shfl_xor(ss[r], o); }
    const f32x4* gr = (const f32x4*)g + 2 * lane;
#pragma unroll
    for (int j = 0; j < 4; ++j) { const f32x4 g0 = gr[128 * j], g1 = gr[128 * j + 1];
#pragma unroll
        for (int r = 0; r < R; ++r) { const float rstd = rsqrtf(ss[r] * (1.f / DM) + EPS); float v[8];
#pragma unroll
            for (int e = 0; e < 4; ++e) { v[2 * e] = __builtin_bit_cast(float, w[r][j][e] << 16) * rstd; v[2 * e + 1] = __builtin_bit_cast(float, w[r][j][e] & 0xffff0000u) * rstd; }
            if constexpr (OUT_F32) { f32x4* o4 = (f32x4*)((float*)O + (size_t)(m0 + r) * DM) + 2 * lane;
                o4[128 * j] = (f32x4){v[0] * g0.x, v[1] * g0.y, v[2] * g0.z, v[3] * g0.w}; o4[128 * j + 1] = (f32x4){v[4] * g1.x, v[5] * g1.y, v[6] * g1.z, v[7] * g1.w}; }
            else { v4u q; q.x = pk2(v[0] * g0.x, v[1] * g0.y); q.y = pk2(v[2] * g0.z, v[3] * g0.w); q.z = pk2(v[4] * g1.x, v[5] * g1.y); q.w = pk2(v[6] * g1.z, v[7] * g1.w);
                ((v4u*)((bf16r*)O + (size_t)(m0 + r) * DM) + lane)[64 * j] = q; } } }
}
__device__ __forceinline__ void rms_row_f32_inplace(float* xrow, const float* g, int lane) {
    f32x4* xr = (f32x4*)xrow + lane; const f32x4* gr = (const f32x4*)g + lane;
    f32x4 v[8]; float s = 0.f;
#pragma unroll
    for (int j = 0; j < 8; ++j) { v[j] = xr[64 * j]; s += (v[j].x * v[j].x + v[j].y * v[j].y) + (v[j].z * v[j].z + v[j].w * v[j].w); }
    const float rstd = rsqrtf(wave_sum(s) * (1.f / DM) + EPS);
#pragma unroll
    for (int j = 0; j < 8; ++j) { const f32x4 gg = gr[64 * j]; xr[64 * j] = (f32x4){v[j].x * rstd * gg.x, v[j].y * rstd * gg.y, v[j].z * rstd * gg.z, v[j].w * rstd * gg.w}; }
}

struct Args { const float* in[22]; float* out; unsigned char* ws; int ph_lo, ph_hi; };
typedef const __attribute__((address_space(4))) unsigned long long* karg_t;
__device__ __forceinline__ unsigned long long ldarg(int i) { karg_t p = (karg_t)__builtin_amdgcn_kernarg_segment_ptr(); asm volatile("" : "+s"(p) :: "memory"); return p[i]; }
#define GASP __attribute__((address_space(1)))
#define AIN(i) ((const float*)(GASP const float*)ldarg(i))
#define AOUT() ((float*)(GASP float*)ldarg(22))
#define AWS() ((unsigned char*)(GASP unsigned char*)ldarg(23))
#define WSP(off) ((bf16r*)(AWS() + (off)))

__global__ void __launch_bounds__(512) fwd_kernel(Args a) {
    extern __shared__ __attribute__((aligned(16))) unsigned char lds[];
    LAS unsigned char* ldsl = (LAS unsigned char*)lds;
    const int wave = __builtin_amdgcn_readfirstlane((int)threadIdx.x >> 6);
#define lane ((int)__builtin_amdgcn_mbcnt_hi(~0u, __builtin_amdgcn_mbcnt_lo(~0u, 0u)))
#define tid (wave * 64 + lane)
    const int G = gridDim.x, bx = blockIdx.x;
    const int gw = bx * 8 + wave, NGW = G * 8;
    const int lo = a.ph_lo, hi = a.ph_hi; int nbar = 0;
#define IN(k) (lo <= (k) && (k) < hi)
#define CBAR() do { asm volatile("s_waitcnt vmcnt(0)" ::: "memory"); ++nbar; __syncthreads(); \
            if (tid == 0) { unsigned* ctr = (unsigned*)AWS(); \
                __builtin_amdgcn_fence(__ATOMIC_RELEASE, "agent"); asm volatile("s_waitcnt vmcnt(0)" ::: "memory"); \
                __hip_atomic_fetch_add(ctr, 1u, __ATOMIC_RELAXED, __HIP_MEMORY_SCOPE_AGENT); \
                const unsigned target = (unsigned)nbar * (unsigned)G; \
                while (__hip_atomic_load(ctr, __ATOMIC_RELAXED, __HIP_MEMORY_SCOPE_AGENT) < target) __builtin_amdgcn_s_sleep(2); \
                __builtin_amdgcn_fence(__ATOMIC_ACQUIRE, "agent"); asm volatile("s_waitcnt vmcnt(0)" ::: "memory"); } \
            __syncthreads(); } while (0)
#define SEAM(k) do { if (IN(k) && IN((k) + 1)) { if ((k) == 0) { asm volatile("s_waitcnt vmcnt(0)" ::: "memory"); cg::this_grid().sync(); } else { CBAR(); } } } while (0)

    if (lo == 0 && hi > 1 && bx == 0 && tid == 0) __hip_atomic_store((unsigned*)AWS(), 0u, __ATOMIC_RELAXED, __HIP_MEMORY_SCOPE_AGENT);
    if (IN(0)) {
        unsigned char* const ws_ = AWS(); bf16r* const WIN = (bf16r*)(ws_ + WS_WIN); bf16r* const WO = (bf16r*)(ws_ + WS_WO); bf16r* const WQX = (bf16r*)(ws_ + WS_WQX); bf16r* const WKV = (bf16r*)(ws_ + WS_WKV); bf16r* const WOX = (bf16r*)(ws_ + WS_WOX); bf16r* const WGU = (bf16r*)(ws_ + WS_WGU); bf16r* const WDN = (bf16r*)(ws_ + WS_WDN); bf16r* const WPOOL = (bf16r*)(ws_ + WS_WPOOL); bf16r* const MN = (bf16r*)(ws_ + WS_MN); bf16r* const HN = (bf16r*)(ws_ + WS_HN);

        LAS float* scr = (LAS float*)(ldsl + wave * 16384);
        constexpr int I_IN = 32 * 128, I_SQ = 32 * 64, I_KV = 32 * 128, I_G = 32 * 176, I_DN = 88 * 64, I_P = 4 * 4 * 8;
        constexpr int NITEMS = I_IN + 3 * I_SQ + I_KV + 2 * I_G + I_DN + I_P;
        for (int it = gw; it < NITEMS; it += NGW) {
            int r = it;
            if (r < I_IN) { const int kb = r / 128, nb = r % 128; transpose_item(AIN(3), DIN, WIN, DM, 64 * kb, 32 * nb, 32 * nb, scr, lane); continue; } r -= I_IN;
            if (r < I_SQ) { const int kb = r / 64, nb = r % 64; transpose_item(AIN(11), DM, WO, DM, 64 * kb, 32 * nb, 32 * nb, scr, lane); continue; } r -= I_SQ;
            if (r < I_SQ) { const int kb = r / 64, nb = r % 64; transpose_item(AIN(14), DM, WQX, DM, 64 * kb, 32 * nb, 32 * nb, scr, lane); continue; } r -= I_SQ;
            if (r < I_KV) { const int kb = r / 128, nb = r % 128; transpose_item(AIN(15), 2 * DM, WKV, DM, 64 * kb, 32 * nb, 32 * nb, scr, lane); continue; } r -= I_KV;
            if (r < I_SQ) { const int kb = r / 64, nb = r % 64; transpose_item(AIN(16), DM, WOX, DM, 64 * kb, 32 * nb, 32 * nb, scr, lane); continue; } r -= I_SQ;
            if (r < I_G) { const int kb = r / 176, nb = r % 176, n0 = 32 * nb; transpose_item(AIN(18), DFF, WGU, DM, 64 * kb, n0, 256 * (n0 >> 7) + (n0 & 127), scr, lane); continue; } r -= I_G;
            if (r < I_G) { const int kb = r / 176, nb = r % 176, n0 = 32 * nb; transpose_item(AIN(19), DFF, WGU, DM, 64 * kb, n0, 256 * (n0 >> 7) + 128 + (n0 & 127), scr, lane); continue; } r -= I_G;
            if (r < I_DN) { const int kb = r / 64, nb = r % 64; transpose_item(AIN(20), DM, WDN, DFF, 64 * kb, 32 * nb, 32 * nb, scr, lane); continue; } r -= I_DN;
            { const int gidx = r / 32, q = r % 32, kb = q / 8, nb = q % 8; transpose_item(AIN(9) + (size_t)gidx * 65536, 256, WPOOL + (size_t)gidx * 65536, 256, 64 * kb, 32 * nb, 32 * nb, scr, lane); }
        }
        { const float* xin = AIN(0); const float* gin = AIN(2); for (int m = gw * 4; m < M; m += NGW * 4) rms_rows_f32_to_bf16<4>(xin, gin, HN, m, lane); }
        for (int m = gw; m < BATCH * MEM; m += NGW) rms_row_bf16(AIN(1) + (size_t)m * DM, AIN(13), MN + (size_t)m * DM, lane);
        __syncthreads();
    }
    SEAM(0);
    if (IN(1)) {
        unsigned char* const ws_ = AWS(); bf16r* const HN = (bf16r*)(ws_ + WS_HN); bf16r* const WIN = (bf16r*)(ws_ + WS_WIN); bf16r* const PROJ = (bf16r*)(ws_ + WS_PROJ);

        pg8::Gemm g{HN, WIN, DM, DM, DM, 1, 0, 0, 0, 0}; pg8::StaticOrder S; S.init(M, DIN, G, bx);
        pg8::EpiProj E{PROJ, PROJ + (size_t)192 * 1024 * 1024 / 2};
        pg8::gemm_phase<pg8::EpiProj, pg8::StaticOrder, true>(ldsl, ldsl + XL_OFF, g, S, E);
    }
    SEAM(1);
    if (IN(1) && IN(2)) { for (int ps_ = 0; ps_ < PROBE_SEAMS; ++ps_) CBAR(); }
    if (IN(2)) {
        unsigned char* const ws_ = AWS(); bf16r* const PROJ = (bf16r*)(ws_ + WS_PROJ); bf16r* const POOLED = (bf16r*)(ws_ + WS_POOLED); bf16r* const O16 = (bf16r*)(ws_ + WS_O16);

        {
            constexpr int RUN = 32;
            const int ntask = (M / RUN) * 128;
            for (int task = bx * 512 + tid; task < ntask; task += G * 512) {
                const int c8 = task & 127, token0 = (task >> 7) * RUN, t0 = token0 & (SEQ - 1);
                const int wl = 2 << (c8 >> 5);
                const bf16r* up = PROJ + (size_t)192 * 1024 * 1024 / 2 + (size_t)token0 * 1024 + c8 * 8;
                bf16r* op = POOLED + (size_t)token0 * 1024 + c8 * 8;
                float sacc[8];
#pragma unroll
                for (int e = 0; e < 8; ++e) sacc[e] = 0.f;
                for (int j = 1; j < wl; ++j) if (t0 - j >= 0) { const v4u w = *(const v4u*)(up - (size_t)j * 1024);
#pragma unroll
                    for (int e = 0; e < 4; ++e) { sacc[2 * e] += __builtin_bit_cast(float, w[e] << 16); sacc[2 * e + 1] += __builtin_bit_cast(float, w[e] & 0xffff0000u); } }
#pragma unroll 4
                for (int i = 0; i < RUN; ++i) {
                    const v4u w = *(const v4u*)(up + (size_t)i * 1024);
                    const int t = t0 + i; const bool full = (t + 1 >= wl);
                    const v4u wo = *(const v4u*)(up + (size_t)(full ? i - (wl - 1) : i) * 1024);
                    float u0[8];
#pragma unroll
                    for (int e = 0; e < 4; ++e) { u0[2 * e] = __builtin_bit_cast(float, w[e] << 16); u0[2 * e + 1] = __builtin_bit_cast(float, w[e] & 0xffff0000u); }
#pragma unroll
                    for (int e = 0; e < 8; ++e) sacc[e] += u0[e];
                    const float ic = 1.0f / (float)(full ? wl : t + 1);
                    v4u o;
#pragma unroll
                    for (int e = 0; e < 4; ++e) o[e] = pk2(sacc[2 * e] * ic - u0[2 * e], sacc[2 * e + 1] * ic - u0[2 * e + 1]);
                    *(v4u*)(op + (size_t)i * 1024) = o;
                    if (full) {
#pragma unroll
                        for (int e = 0; e < 4; ++e) { sacc[2 * e] -= __builtin_bit_cast(float, wo[e] << 16); sacc[2 * e + 1] -= __builtin_bit_cast(float, wo[e] & 0xffff0000u); } }
                }
            }
        }
        __syncthreads();
        { const float* lq1 = AIN(4); const float* lk1 = AIN(5); const float* lq2 = AIN(6); const float* lk2 = AIN(7);
          const float s1 = wave_sum(lq1[lane] * lk1[lane] + lq1[lane + 64] * lk1[lane + 64]);
          const float s2 = wave_sum(lq2[lane] * lk2[lane] + lq2[lane + 64] * lk2[lane + 64]);
          const float lam = __expf(s1) - __expf(s2) + LAM_INIT;
          att2::attn_phase2((char*)lds, (const att::bf16*)PROJ, (att::bf16*)O16, (att::bf16*)(ws_ + WS_CONCAT), lam, AIN(8), G, bx, wave); }
        __syncthreads();
    }
    SEAM(2);
    if (IN(3)) {
        unsigned char* const ws_ = AWS(); bf16r* const O16 = (bf16r*)(ws_ + WS_O16); bf16r* const CONCAT = (bf16r*)(ws_ + WS_CONCAT); bf16r* const POOLED = (bf16r*)(ws_ + WS_POOLED); bf16r* const WPOOL = (bf16r*)(ws_ + WS_WPOOL); bf16r* const MN = (bf16r*)(ws_ + WS_MN); bf16r* const WKV = (bf16r*)(ws_ + WS_WKV); bf16r* const KX = (bf16r*)(ws_ + WS_KX); bf16r* const VXT = (bf16r*)(ws_ + WS_VXT);

        {
            pg8::Gemm g{POOLED, WPOOL, 1024, 256, 256, 1, 256, 0, 65536, 0}; pg8::BatchOrder S; S.init(M, 256, 4, G, bx);
            pg8::EpiBf16 E{CONCAT + 1024, DM, 1, 256, 0, AIN(10), 256};
            pg8::gemm_phase<pg8::EpiBf16, pg8::BatchOrder, true>(ldsl, ldsl + XL_OFF, g, S, E);
        }
        {
            pg8::Gemm g{MN, WKV, DM, DM, DM, 1, 0, 0, 0, 0}; pg8::StaticOrder S; S.init(BATCH * MEM, DM, G, bx);
            pg8::EpiBf16 E{KX, DM, 1, 0, 0, nullptr, 0};
            pg8::gemm_phase<pg8::EpiBf16, pg8::StaticOrder, true>(ldsl, ldsl + XL_OFF, g, S, E);
        }
        {
            pg8::Gemm g{WKV + (size_t)DM * DM, MN, DM, DM, DM, 1, 0, 0, 0, 0}; pg8::StaticOrder S; S.init(DM, BATCH * MEM, G, G - 1 - bx);
            pg8::EpiBf16 E{VXT, BATCH * MEM, 1, 0, 0, nullptr, 0};
            pg8::gemm_phase<pg8::EpiBf16, pg8::StaticOrder, true>(ldsl, ldsl + XL_OFF, g, S, E);
        }
    }
    SEAM(3);
    if (IN(4)) {
        unsigned char* const ws_ = AWS(); bf16r* const CONCAT = (bf16r*)(ws_ + WS_CONCAT); bf16r* const WO = (bf16r*)(ws_ + WS_WO); float* const xres = AOUT();

        pg8::Gemm g{CONCAT, WO, DM, DM, DM, 1, 0, 0, 0, 0}; pg8::StaticOrder S; S.init(M, DM, G, bx);
        pg8::EpiResX<false, true> E{AIN(0), ws_ + WS_XB, DM};
        pg8::gemm_phase<pg8::EpiResX<false, true>, pg8::StaticOrder, true>(ldsl, ldsl + XL_OFF, g, S, E);
    }
    SEAM(4);
    if (IN(5)) {
        unsigned char* const ws_ = AWS(); bf16r* const HN = (bf16r*)(ws_ + WS_HN); float* const xres = AOUT();
 { const float* gin = AIN(12); for (int m = gw * 4; m < M; m += NGW * 4) rms_rows_bf16<4, false>((const bf16r*)(ws_ + WS_XB), gin, HN, m, lane); } }
    SEAM(5);
    if (IN(6)) {
        unsigned char* const ws_ = AWS(); bf16r* const HN = (bf16r*)(ws_ + WS_HN); bf16r* const WQX = (bf16r*)(ws_ + WS_WQX); bf16r* const QX = (bf16r*)(ws_ + WS_QX);

        pg8::Gemm g{HN, WQX, DM, DM, DM, 1, 0, 0, 0, 0}; pg8::StaticOrder S; S.init(M, DM, G, bx);
        pg8::EpiBf16 E{QX, DM, 1, 0, 0, nullptr, 0};
        pg8::gemm_phase<pg8::EpiBf16, pg8::StaticOrder, true>(ldsl, ldsl + XL_OFF, g, S, E);
    }
    SEAM(6);
    if (IN(7)) {
        unsigned char* const ws_ = AWS(); bf16r* const QX = (bf16r*)(ws_ + WS_QX); bf16r* const KX = (bf16r*)(ws_ + WS_KX); bf16r* const PSC = (bf16r*)(ws_ + WS_PSC);

        pg8::Gemm g{QX, KX, DM, DM, 512, 4, (long)SEQ * DM, 512, (long)MEM * DM, 512}; pg8::BatchOrder S; S.init(SEQ, MEM, 8, G, bx);
        pg8::EpiSoftmax E{PSC, (long)SEQ * MEM, 0.044194173824159216f * 1.4426950408889634f};
        pg8::gemm_phase<pg8::EpiSoftmax, pg8::BatchOrder, true>(ldsl, ldsl + XL_OFF, g, S, E);
    }
    SEAM(7);
    if (IN(8)) {
        unsigned char* const ws_ = AWS(); bf16r* const PSC = (bf16r*)(ws_ + WS_PSC); bf16r* const VXT = (bf16r*)(ws_ + WS_VXT); bf16r* const OX = (bf16r*)(ws_ + WS_OX);

        pg8::Gemm g{PSC, VXT, MEM, BATCH * MEM, MEM, 4, (long)4 * SEQ * MEM, (long)SEQ * MEM, MEM, (long)512 * (BATCH * MEM)}; pg8::BatchOrder S; S.init(SEQ, 512, 8, G, bx);
        pg8::EpiBf16 E{OX, DM, 4, (long)SEQ * DM, 512, nullptr, 0};
        pg8::gemm_phase<pg8::EpiBf16, pg8::BatchOrder, true>(ldsl, ldsl + XL_OFF, g, S, E);
    }
    SEAM(8);
    if (IN(9)) {
        unsigned char* const ws_ = AWS(); bf16r* const OX = (bf16r*)(ws_ + WS_OX); bf16r* const WOX = (bf16r*)(ws_ + WS_WOX); float* const xres = AOUT();

        pg8::Gemm g{OX, WOX, DM, DM, DM, 1, 0, 0, 0, 0}; pg8::StaticOrder S; S.init(M, DM, G, bx);
        pg8::EpiResX<true, true> E{ws_ + WS_XB, ws_ + WS_XB, DM};
        pg8::gemm_phase<pg8::EpiResX<true, true>, pg8::StaticOrder, true>(ldsl, ldsl + XL_OFF, g, S, E);
    }
    SEAM(9);
    if (IN(10)) {
        unsigned char* const ws_ = AWS(); bf16r* const HN = (bf16r*)(ws_ + WS_HN); float* const xres = AOUT();
 { const float* gin = AIN(17); for (int m = gw * 4; m < M; m += NGW * 4) rms_rows_bf16<4, false>((const bf16r*)(ws_ + WS_XB), gin, HN, m, lane); } }
    SEAM(10);
    if (IN(11)) {
        unsigned char* const ws_ = AWS(); bf16r* const HN = (bf16r*)(ws_ + WS_HN); bf16r* const WGU = (bf16r*)(ws_ + WS_WGU); bf16r* const HID = (bf16r*)(ws_ + WS_HID);

        pg8::Gemm g{HN, WGU, DM, DM, DM, 1, 0, 0, 0, 0}; pg8::StaticOrder S; S.init(M, 2 * DFF, G, bx);
        pg8::EpiSwiGLU E{HID, DFF};
        pg8::gemm_phase<pg8::EpiSwiGLU, pg8::StaticOrder, true>(ldsl, ldsl + XL_OFF, g, S, E);
    }
    SEAM(11);
    if (IN(12)) {
        unsigned char* const ws_ = AWS(); bf16r* const HID = (bf16r*)(ws_ + WS_HID); bf16r* const WDN = (bf16r*)(ws_ + WS_WDN); float* const xres = AOUT();

        pg8::Gemm g{HID, WDN, DFF, DFF, DFF, 1, 0, 0, 0, 0}; pg8::StaticOrder S; S.init(M, DM, G, bx);
        pg8::EpiResX<true, true> E{ws_ + WS_XB, ws_ + WS_XB, DM};
        pg8::gemm_phase<pg8::EpiResX<true, true>, pg8::StaticOrder, true>(ldsl, ldsl + XL_OFF, g, S, E);
    }
    SEAM(12);
    if (IN(13)) {
        unsigned char* const ws_ = AWS(); float* const xres = AOUT();
 { const float* gin = AIN(21); for (int m = gw * 4; m < M; m += NGW * 4) rms_rows_bf16<4, true>((const bf16r*)(ws_ + WS_XB), gin, xres, m, lane); } }
#undef IN
#undef SEAM
#undef lane
#undef tid
}

extern "C" void kernel_launch(void* const* d_in, const int* in_sizes, int n_in, void* d_out, int out_size, void* d_ws, size_t ws_size, hipStream_t stream) {
    static int grid = 0;
    if (grid == 0) {
        if (n_in != 22 || in_sizes[0] != M * DM || out_size != M * DM || ws_size < WS_END) {
            fprintf(stderr, "kernel_launch: unexpected shapes n_in %d in0 %d out %d ws %zu (need %zu)\n", n_in, n_in > 0 ? in_sizes[0] : -1, out_size, ws_size, (size_t)WS_END); grid = -1; return; }
        int dev = 0, cus = 0, per_cu = 0;
        (void)hipGetDevice(&dev); (void)hipDeviceGetAttribute(&cus, hipDeviceAttributeMultiprocessorCount, dev);
        if (hipFuncSetAttribute((const void*)fwd_kernel, hipFuncAttributeMaxDynamicSharedMemorySize, LDS_BYTES) != hipSuccess) { fprintf(stderr, "kernel_launch: hipFuncSetAttribute failed\n"); grid = -1; return; }
        if (hipOccupancyMaxActiveBlocksPerMultiprocessor(&per_cu, (const void*)fwd_kernel, 512, LDS_BYTES) != hipSuccess || per_cu < 1) { fprintf(stderr, "kernel_launch: occupancy query gave %d\n", per_cu); per_cu = 1; }
        (void)hipGetLastError();
        if (cus <= 0) cus = 256;
        grid = cus * per_cu;
        if (grid > 256) grid = 256;
    }
    if (grid < 0) return;
    Args a{};
    for (int i = 0; i < 22; ++i) a.in[i] = (const float*)d_in[i];
    a.out = (float*)d_out; a.ws = (unsigned char*)d_ws;
#if MK_PER_PHASE
    for (int p = 0; p < NPHASE; ++p) { a.ph_lo = p; a.ph_hi = p + 1; hipLaunchKernelGGL(fwd_kernel, dim3(grid), dim3(512), LDS_BYTES, stream, a); }
#else
    const int cuts[4] = {0, PROBE_DUP >= 0 ? PROBE_DUP + 1 : NPHASE, PROBE_DUP >= 0 ? PROBE_DUP + 1 : NPHASE, NPHASE};
    for (int li = 0; li < (PROBE_DUP >= 0 ? 3 : 1); ++li) {
        a.ph_lo = cuts[li]; a.ph_hi = cuts[li + 1];
        if (PROBE_DUP >= 0 && li == 1) { a.ph_lo = PROBE_DUP; a.ph_hi = PROBE_DUP + 1; }
        if (!(a.ph_lo == 0 && a.ph_hi > 1)) (void)hipMemsetAsync(d_ws, 0, 256, stream);
        void* args[] = {&a};
        hipError_t e = hipLaunchCooperativeKernel((const void*)fwd_kernel, dim3(grid), dim3(512), args, LDS_BYTES, stream);
        if (e != hipSuccess) fprintf(stderr, "cooperative launch failed: %s (grid %d)\n", hipGetErrorString(e), grid);
    }
#endif
}
```

```cpp
#include <hip/hip_runtime.h>
#include <hip/hip_bf16.h>
#include <hip/hip_cooperative_groups.h>
#include <cstdio>
#include <cstdint>
namespace cg = cooperative_groups;

#ifndef PROBE_DUP
#define PROBE_DUP -1
#endif
#ifndef PROBE_SEAMS
#define PROBE_SEAMS 0
#endif
#ifndef MK_PER_PHASE
#define MK_PER_PHASE 0
#endif

constexpr int BATCH = 2, SEQ = 16384, DM = 2048, MEM = 256, DIN = 4096, DFF = 5632;
constexpr int M = BATCH * SEQ;
constexpr float EPS = 1e-6f;
constexpr float LAM_INIT = 0.2f;

namespace pg8 {
#define PG8_LAS __attribute__((address_space(3)))
typedef unsigned short bf16_t;
typedef short bf16x8 __attribute__((ext_vector_type(8)));
typedef float f32x4 __attribute__((ext_vector_type(4)));
typedef unsigned u32x4 __attribute__((ext_vector_type(4)));
constexpr int BM = 256, BK = 64, HALF = 128, HTB = HALF * BK * 2, STAGE_BYTES = 8 * HTB, NXCD = 8, WGM = 8;

__host__ __device__ __forceinline__ int lds_byte(int r, int c) { const int st = (r >> 4) * 2 + (c >> 5), rr = r & 15, cc = c & 31, ob = rr * 64 + cc * 2; return st * 1024 + (ob ^ (((ob >> 9) & 1) << 5)); }
__host__ __device__ __forceinline__ void stage_rc(int b, int& R, int& C) { const int st = b / 1024, sb = b % 1024, swz = sb ^ (((sb >> 9) & 1) << 5); R = (st >> 1) * 16 + swz / 64; C = (st & 1) * 32 + (swz % 64) / 2; }
__host__ __device__ __forceinline__ int perm32(int rho) { const int n = rho >> 4, i = rho & 15; return 8 * (i >> 2) + 4 * n + (i & 3); }

struct Unit { int pm, pn, z; };
struct Gemm { const bf16_t* A; const bf16_t* Bt; int lda, ldb, K, ZH; long sAb, sAh, sBb, sBh; };

struct StaticOrder {
    int nM, nN, nwg, G, c;
    __device__ void init(int Mr, int N, int G_, int c_) { nM = Mr / BM; nN = N / BM; nwg = nM * nN; G = G_; c = c_; }
    __device__ bool next(int i, Unit& u) const {
        const long L = (long)i * G + c; if (L >= nwg) return false;
        int wgid = (int)L; { const int q = nwg / NXCD, r = nwg % NXCD, xcd = wgid % NXCD, off = wgid / NXCD; wgid = (xcd < r ? xcd * (q + 1) : r * (q + 1) + (xcd - r) * q) + off; }
        const int nig = WGM * nN, gid = wgid / nig, fm = gid * WGM, gsz = (nM - fm) < WGM ? (nM - fm) : WGM;
        u.pm = fm + ((wgid % nig) % gsz); u.pn = (wgid % nig) / gsz; u.z = 0; return true;
    }
};
struct StaticOrderZ : StaticOrder {
    int zdiv;
    __device__ bool next(int i, Unit& u) const { if (!StaticOrder::next(i, u)) return false; u.z = u.pm / zdiv; return true; }
};
struct BatchOrder {
    int nM, nN, nwg, G, c;
    __device__ void init(int Mr, int N, int Z, int G_, int c_) { nM = Mr / BM; nN = N / BM; nwg = nM * nN * Z; G = G_; c = c_; }
    __device__ bool next(int i, Unit& u) const {
        const long L = (long)i * G + c; if (L >= nwg) return false;
        int l = (int)L; u.pn = l % nN; l /= nN; u.pm = l % nM; u.z = l / nM; return true;
    }
};

__device__ __forceinline__ unsigned cvt_pk_bf16(float lo, float hi) { unsigned r; asm volatile("v_cvt_pk_bf16_f32 %0, %1, %2" : "=v"(r) : "v"(lo), "v"(hi)); return r; }

typedef f32x4 Acc[2][2][4][2];

struct EpiBf16 {
    static constexpr bool PERM = true;
    bf16_t* O; int ldc, ZH; long sOb, sOh; const float* cscale; int nsc;
    __device__ __forceinline__ void operator()(Acc& acc, const Unit& u, int wr, int wc, int fr, int fq, PG8_LAS unsigned char*) const {
        const int row0 = u.pm * BM + wr * 64 + fr, col0 = u.pn * BM + wc * 32 + 8 * fq;
        bf16_t* base = O + (size_t)(u.z / ZH) * sOb + (size_t)(u.z % ZH) * sOh;
        f32x4 sv[2][2];
#pragma unroll
        for (int bj = 0; bj < 2; ++bj)
#pragma unroll
            for (int n = 0; n < 2; ++n) sv[bj][n] = cscale ? *(const f32x4*)(cscale + (size_t)u.z * nsc + col0 + bj * HALF + 4 * n) : (f32x4){1.f, 1.f, 1.f, 1.f};
#pragma unroll
        for (int ai = 0; ai < 2; ++ai)
#pragma unroll
            for (int m = 0; m < 4; ++m) { bf16_t* rowp = base + (size_t)(row0 + ai * HALF + m * 16) * ldc + col0;
#pragma unroll
                for (int bj = 0; bj < 2; ++bj) { f32x4 v0 = acc[ai][bj][m][0] * sv[bj][0], v1 = acc[ai][bj][m][1] * sv[bj][1];
                    u32x4 w; w.x = cvt_pk_bf16(v0[0], v0[1]); w.y = cvt_pk_bf16(v0[2], v0[3]); w.z = cvt_pk_bf16(v1[0], v1[1]); w.w = cvt_pk_bf16(v1[2], v1[3]);
                    *(u32x4*)(rowp + bj * HALF) = w; } }
    }
};
template <bool BASE_BF16, bool OUT_BF16> struct EpiResX {
    static constexpr bool PERM = true;
    const void* base; void* out; int ldc;
    __device__ __forceinline__ void operator()(Acc& acc, const Unit& u, int wr, int wc, int fr, int fq, PG8_LAS unsigned char*) const {
        const int col0 = u.pn * BM + wc * 32 + 8 * fq;
#pragma unroll
        for (int ai = 0; ai < 2; ++ai)
#pragma unroll
            for (int m = 0; m < 4; ++m) { const int r = ai * HALF + wr * 64 + m * 16 + fr; const size_t off = (size_t)(u.pm * BM + r) * ldc + col0;
                f32x4 bs[2][2];
#pragma unroll
                for (int bj = 0; bj < 2; ++bj) {
                    if constexpr (BASE_BF16) { const u32x4 w = *(const u32x4*)((const bf16_t*)base + off + bj * HALF);
                        bs[bj][0] = (f32x4){__builtin_bit_cast(float, w.x << 16), __builtin_bit_cast(float, w.x & 0xffff0000u), __builtin_bit_cast(float, w.y << 16), __builtin_bit_cast(float, w.y & 0xffff0000u)};
                        bs[bj][1] = (f32x4){__builtin_bit_cast(float, w.z << 16), __builtin_bit_cast(float, w.z & 0xffff0000u), __builtin_bit_cast(float, w.w << 16), __builtin_bit_cast(float, w.w & 0xffff0000u)}; }
                    else { bs[bj][0] = *(const f32x4*)((const float*)base + off + bj * HALF); bs[bj][1] = *(const f32x4*)((const float*)base + off + bj * HALF + 4); } }
#pragma unroll
                for (int bj = 0; bj < 2; ++bj) { const f32x4 v0 = bs[bj][0] + acc[ai][bj][m][0], v1 = bs[bj][1] + acc[ai][bj][m][1];
                    if constexpr (OUT_BF16) { u32x4 w; w.x = cvt_pk_bf16(v0[0], v0[1]); w.y = cvt_pk_bf16(v0[2], v0[3]); w.z = cvt_pk_bf16(v1[0], v1[1]); w.w = cvt_pk_bf16(v1[2], v1[3]);
                        *(u32x4*)((bf16_t*)out + off + bj * HALF) = w; }
                    else { *(f32x4*)((float*)out + off + bj * HALF) = v0; *(f32x4*)((float*)out + off + bj * HALF + 4) = v1; } }
                asm volatile("" ::: "memory"); }
    }
};
struct EpiProj {
    static constexpr bool PERM = true;
    bf16_t* QKVH; bf16_t* U;
    __device__ __forceinline__ void operator()(Acc& acc, const Unit& u, int wr, int wc, int fr, int fq, PG8_LAS unsigned char*) const {
        const int row0 = u.pm * BM + wr * 64 + fr, b = (u.pm * BM) / SEQ, s0 = row0 - b * SEQ, cin = wc * 32 + 8 * fq;
#pragma unroll
        for (int ai = 0; ai < 2; ++ai)
#pragma unroll
            for (int m = 0; m < 4; ++m) {
#pragma unroll
                for (int bj = 0; bj < 2; ++bj) { const f32x4 v0 = acc[ai][bj][m][0], v1 = acc[ai][bj][m][1];
                    u32x4 w; w.x = cvt_pk_bf16(v0[0], v0[1]); w.y = cvt_pk_bf16(v0[2], v0[3]); w.z = cvt_pk_bf16(v1[0], v1[1]); w.w = cvt_pk_bf16(v1[2], v1[3]);
                    bf16_t* dst = (u.pn < 12) ? QKVH + ((size_t)(b * 24 + u.pn * 2 + bj) * SEQ + (s0 + ai * HALF + m * 16)) * 128 + cin
                                              : U + (size_t)(row0 + ai * HALF + m * 16) * 1024 + (u.pn - 12) * 256 + bj * HALF + cin;
                    *(u32x4*)dst = w; } }
    }
};
struct EpiResF32 {
    static constexpr bool PERM = false;
    const float* base; float* out; int ldc;
    __device__ __forceinline__ void operator()(Acc& acc, const Unit& u, int wr, int wc, int fr, int fq, PG8_LAS unsigned char*) const {
        const int col0 = u.pn * BM + wc * 32 + 4 * fq;
#pragma unroll
        for (int ai = 0; ai < 2; ++ai)
#pragma unroll
            for (int m = 0; m < 4; ++m) { const int r = ai * HALF + wr * 64 + m * 16 + fr; const size_t off = (size_t)(u.pm * BM + r) * ldc + col0;
                f32x4 bs[2][2];
#pragma unroll
                for (int bj = 0; bj < 2; ++bj)
#pragma unroll
                    for (int n = 0; n < 2; ++n) bs[bj][n] = *(const f32x4*)(base + off + bj * HALF + n * 16);
#pragma unroll
                for (int bj = 0; bj < 2; ++bj)
#pragma unroll
                    for (int n = 0; n < 2; ++n) *(f32x4*)(out + off + bj * HALF + n * 16) = bs[bj][n] + acc[ai][bj][m][n];
                asm volatile("" ::: "memory"); }
    }
};
struct EpiSwiGLU {
    static constexpr bool PERM = true;
    bf16_t* O; int ldc;
    __device__ __forceinline__ void operator()(Acc& acc, const Unit& u, int wr, int wc, int fr, int fq, PG8_LAS unsigned char*) const {
        const int row0 = u.pm * BM + wr * 64 + fr, col0 = u.pn * HALF + wc * 32 + 8 * fq;
#pragma unroll
        for (int ai = 0; ai < 2; ++ai)
#pragma unroll
            for (int m = 0; m < 4; ++m) { bf16_t* rowp = O + (size_t)(row0 + ai * HALF + m * 16) * ldc + col0;
                float h[8];
#pragma unroll
                for (int n = 0; n < 2; ++n)
#pragma unroll
                    for (int e = 0; e < 4; ++e) { const float gt = acc[ai][0][m][n][e], up = acc[ai][1][m][n][e];
                        const float sg = __builtin_amdgcn_rcpf(1.f + __builtin_amdgcn_exp2f(-1.4426950408889634f * gt));
                        h[n * 4 + e] = gt * sg * up; }
                u32x4 w; w.x = cvt_pk_bf16(h[0], h[1]); w.y = cvt_pk_bf16(h[2], h[3]); w.z = cvt_pk_bf16(h[4], h[5]); w.w = cvt_pk_bf16(h[6], h[7]);
                *(u32x4*)rowp = w; }
    }
};
struct EpiSoftmax {
    static constexpr bool PERM = true;
    bf16_t* O; long sOz; float sc2; int ldc;
    __device__ __forceinline__ void operator()(Acc& acc, const Unit& u, int wr, int wc, int fr, int fq, PG8_LAS unsigned char* xl) const {
        PG8_LAS float* MX = (PG8_LAS float*)xl;
        PG8_LAS float* SMv = (PG8_LAS float*)(xl + 4096);
#pragma unroll
        for (int ai = 0; ai < 2; ++ai)
#pragma unroll
            for (int m = 0; m < 4; ++m) { float mx = -3.0e38f;
#pragma unroll
                for (int bj = 0; bj < 2; ++bj)
#pragma unroll
                    for (int n = 0; n < 2; ++n) { f32x4 s = acc[ai][bj][m][n] * sc2; acc[ai][bj][m][n] = s; mx = fmaxf(mx, fmaxf(fmaxf(s[0], s[1]), fmaxf(s[2], s[3]))); }
                mx = fmaxf(mx, __shfl_xor(mx, 16)); mx = fmaxf(mx, __shfl_xor(mx, 32));
                if (fq == 0) MX[(ai * HALF + wr * 64 + m * 16 + fr) * 4 + wc] = mx; }
        asm volatile("s_waitcnt lgkmcnt(0)" ::: "memory"); __builtin_amdgcn_s_barrier(); asm volatile("" ::: "memory");
#pragma unroll
        for (int ai = 0; ai < 2; ++ai)
#pragma unroll
            for (int m = 0; m < 4; ++m) { const int r = ai * HALF + wr * 64 + m * 16 + fr;
                const f32x4 q = *(const PG8_LAS f32x4*)(MX + r * 4); const float rm = fmaxf(fmaxf(q[0], q[1]), fmaxf(q[2], q[3]));
                float sm = 0.f;
#pragma unroll
                for (int bj = 0; bj < 2; ++bj)
#pragma unroll
                    for (int n = 0; n < 2; ++n) { f32x4 s = acc[ai][bj][m][n];
#pragma unroll
                        for (int e = 0; e < 4; ++e) { s[e] = __builtin_amdgcn_exp2f(s[e] - rm); sm += s[e]; }
                        acc[ai][bj][m][n] = s; }
                sm += __shfl_xor(sm, 16); sm += __shfl_xor(sm, 32);
                if (fq == 0) SMv[r * 4 + wc] = sm; }
        asm volatile("s_waitcnt lgkmcnt(0)" ::: "memory"); __builtin_amdgcn_s_barrier(); asm volatile("" ::: "memory");
        const int row0 = u.pm * BM + wr * 64 + fr, col0 = wc * 32 + 8 * fq;
        bf16_t* base = O + (size_t)u.z * sOz;
#pragma unroll
        for (int ai = 0; ai < 2; ++ai)
#pragma unroll
            for (int m = 0; m < 4; ++m) { const int r = ai * HALF + wr * 64 + m * 16 + fr;
                const f32x4 q = *(const PG8_LAS f32x4*)(SMv + r * 4); const float inv = 1.0f / ((q[0] + q[1]) + (q[2] + q[3]));
                bf16_t* rowp = base + (size_t)(row0 + ai * HALF + m * 16) * ldc + u.pn * BM + col0;
#pragma unroll
                for (int bj = 0; bj < 2; ++bj) { const f32x4 v0 = acc[ai][bj][m][0] * inv, v1 = acc[ai][bj][m][1] * inv;
                    u32x4 w; w.x = cvt_pk_bf16(v0[0], v0[1]); w.y = cvt_pk_bf16(v0[2], v0[3]); w.z = cvt_pk_bf16(v1[0], v1[1]); w.w = cvt_pk_bf16(v1[2], v1[3]);
                    *(u32x4*)(rowp + bj * HALF) = w; } }
    }
};

template <class Epi, class Sched, bool ALIGN_EPI>
__device__ __forceinline__ void gemm_phase(PG8_LAS unsigned char* lds, PG8_LAS unsigned char* xl, const Gemm g, const Sched& S, const Epi& E) {
    const int tid = threadIdx.x, wid = __builtin_amdgcn_readfirstlane(tid >> 6), lane = tid & 63, wr = wid >> 2, wc = wid & 3, fr = lane & 15, fq = lane >> 4;
    const int K = g.K, nt = K / BK;
    unsigned voffA[2], voffB[2];
#pragma unroll
    for (int i = 0; i < 2; ++i) { int R, C; stage_rc(tid * 16 + i * 8192, R, C); const int Rb = Epi::PERM ? ((R & ~31) + perm32(R & 31)) : R;
        voffA[i] = (unsigned)(R * g.lda + C) * 2u; voffB[i] = (unsigned)(Rb * g.ldb + C) * 2u; }
    const size_t kstep = (size_t)(BK * 2);
    const size_t hstepA = (size_t)HALF * g.lda * 2, hstepB = (size_t)HALF * g.ldb * 2;
    const unsigned ldsw = (unsigned)wid * 1024u;
    const int aoff = lds_byte(wr * 64 + fr, fq * 8), boff = lds_byte(wc * 32 + fr, fq * 8);
#define PG8_APTR(u_) ((const char*)g.A + 2 * ((size_t)((u_).z / g.ZH) * g.sAb + (size_t)((u_).z % g.ZH) * g.sAh) + (size_t)(u_).pm * 2 * hstepA)
#define PG8_BPTR(u_) ((const char*)g.Bt + 2 * ((size_t)((u_).z / g.ZH) * g.sBb + (size_t)((u_).z % g.ZH) * g.sBh) + (size_t)(u_).pn * 2 * hstepB)
#define PG8_SA(b, h) (((b) * 2 + (h)) * HTB)
#define PG8_SB(b, h) ((4 + (b) * 2 + (h)) * HTB)
#define PG8_STAGE(bufoff, gbase, voff) do { _Pragma("unroll") for (int _i = 0; _i < 2; ++_i) \
        __builtin_amdgcn_global_load_lds((const unsigned*)((const char*)(gbase) + (voff)[_i]), (PG8_LAS unsigned*)(lds + (bufoff) + ldsw + _i * 8192), 16, 0, 0); } while (0)
#define PG8_LDA(dst, b, h) do { _Pragma("unroll") for (int m = 0; m < 4; ++m) _Pragma("unroll") for (int k = 0; k < 2; ++k) dst[m][k] = *(const PG8_LAS bf16x8*)(lds + PG8_SA(b, h) + aoff + m * 2048 + k * 1024); } while (0)
#define PG8_LDB(dst, b, h) do { _Pragma("unroll") for (int n = 0; n < 2; ++n) _Pragma("unroll") for (int k = 0; k < 2; ++k) dst[n][k] = *(const PG8_LAS bf16x8*)(lds + PG8_SB(b, h) + boff + n * 2048 + k * 1024); } while (0)
#define PG8_MMA(ai, bj, At, Bt) do { __builtin_amdgcn_s_setprio(1); _Pragma("unroll") for (int m = 0; m < 4; ++m) _Pragma("unroll") for (int n = 0; n < 2; ++n) _Pragma("unroll") for (int k = 0; k < 2; ++k) \
        acc[ai][bj][m][n] = __builtin_amdgcn_mfma_f32_16x16x32_bf16(Bt[n][k], At[m][k], acc[ai][bj][m][n], 0, 0, 0); __builtin_amdgcn_s_setprio(0); } while (0)
#define PG8_WAIT_V(n) asm volatile("s_waitcnt vmcnt(" #n ")" ::: "memory")
#define PG8_WAIT_L(n) asm volatile("s_waitcnt lgkmcnt(" #n ")" ::: "memory")
#define PG8_BAR __builtin_amdgcn_s_barrier()
#define PG8_SCHED __builtin_amdgcn_sched_barrier(0)
    Unit cur, nxt; int ui = 0;
    if (!S.next(0, cur)) return;
    Acc acc;
#pragma unroll
    for (int a = 0; a < 2; ++a)
#pragma unroll
        for (int b = 0; b < 2; ++b)
#pragma unroll
            for (int m = 0; m < 4; ++m)
#pragma unroll
                for (int n = 0; n < 2; ++n) acc[a][b][m][n] = (f32x4){0.f, 0.f, 0.f, 0.f};
    bf16x8 At[4][2], B0[2][2], B1[2][2];
    const char* cA = PG8_APTR(cur); const char* cB = PG8_BPTR(cur);
    PG8_STAGE(PG8_SB(0, 0), cB, voffB); PG8_STAGE(PG8_SB(0, 1), cB + hstepB, voffB); PG8_STAGE(PG8_SA(0, 0), cA, voffA); PG8_STAGE(PG8_SA(0, 1), cA + hstepA, voffA);
    if (wr == 1) PG8_BAR;
    PG8_WAIT_V(2); PG8_BAR;
    PG8_STAGE(PG8_SB(1, 0), cB + kstep, voffB); PG8_STAGE(PG8_SA(1, 0), cA + kstep, voffA); PG8_STAGE(PG8_SB(1, 1), cB + hstepB + kstep, voffB);
    PG8_WAIT_V(6); PG8_BAR;
    for (;;) {
        const bool has_next = S.next(ui + 1, nxt);
        const char* nA = has_next ? PG8_APTR(nxt) : cA; const char* nB = has_next ? PG8_BPTR(nxt) : cB;
        for (int t = 0; t < nt; t += 2) {
            const bool last = (t == nt - 2);
            const char* a1 = cA + (size_t)(t + 1) * kstep;
            const char* a2 = last ? nA : cA + (size_t)(t + 2) * kstep; const char* b2 = last ? nB : cB + (size_t)(t + 2) * kstep;
            const char* a3 = a2 + kstep; const char* b3 = b2 + kstep;
            PG8_LDB(B0, 0, 0); PG8_LDB(B1, 0, 1); PG8_SCHED; PG8_LDA(At, 0, 0); PG8_STAGE(PG8_SA(1, 1), a1 + hstepA, voffA);
            PG8_WAIT_V(8); PG8_WAIT_L(0); PG8_BAR; PG8_MMA(0, 0, At, B0); PG8_MMA(0, 1, At, B1); PG8_BAR; PG8_SCHED;
            PG8_LDA(At, 0, 1); PG8_STAGE(PG8_SB(0, 0), b2, voffB); PG8_STAGE(PG8_SB(0, 1), b2 + hstepB, voffB); PG8_STAGE(PG8_SA(0, 0), a2, voffA);
            PG8_WAIT_V(8); PG8_WAIT_L(0); PG8_BAR; PG8_MMA(1, 0, At, B0); PG8_MMA(1, 1, At, B1); PG8_BAR; PG8_SCHED;
            PG8_LDB(B0, 1, 0); PG8_LDB(B1, 1, 1); PG8_SCHED; PG8_LDA(At, 1, 0); PG8_STAGE(PG8_SA(0, 1), a2 + hstepA, voffA);
            PG8_WAIT_V(8); PG8_WAIT_L(0); PG8_BAR; PG8_MMA(0, 0, At, B0); PG8_MMA(0, 1, At, B1); PG8_BAR; PG8_SCHED;
            PG8_LDA(At, 1, 1); PG8_STAGE(PG8_SB(1, 0), b3, voffB); PG8_STAGE(PG8_SB(1, 1), b3 + hstepB, voffB); PG8_STAGE(PG8_SA(1, 0), a3, voffA);
            PG8_WAIT_V(8); PG8_WAIT_L(0); PG8_BAR; PG8_MMA(1, 0, At, B0); PG8_MMA(1, 1, At, B1); PG8_BAR; PG8_SCHED;
        }
        if constexpr (ALIGN_EPI) { if (wr == 0) PG8_BAR; }
        E(acc, cur, wr, wc, fr, fq, xl);
        if (!has_next) break;
#pragma unroll
        for (int a = 0; a < 2; ++a)
#pragma unroll
            for (int b = 0; b < 2; ++b)
#pragma unroll
                for (int m = 0; m < 4; ++m)
#pragma unroll
                    for (int n = 0; n < 2; ++n) acc[a][b][m][n] = (f32x4){0.f, 0.f, 0.f, 0.f};
        cur = nxt; cA = nA; cB = nB; ++ui;
        if constexpr (ALIGN_EPI) { if (wr == 1) PG8_BAR; }
    }
    PG8_WAIT_V(0);
    if constexpr (!ALIGN_EPI) { if (wr == 0) PG8_BAR; }
    PG8_BAR;
#undef PG8_APTR
#undef PG8_BPTR
#undef PG8_SA
#undef PG8_SB
#undef PG8_STAGE
#undef PG8_LDA
#undef PG8_LDB
#undef PG8_MMA
#undef PG8_WAIT_V
#undef PG8_WAIT_L
#undef PG8_BAR
#undef PG8_SCHED
}
}

namespace att {
constexpr int D = 128;
constexpr int PIN = DIN;
constexpr int POUT = 2048;
constexpr float SCALE = 0.08838834764831845f;
constexpr float THR = 8.f;
constexpr int NW = 8, QBLK = 32, KVBLK = 64, QB = NW * QBLK;
constexpr int SHM_V = KVBLK * D * 2, SHM_K = KVBLK * D * 2;
constexpr int LDS_BYTES = 2 * SHM_V + 2 * SHM_K + NW * 64 * 4;
using bf16 = __hip_bfloat16;
typedef short bf16x8 __attribute__((ext_vector_type(8)));
typedef short s16x4 __attribute__((ext_vector_type(4)));
typedef float f32x16 __attribute__((ext_vector_type(16)));
typedef float f32x4 __attribute__((ext_vector_type(4)));
typedef unsigned u32x4 __attribute__((ext_vector_type(4)));

#define KSWZ(row, colB) ((row) * 256 + ((colB) ^ (((row) & 7) << 4)))
#define SBAR() __builtin_amdgcn_sched_barrier(0)
__device__ __forceinline__ int v_st(int k, int c) { const int kk = (k & ~0xC) | ((k & 4) << 1) | ((k & 8) >> 1); return ((kk >> 3) * 4 + (c >> 5)) * 512 + ((kk & 7) * 32 + (c & 31)) * 2; }
__device__ __forceinline__ int v_rd_base(int lane) { return ((lane & 3) << 3) | (((lane >> 2) & 3) << 6) | (((lane >> 4) & 1) << 5) | (((lane >> 5) & 1) << 8); }
constexpr int v_rd_off(int d0, int ks, int half) { return d0 * 512 + ks * 4096 + half * 2048; }
__device__ __forceinline__ int crow(int r, int hi) { return (r & 3) + 8 * (r >> 2) + 4 * hi; }
__device__ __forceinline__ unsigned cvtpk(float lo, float hi) { unsigned r; asm volatile("v_cvt_pk_bf16_f32 %0, %1, %2" : "=v"(r) : "v"(lo), "v"(hi)); return r; }
__device__ __forceinline__ bf16x8 load8(const bf16* p) { return *reinterpret_cast<const bf16x8*>(p); }
__device__ __forceinline__ void mask_tile(f32x16& p0, f32x16& p1, int dq, unsigned W) {
    const float NEG = -__builtin_inff();
#pragma unroll
    for (int r = 0; r < 16; ++r) {
        const int c = (r & 3) + 8 * (r >> 2);
        if ((unsigned)(dq - c) >= W) p0[r] = NEG;
        if ((unsigned)(dq - c - 32) >= W) p1[r] = NEG;
    }
}
__device__ __forceinline__ void partialSM(f32x16& p0, f32x16& p1, float& m_reg, float& mn, float& alpha) {
    float pmax = p0[0]; for (int r = 1; r < 16; ++r) pmax = fmaxf(pmax, p0[r]); for (int r = 0; r < 16; ++r) pmax = fmaxf(pmax, p1[r]);
    { auto rr = __builtin_amdgcn_permlane32_swap(__float_as_uint(pmax), __float_as_uint(pmax), false, false);
      pmax = fmaxf(__uint_as_float(rr[0]), __uint_as_float(rr[1])); }
    constexpr float C2 = 1.4426950408889634f * SCALE;
    if (__builtin_expect(__all((pmax - m_reg) * SCALE <= THR), 1)) { mn = m_reg; alpha = 1.f; }
    else { mn = fmaxf(m_reg, pmax); alpha = __builtin_amdgcn_exp2f((m_reg - mn) * C2); m_reg = mn; }
    const float mnL = -mn * C2;
    for (int r = 0; r < 16; ++r) p0[r] = fmaf(p0[r], C2, mnL); for (int r = 0; r < 16; ++r) p1[r] = fmaf(p1[r], C2, mnL);
    for (int r = 0; r < 16; ++r) p0[r] = __builtin_amdgcn_exp2f(p0[r]);
}
__device__ __forceinline__ void finishSM(f32x16& p0, f32x16& p1, float alpha, float& l_reg, bf16x8& pa0, bf16x8& pa1, bf16x8& pa2, bf16x8& pa3) {
    for (int r = 0; r < 16; ++r) p1[r] = __builtin_amdgcn_exp2f(p1[r]);
    float ps = 0; for (int r = 0; r < 16; ++r) ps += p0[r]; for (int r = 0; r < 16; ++r) ps += p1[r];
    { auto rr = __builtin_amdgcn_permlane32_swap(__float_as_uint(ps), __float_as_uint(ps), false, false);
      ps = __uint_as_float(rr[0]) + __uint_as_float(rr[1]); }
    l_reg = l_reg * alpha + ps;
#define PK4(P, B_, OUT) do { unsigned a0 = cvtpk(P[B_+0], P[B_+1]), a1 = cvtpk(P[B_+2], P[B_+3]);                          \
        unsigned b0 = cvtpk(P[B_+4], P[B_+5]), b1 = cvtpk(P[B_+6], P[B_+7]);                                             \
        auto r0 = __builtin_amdgcn_permlane32_swap(a0, b0, false, false); auto r1 = __builtin_amdgcn_permlane32_swap(a1, b1, false, false); \
        u32x4 w = {r0[0], r1[0], r0[1], r1[1]}; OUT = *reinterpret_cast<bf16x8*>(&w); } while (0)
    PK4(p0, 0, pa0); PK4(p0, 8, pa1); PK4(p1, 0, pa2); PK4(p1, 8, pa3);
#undef PK4
}
template <int KB>
__device__ __forceinline__ void qkt(f32x16& p0, f32x16& p1, const char* K_lds, int r32, int hi, const bf16x8* qr) {
    p0 = f32x16{}; p1 = f32x16{};
    const char* kb[4];
#pragma unroll
    for (int dd = 0; dd < 4; ++dd) kb[dd] = K_lds + KB * SHM_K + KSWZ(r32, (dd * 16 + hi * 8) * 2);
#pragma unroll
    for (int d0 = 0; d0 < 8; ++d0) { const char* a = kb[d0 & 3] + (d0 >> 2) * 128;
        bf16x8 b0 = *reinterpret_cast<const bf16x8*>(a);
        bf16x8 b1 = *reinterpret_cast<const bf16x8*>(a + 32 * 256);
        p0 = __builtin_amdgcn_mfma_f32_32x32x16_bf16(b0, qr[d0], p0, 0, 0, 0);
        p1 = __builtin_amdgcn_mfma_f32_32x32x16_bf16(b1, qr[d0], p1, 0, 0, 0); }
}
template <int VB>
__device__ __forceinline__ void pv_tile(f32x16* o, int vb0, bf16x8 pa0, bf16x8 pa1, bf16x8 pa2, bf16x8 pa3) {
#define TRRD(dst, off) asm volatile("ds_read_b64_tr_b16 %0, %1 offset:%2" : "=&v"(dst) : "v"(vb0), "i"(off) : "memory")
#define PV_D0(d0) do { s16x4 l0, l1, l2, l3, h0, h1, h2, h3; constexpr int b_ = VB * SHM_V + v_rd_off(d0, 0, 0); \
        TRRD(l0, b_); TRRD(h0, b_ + 2048); TRRD(l1, b_ + 4096); TRRD(h1, b_ + 6144); TRRD(l2, b_ + 8192); TRRD(h2, b_ + 10240); TRRD(l3, b_ + 12288); TRRD(h3, b_ + 14336); \
        asm volatile("s_waitcnt lgkmcnt(0)" ::: "memory"); SBAR();   \
        o[d0] = __builtin_amdgcn_mfma_f32_32x32x16_bf16(pa0, (bf16x8){l0[0], l0[1], l0[2], l0[3], h0[0], h0[1], h0[2], h0[3]}, o[d0], 0, 0, 0);   \
        o[d0] = __builtin_amdgcn_mfma_f32_32x32x16_bf16(pa1, (bf16x8){l1[0], l1[1], l1[2], l1[3], h1[0], h1[1], h1[2], h1[3]}, o[d0], 0, 0, 0);   \
        o[d0] = __builtin_amdgcn_mfma_f32_32x32x16_bf16(pa2, (bf16x8){l2[0], l2[1], l2[2], l2[3], h2[0], h2[1], h2[2], h2[3]}, o[d0], 0, 0, 0);   \
        o[d0] = __builtin_amdgcn_mfma_f32_32x32x16_bf16(pa3, (bf16x8){l3[0], l3[1], l3[2], l3[3], h3[0], h3[1], h3[2], h3[3]}, o[d0], 0, 0, 0); } while (0)
    PV_D0(0); PV_D0(1); PV_D0(2); PV_D0(3);
#undef PV_D0
#undef TRRD
}

struct BlockRef { const bf16* Q; const bf16* K; const bf16* V; bf16* O; int P0; };
struct Seam { bf16x8 qr[8]; bf16x8 st_v0, st_v1, st_k0, st_k1; };
#define ROW(p, k0, rr) ((p) + (size_t)((k0) + (rr)) * PIN + sc)
#define VMW() asm volatile("s_waitcnt vmcnt(0)" ::: "memory")
#define VMWN(n) asm volatile("s_waitcnt vmcnt(%0)" :: "i"(n) : "memory")
#define SLOAD_H(Kp, Vp, k0) do { S.st_v0 = load8(ROW(Vp, k0, sr)); S.st_v1 = load8(ROW(Vp, k0, 32 + sr));              \
                         S.st_k0 = load8(ROW(Kp, k0, sr)); S.st_k1 = load8(ROW(Kp, k0, 32 + sr)); } while (0)
#define SWRITE_HK(bf) do { *(bf16x8*)(K_lds + (bf) * SHM_K + kws) = S.st_k0; *(bf16x8*)(K_lds + (bf) * SHM_K + kws + 32 * 256) = S.st_k1; } while (0)
#define SWRITE_HV(bf) do { *(bf16x8*)(V_lds + (bf) * SHM_V + vst0) = S.st_v0; *(bf16x8*)(V_lds + (bf) * SHM_V + vst1) = S.st_v1; } while (0)
#define SWRITE_H(bf) do { SWRITE_HV(bf); SWRITE_HK(bf); } while (0)
__device__ __forceinline__ void causal_prime(const BlockRef& cur, char* lds, Seam& S) {
    const int tid = threadIdx.x, wid = __builtin_amdgcn_readfirstlane(tid >> 6), lane = tid & 63, r32 = lane & 31, hi = lane >> 5;
    const int sr = tid >> 4, sc = (tid & 15) * 8, kws = KSWZ(sr, sc * 2); char* K_lds = lds + 2 * SHM_V;
    const int kb0 = 0;
    for (int d0 = 0; d0 < 8; ++d0) S.qr[d0] = load8(cur.Q + (size_t)(wid * QBLK + r32) * PIN + d0 * 16 + hi * 8);
    SLOAD_H(cur.K, cur.V, kb0); VMW(); SWRITE_HK(0);
    __syncthreads();
}
__device__ __forceinline__ void causal_block(const BlockRef& cur, const BlockRef& nxt, int skv, char* lds, Seam& S) {
    const int W = 1 << 30;
    const int tid = threadIdx.x, wid = __builtin_amdgcn_readfirstlane(tid >> 6), lane = tid & 63, r32 = lane & 31, hi = lane >> 5;
    const int j_lo = 0;
    int j_hi = (cur.P0 + QB - 1) / KVBLK + 1; if (j_hi > skv / KVBLK) j_hi = skv / KVBLK;
    const int NT = j_hi - j_lo;
    const int kbn = 0;
    const int qlo = cur.P0 + wid * QBLK, qm = qlo + r32 - 4 * hi;
    char* V_lds = lds; char* K_lds = lds + 2 * SHM_V;
    float* ws = (float*)(lds + 2 * SHM_V + 2 * SHM_K) + wid * 64; float* li_l = ws, * al_l = ws + 32;
    float m_reg = -1e30f, l_reg = 0; f32x16 o[4] = {};
    const int sr = tid >> 4, sc = (tid & 15) * 8, vst0 = v_st(sr, sc), vst1 = v_st(32 + sr, sc), kws = KSWZ(sr, sc * 2);
    const int vb0 = (int)(uintptr_t)V_lds + v_rd_base(lane);
    const bf16* Kh = cur.K; const bf16* Vh = cur.V;
#define RESC(a) do { if (__any((a) < 1.f)) { if (hi == 0) al_l[r32] = (a); asm volatile("s_waitcnt lgkmcnt(0)" ::: "memory");              \
                     for (int d_ = 0; d_ < 4; ++d_) for (int r = 0; r < 16; ++r) o[d_][r] *= al_l[crow(r, hi)]; } } while (0)
#define KBASE(t) ((j_lo + (t)) * KVBLK)
#define MASKT(P0_, P1_, t) do { const int kb_ = KBASE(t); if (kb_ + KVBLK - 1 > qlo) mask_tile(P0_, P1_, qm - kb_, (unsigned)W); } while (0)
    constexpr int NQL = 8;
#define SEAM_K0() do { VMWN(NQL); SWRITE_HK(0); SBAR(); } while (0)
    f32x16 pA0, pA1, pB0, pB1; float mnA, mnB, alA, alB; bf16x8 pa0, pa1, pa2, pa3;
    SWRITE_HV(0); SBAR();
    if (NT > 1) { SLOAD_H(Kh, Vh, KBASE(1)); }
    SBAR(); qkt<0>(pA0, pA1, K_lds, r32, hi, S.qr);
    MASKT(pA0, pA1, 0); partialSM(pA0, pA1, m_reg, mnA, alA);
    if (NT > 1) { VMW(); SWRITE_H(1); }
    __syncthreads();
#define HALF_STEP(PX0, PX1, mnX, alX, PY0, PY1, alY, t, KB, VB, SB) do {                                                      \
        SBAR(); qkt<KB>(PX0, PX1, K_lds, r32, hi, S.qr);                                                                      \
        finishSM(PY0, PY1, alY, l_reg, pa0, pa1, pa2, pa3); SBAR();                                                           \
        if ((t) + 1 < NT) { SLOAD_H(Kh, Vh, KBASE((t) + 1)); SBAR(); }                                                        \
        pv_tile<VB>(o, vb0, pa0, pa1, pa2, pa3); MASKT(PX0, PX1, (t)); partialSM(PX0, PX1, m_reg, mnX, alX);                  \
        __syncthreads();                                                                                                      \
        if ((t) + 1 < NT) { VMW(); SWRITE_H(SB); }                                                                            \
        RESC(alX); __syncthreads(); } while (0)
    for (int t = 1; t + 1 < NT; t += 2) {
        HALF_STEP(pB0, pB1, mnB, alB, pA0, pA1, alA, t, 1, 0, 0);
        HALF_STEP(pA0, pA1, mnA, alA, pB0, pB1, alB, t + 1, 0, 1, 1);
    }
    const bool even = (NT & 1) == 0;
    if (even) { SBAR(); qkt<1>(pB0, pB1, K_lds, r32, hi, S.qr); SBAR(); }
    SLOAD_H(nxt.K, nxt.V, kbn); SBAR();
#pragma unroll
    for (int d0 = 0; d0 < 8; ++d0) S.qr[d0] = load8(nxt.Q + (size_t)(wid * QBLK + r32) * PIN + d0 * 16 + hi * 8);
    SBAR();
    finishSM(pA0, pA1, alA, l_reg, pa0, pa1, pa2, pa3); SBAR();
    pv_tile<0>(o, vb0, pa0, pa1, pa2, pa3);
    if (even) { MASKT(pB0, pB1, NT - 1); partialSM(pB0, pB1, m_reg, mnB, alB); __syncthreads(); RESC(alB);
        finishSM(pB0, pB1, alB, l_reg, pa0, pa1, pa2, pa3); SBAR(); pv_tile<1>(o, vb0, pa0, pa1, pa2, pa3); }
    SBAR(); SEAM_K0();
    if (hi == 0) li_l[r32] = l_reg; asm volatile("s_waitcnt lgkmcnt(0)" ::: "memory");
    float rli[16];
#pragma unroll
    for (int r = 0; r < 16; ++r) rli[r] = __builtin_amdgcn_rcpf(li_l[crow(r, hi)]);
    bf16* Ow = cur.O + (size_t)(wid * QBLK) * POUT;
#pragma unroll
    for (int r = 0; r < 16; ++r) { const int orow = crow(r, hi);
#pragma unroll
        for (int d0 = 0; d0 < 4; ++d0) { const float v = o[d0][r] * rli[r];
            const float vn = __shfl_xor(v, 1);
            if ((r32 & 1) == 0) *(unsigned*)(Ow + (size_t)orow * POUT + d0 * 32 + r32) = cvtpk(v, vn); } }
    __syncthreads();
#undef RESC
#undef KBASE
#undef MASKT
#undef SEAM_K0
#undef HALF_STEP
}
#undef ROW
#undef VMW
#undef VMWN
#undef SLOAD_H
#undef SWRITE_HK
#undef SWRITE_HV
#undef SWRITE_H
#undef KSWZ
#undef SBAR

__device__ __forceinline__ BlockRef make_ref(int L, int pass, const bf16* PROJ, bf16* O16) {
    const int xcd = L & 7, kk = L >> 3, p = xcd * 4 + (kk >> 5), x = kk & 31;
    const int qb = pass ? 63 - x : x;
    const int b = p >> 4, h = (p >> 2) & 3, m = (p >> 1) & 1, vh = p & 1;
    const size_t rb = (size_t)b * SEQ;
    BlockRef r;
    r.Q = PROJ + (rb + (size_t)qb * QB) * PIN + (h * 2 + m) * 128;
    r.K = PROJ + rb * PIN + 1024 + (h * 2 + m) * 128;
    r.V = PROJ + rb * PIN + 2048 + h * 256 + vh * 128;
    r.O = O16 + (rb + (size_t)qb * QB) * POUT + (p & 15) * 128;
    r.P0 = qb * QB;
    return r;
}
__device__ __forceinline__ void attn_phase(char* lds, const bf16* PROJ, bf16* O16, int G, int w) {
    constexpr int total = 1024;
    int L = w; if (L >= total) return;
    int pass = 0;
    BlockRef cur = make_ref(L, 0, PROJ, O16);
    Seam S;
    causal_prime(cur, lds, S);
    for (;;) {
        const bool more_pass = pass == 0, more_item = L + G < total, last = !more_pass && !more_item;
        int passn, Ln;
        if (more_pass) { passn = 1; Ln = L; } else { passn = 0; Ln = more_item ? L + G : L; }
        const BlockRef nxt = last ? cur : make_ref(Ln, passn, PROJ, O16);
        causal_block(cur, nxt, SEQ, lds, S);
        if (last) break;
        cur = nxt; pass = passn; L = Ln;
    }
}
}


namespace att2 {
using namespace att;
constexpr int QB2 = 128;
constexpr int PH = 128;
constexpr long HSTR = (long)SEQ * PH;
constexpr int L_V = 0, L_K = 4 * SHM_V, L_WSF = L_K + 2 * SHM_K, L_XM = L_WSF + 2048, L_XP = L_XM + 2048, L_XL = L_XP + 32768, L_END = L_XL + 1024;
#define KSWZ2(row, colB) ((row) * 256 + ((colB) ^ (((row) & 7) << 4)))
#define SBAR2() __builtin_amdgcn_sched_barrier(0)
struct BlockRef2 { const bf16* Q; const bf16* K; const bf16* V; bf16* O; int P0; };

__device__ __forceinline__ void block2(const BlockRef2& cur, char* lds, int wave) {
    const int lane = (int)__builtin_amdgcn_mbcnt_hi(~0u, __builtin_amdgcn_mbcnt_lo(~0u, 0u)), r32 = lane & 31, hi = lane >> 5, tid = wave * 64 + lane;
    const int rg = wave & 3, c = wave >> 2, pw = wave ^ 4;
    const int NT = (cur.P0 + QB2 - 1) / KVBLK + 1;
    const int qlo = cur.P0 + rg * QBLK, qm = qlo + r32 - 4 * hi;
    char* V_lds = lds + L_V; char* K_lds = lds + L_K;
    float* wsf = (float*)(lds + L_WSF) + wave * 64; float* li_l = wsf; float* al_l = wsf + 32;
    float* xm = (float*)(lds + L_XM);
    char* xp = lds + L_XP;
    float* xl = (float*)(lds + L_XL);
    const int sr = tid >> 4, sc = (tid & 15) * 8, vst0 = v_st(sr, sc), vst1 = v_st(32 + sr, sc), kws = KSWZ2(sr, sc * 2);
    const int vb0 = (int)(uintptr_t)V_lds + c * SHM_V + v_rd_base(lane);
    const bf16* Kh = cur.K; const bf16* Vh = cur.V;
    bf16x8 qr[8];
#pragma unroll
    for (int d0 = 0; d0 < 8; ++d0) qr[d0] = *reinterpret_cast<const bf16x8*>((const char*)(cur.Q + (size_t)(rg * QBLK) * PH) + (unsigned)(r32 * PH + hi * 8) * 2u + d0 * 32);
    bf16x8 sk0, sk1, sv00, sv01, sv10, sv11;
    unsigned voff = (unsigned)(sr * PH + sc) * 2u; asm volatile("" : "+v"(voff));
#define LD16(base_, byteoff_) (*reinterpret_cast<const bf16x8*>((const char*)(base_) + voff + (byteoff_)))
#define KLOAD(k0) do { const bf16* kb0_ = Kh + (size_t)(k0) * PH; const bf16* kb1_ = Kh + (size_t)((k0) + 32) * PH; sk0 = LD16(kb0_, 0); sk1 = LD16(kb1_, 0); } while (0)
#define VLOAD(k0) do { const bf16* vb0_ = Vh + (size_t)(k0) * PH; const bf16* vb1_ = Vh + (size_t)((k0) + 32) * PH; \
                       sv00 = LD16(vb0_, 0); sv01 = LD16(vb1_, 0); sv10 = LD16(vb0_ + HSTR, 0); sv11 = LD16(vb1_ + HSTR, 0); } while (0)
#define KWRITE(bf) do { *(bf16x8*)(K_lds + (bf) * SHM_K + kws) = sk0; *(bf16x8*)(K_lds + (bf) * SHM_K + kws + 32 * 256) = sk1; } while (0)
#define VWRITE(bf) do { *(bf16x8*)(V_lds + ((bf) * 2) * SHM_V + vst0) = sv00; *(bf16x8*)(V_lds + ((bf) * 2) * SHM_V + vst1) = sv01; \
                        *(bf16x8*)(V_lds + ((bf) * 2 + 1) * SHM_V + vst0) = sv10; *(bf16x8*)(V_lds + ((bf) * 2 + 1) * SHM_V + vst1) = sv11; } while (0)
    KLOAD(0); VLOAD(0); KWRITE(0); VWRITE(0);
    KLOAD(KVBLK); VLOAD(KVBLK); KWRITE(1); VWRITE(1);
    if (NT > 2) { KLOAD(2 * KVBLK); VLOAD(2 * KVBLK); }
    float m_reg = -1e30f, l_reg = 0.f; f32x16 o[4] = {};
    f32x16 pA, pB; float alA = 1.f, alB = 1.f; bf16x8 f0, f1;
    constexpr float C2 = 1.4426950408889634f * SCALE;
#define QKT2(P, KB) do { P = f32x16{}; const char* kq_ = K_lds + (KB) * SHM_K + c * (32 * 256); \
        _Pragma("unroll") for (int d0 = 0; d0 < 8; ++d0) { const bf16x8 b_ = *reinterpret_cast<const bf16x8*>(kq_ + KSWZ2(r32, (((d0) & 3) * 16 + hi * 8) * 2) + ((d0) >> 2) * 128); \
            P = __builtin_amdgcn_mfma_f32_32x32x16_bf16(b_, qr[d0], P, 0, 0, 0); } } while (0)
#define MASKMAX(P, t, par) do { const int kb_ = (t) * KVBLK + 32 * c; \
        if (kb_ + 31 > qlo) { const int dq_ = qm - kb_; const float NEG_ = -__builtin_inff(); \
            _Pragma("unroll") for (int r = 0; r < 16; ++r) { if (dq_ - ((r & 3) + 8 * (r >> 2)) < 0) P[r] = NEG_; } } \
        float pm_ = P[0]; _Pragma("unroll") for (int r = 1; r < 16; ++r) pm_ = fmaxf(pm_, P[r]); \
        { auto rr = __builtin_amdgcn_permlane32_swap(__float_as_uint(pm_), __float_as_uint(pm_), false, false); pm_ = fmaxf(__uint_as_float(rr[0]), __uint_as_float(rr[1])); } \
        pmx = pm_; if (hi == 0) xm[((par) * 8 + wave) * 32 + r32] = pm_; } while (0)
#define SOFTMAX(P, par, alX) do { const float pmax_ = fmaxf(pmx, xm[((par) * 8 + pw) * 32 + r32]); float mn_; \
        if (__builtin_expect(__all((pmax_ - m_reg) * SCALE <= THR), 1)) { mn_ = m_reg; alX = 1.f; } \
        else { mn_ = fmaxf(m_reg, pmax_); alX = __builtin_amdgcn_exp2f((m_reg - mn_) * C2); m_reg = mn_; } \
        const float mnL_ = -mn_ * C2; \
        _Pragma("unroll") for (int r = 0; r < 16; ++r) P[r] = __builtin_amdgcn_exp2f(fmaf(P[r], C2, mnL_)); } while (0)
#define PK4B(P, B_, OUT) do { unsigned a0 = cvtpk(P[B_+0], P[B_+1]), a1 = cvtpk(P[B_+2], P[B_+3]); unsigned b0 = cvtpk(P[B_+4], P[B_+5]), b1 = cvtpk(P[B_+6], P[B_+7]); \
        auto r0 = __builtin_amdgcn_permlane32_swap(a0, b0, false, false); auto r1 = __builtin_amdgcn_permlane32_swap(a1, b1, false, false); \
        u32x4 w = {r0[0], r1[0], r0[1], r1[1]}; OUT = *reinterpret_cast<bf16x8*>(&w); } while (0)
#define FINISH(P, alY, par) do { float ps_ = 0; _Pragma("unroll") for (int r = 0; r < 16; ++r) ps_ += P[r]; \
        { auto rr = __builtin_amdgcn_permlane32_swap(__float_as_uint(ps_), __float_as_uint(ps_), false, false); ps_ = __uint_as_float(rr[0]) + __uint_as_float(rr[1]); } \
        l_reg = l_reg * alY + ps_; PK4B(P, 0, f0); PK4B(P, 8, f1); \
        *(bf16x8*)(xp + (((par) * 8 + wave) * 2 + 0) * 1024 + lane * 16) = f0; *(bf16x8*)(xp + (((par) * 8 + wave) * 2 + 1) * 1024 + lane * 16) = f1; } while (0)
#define TRRD2(dst, off) asm volatile("ds_read_b64_tr_b16 %0, %1 offset:%2" : "=&v"(dst) : "v"(vb0), "i"(off) : "memory")
#define PV2_D0(VB, d0) do { s16x4 l0, l1, l2, l3, h0, h1, h2, h3; constexpr int b_ = (VB) * 2 * SHM_V + v_rd_off(d0, 0, 0); \
        TRRD2(l0, b_); TRRD2(h0, b_ + 2048); TRRD2(l1, b_ + 4096); TRRD2(h1, b_ + 6144); TRRD2(l2, b_ + 8192); TRRD2(h2, b_ + 10240); TRRD2(l3, b_ + 12288); TRRD2(h3, b_ + 14336); \
        asm volatile("s_waitcnt lgkmcnt(0)" ::: "memory"); SBAR2(); __builtin_amdgcn_s_setprio(1);  \
        o[d0] = __builtin_amdgcn_mfma_f32_32x32x16_bf16(pa0, (bf16x8){l0[0], l0[1], l0[2], l0[3], h0[0], h0[1], h0[2], h0[3]}, o[d0], 0, 0, 0);   \
        o[d0] = __builtin_amdgcn_mfma_f32_32x32x16_bf16(pa1, (bf16x8){l1[0], l1[1], l1[2], l1[3], h1[0], h1[1], h1[2], h1[3]}, o[d0], 0, 0, 0);   \
        o[d0] = __builtin_amdgcn_mfma_f32_32x32x16_bf16(pa2, (bf16x8){l2[0], l2[1], l2[2], l2[3], h2[0], h2[1], h2[2], h2[3]}, o[d0], 0, 0, 0);   \
        o[d0] = __builtin_amdgcn_mfma_f32_32x32x16_bf16(pa3, (bf16x8){l3[0], l3[1], l3[2], l3[3], h3[0], h3[1], h3[2], h3[3]}, o[d0], 0, 0, 0); __builtin_amdgcn_s_setprio(0); } while (0)
#define PVALL(VB, par) do { const bf16x8 g0_ = *(const bf16x8*)(xp + (((par) * 8 + pw) * 2 + 0) * 1024 + lane * 16), g1_ = *(const bf16x8*)(xp + (((par) * 8 + pw) * 2 + 1) * 1024 + lane * 16); \
        const bf16x8 pa0 = c ? g0_ : f0, pa1 = c ? g1_ : f1, pa2 = c ? f0 : g0_, pa3 = c ? f1 : g1_; \
        PV2_D0(VB, 0); PV2_D0(VB, 1); PV2_D0(VB, 2); PV2_D0(VB, 3); } while (0)
#define RESC2(a) do { if (__any((a) < 1.f)) { if (hi == 0) al_l[r32] = (a); asm volatile("s_waitcnt lgkmcnt(0)" ::: "memory");              \
                     for (int d_ = 0; d_ < 4; ++d_) for (int r = 0; r < 16; ++r) o[d_][r] *= al_l[crow(r, hi)]; } } while (0)
#define QKT2F(PX, KB, PY, alY, par) do { const char* kq_ = K_lds + (KB) * SHM_K + c * (32 * 256); bf16x8 kf_[8]; \
        _Pragma("unroll") for (int d0 = 0; d0 < 8; ++d0) kf_[d0] = *reinterpret_cast<const bf16x8*>(kq_ + KSWZ2(r32, (((d0) & 3) * 16 + hi * 8) * 2) + ((d0) >> 2) * 128); \
        PX = f32x16{}; float ps_ = 0.f; SBAR2(); __builtin_amdgcn_s_setprio(1); \
        PX = __builtin_amdgcn_mfma_f32_32x32x16_bf16(kf_[0], qr[0], PX, 0, 0, 0); SBAR2(); \
        _Pragma("unroll") for (int r = 0; r < 8; ++r) ps_ += PY[r]; SBAR2(); \
        PX = __builtin_amdgcn_mfma_f32_32x32x16_bf16(kf_[1], qr[1], PX, 0, 0, 0); SBAR2(); \
        _Pragma("unroll") for (int r = 8; r < 16; ++r) ps_ += PY[r]; \
        { auto rr = __builtin_amdgcn_permlane32_swap(__float_as_uint(ps_), __float_as_uint(ps_), false, false); ps_ = __uint_as_float(rr[0]) + __uint_as_float(rr[1]); } \
        l_reg = l_reg * alY + ps_; SBAR2(); \
        PX = __builtin_amdgcn_mfma_f32_32x32x16_bf16(kf_[2], qr[2], PX, 0, 0, 0); SBAR2(); \
        PK4B(PY, 0, f0); *(bf16x8*)(xp + (((par) * 8 + wave) * 2 + 0) * 1024 + lane * 16) = f0; SBAR2(); \
        PX = __builtin_amdgcn_mfma_f32_32x32x16_bf16(kf_[3], qr[3], PX, 0, 0, 0); SBAR2(); \
        PK4B(PY, 8, f1); *(bf16x8*)(xp + (((par) * 8 + wave) * 2 + 1) * 1024 + lane * 16) = f1; SBAR2(); \
        PX = __builtin_amdgcn_mfma_f32_32x32x16_bf16(kf_[4], qr[4], PX, 0, 0, 0); \
        PX = __builtin_amdgcn_mfma_f32_32x32x16_bf16(kf_[5], qr[5], PX, 0, 0, 0); \
        PX = __builtin_amdgcn_mfma_f32_32x32x16_bf16(kf_[6], qr[6], PX, 0, 0, 0); \
        PX = __builtin_amdgcn_mfma_f32_32x32x16_bf16(kf_[7], qr[7], PX, 0, 0, 0); __builtin_amdgcn_s_setprio(0); SBAR2(); } while (0)
#define SM_DECIDE(par, alX) do { const float pmax_ = fmaxf(pmx, xm[((par) * 8 + pw) * 32 + r32]); float mn_; \
        if (__builtin_expect(__all((pmax_ - m_reg) * SCALE <= THR), 1)) { mn_ = m_reg; alX = 1.f; } \
        else { mn_ = fmaxf(m_reg, pmax_); alX = __builtin_amdgcn_exp2f((m_reg - mn_) * C2); m_reg = mn_; } \
        mnL = -mn_ * C2; } while (0)
#define SM_EXP4(P, B_) do { _Pragma("unroll") for (int r = (B_); r < (B_) + 4; ++r) P[r] = __builtin_amdgcn_exp2f(fmaf(P[r], C2, mnL)); } while (0)
#define PVSM(VB, par, PX, parX, alX) do { const bf16x8 g0_ = *(const bf16x8*)(xp + (((par) * 8 + pw) * 2 + 0) * 1024 + lane * 16), g1_ = *(const bf16x8*)(xp + (((par) * 8 + pw) * 2 + 1) * 1024 + lane * 16); \
        SM_DECIDE(parX, alX); \
        const bf16x8 pa0 = c ? g0_ : f0, pa1 = c ? g1_ : f1, pa2 = c ? f0 : g0_, pa3 = c ? f1 : g1_; SBAR2(); \
        PV2_D0(VB, 0); SBAR2(); SM_EXP4(PX, 0); SBAR2(); PV2_D0(VB, 1); SBAR2(); SM_EXP4(PX, 4); SBAR2(); \
        PV2_D0(VB, 2); SBAR2(); SM_EXP4(PX, 8); SBAR2(); PV2_D0(VB, 3); SBAR2(); SM_EXP4(PX, 12); SBAR2(); } while (0)
    float pmx, mnL;
    __syncthreads();
    QKT2(pA, 0); MASKMAX(pA, 0, 0);
    __syncthreads();
    SOFTMAX(pA, 0, alA);
#define STEP2(PX, alX, PY, alY, t, KB, VB) do { \
        SBAR2(); QKT2F(PX, KB, PY, alY, VB); \
        MASKMAX(PX, t, KB); \
        __syncthreads(); \
        if ((t) + 1 < NT) { KWRITE(VB); if ((t) + 2 < NT) KLOAD(((t) + 2) * KVBLK); } \
        PVSM(VB, VB, PX, KB, alX); \
        __syncthreads(); \
        if ((t) + 1 < NT) { VWRITE(VB); if ((t) + 2 < NT) VLOAD(((t) + 2) * KVBLK); } \
        RESC2(alX); } while (0)
    for (int t = 1; t + 1 < NT; t += 2) {
        STEP2(pB, alB, pA, alA, t, 1, 0);
        STEP2(pA, alA, pB, alB, t + 1, 0, 1);
    }
    STEP2(pB, alB, pA, alA, NT - 1, 1, 0);
    FINISH(pB, alB, 1);
    if (hi == 0) xl[wave * 32 + r32] = l_reg;
    __syncthreads();
    PVALL(1, 1);
    l_reg += xl[pw * 32 + r32];
    if (hi == 0) li_l[r32] = l_reg; asm volatile("s_waitcnt lgkmcnt(0)" ::: "memory");
    float rli[16];
#pragma unroll
    for (int r = 0; r < 16; ++r) rli[r] = __builtin_amdgcn_rcpf(li_l[crow(r, hi)]);
    { char* stg = lds + (wave < 4 ? L_V + wave * 8192 : L_K + (wave - 4) * 8192);
      unsigned soff = (unsigned)(4 * hi * 256 + r32 * 2); asm volatile("" : "+v"(soff));
#pragma unroll
      for (int r = 0; r < 16; ++r) { const unsigned orow = (unsigned)((r & 3) + 8 * (r >> 2));
#pragma unroll
          for (int d0 = 0; d0 < 4; ++d0) *(bf16*)(stg + soff + orow * 256u + d0 * 64u) = __float2bfloat16(o[d0][r] * rli[r]); }
      asm volatile("s_waitcnt lgkmcnt(0)" ::: "memory");
      char* Ow = (char*)(cur.O + (size_t)(rg * QBLK) * POUT + c * 128);
      unsigned roff = (unsigned)((lane >> 4) * 256 + (lane & 15) * 16), goff = (unsigned)((lane >> 4) * (POUT * 2) + (lane & 15) * 16); asm volatile("" : "+v"(roff), "+v"(goff));
#pragma unroll
      for (int i = 0; i < 8; ++i) { const u32x4 v = *(const u32x4*)(stg + roff + i * 1024u); *(u32x4*)(Ow + goff + (unsigned)i * (4u * POUT * 2u)) = v; } }
    __syncthreads();
#undef LD16
#undef KLOAD
#undef VLOAD
#undef KWRITE
#undef VWRITE
#undef QKT2
#undef MASKMAX
#undef SOFTMAX
#undef PK4B
#undef FINISH
#undef TRRD2
#undef PV2_D0
#undef PVALL
#undef RESC2
#undef STEP2
#undef QKT2F
#undef SM_DECIDE
#undef SM_EXP4
#undef PVSM
}
__device__ __forceinline__ BlockRef2 make_ref2(int L, int pass, const bf16* PROJ, bf16* O16) {
    const int xcd = L & 7, kk = L >> 3, p = xcd * 2 + (kk & 1), x = kk >> 1;
    const int qb = pass ? 127 - x : x;
    const int b = p >> 3, h = (p >> 1) & 3, m = p & 1;
    const size_t rb = (size_t)b * SEQ;
    BlockRef2 r;
    const bf16* hb = PROJ + (size_t)b * 24 * HSTR;
    r.Q = hb + (size_t)(h * 2 + m) * HSTR + (size_t)qb * QB2 * PH;
    r.K = hb + (size_t)(8 + h * 2 + m) * HSTR;
    r.V = hb + (size_t)(16 + h * 2) * HSTR;
    r.O = O16 + (rb + (size_t)qb * QB2) * POUT + h * 512 + m * 256;
    r.P0 = qb * QB2;
    return r;
}
__device__ __forceinline__ void attn_phase2(char* lds, const bf16* PROJ, bf16* O16, int G, int w, int wave) {
    for (int L = w; L < 1024; L += G)
        for (int pass = 0; pass < 2; ++pass) { const BlockRef2 cur = make_ref2(L, pass, PROJ, O16); block2(cur, lds, wave); }
}
#undef KSWZ2
#undef SBAR2
}

constexpr size_t MiB = 1u << 20;
constexpr size_t WS_WIN = 1 * MiB;
constexpr size_t WS_WO = 17 * MiB;
constexpr size_t WS_WQX = 25 * MiB;
constexpr size_t WS_WKV = 33 * MiB;
constexpr size_t WS_WOX = 49 * MiB;
constexpr size_t WS_WGU = 57 * MiB;
constexpr size_t WS_WDN = 101 * MiB;
constexpr size_t WS_WPOOL = 123 * MiB;
constexpr size_t WS_MN = 124 * MiB;
constexpr size_t WS_KX = 126 * MiB;
constexpr size_t WS_VXT = 128 * MiB;
constexpr size_t WS_HN = 144 * MiB;
constexpr size_t WS_PROJ = 272 * MiB;
constexpr size_t WS_O16 = 528 * MiB;
constexpr size_t WS_POOLED = 656 * MiB;
constexpr size_t WS_CONCAT = 720 * MiB;
constexpr size_t WS_QX = 272 * MiB;
constexpr size_t WS_PSC = 400 * MiB;
constexpr size_t WS_OX = 528 * MiB;
constexpr size_t WS_HID = 272 * MiB;
constexpr size_t WS_XB = 848 * MiB;
constexpr size_t WS_WQK = 130 * MiB;
constexpr size_t WS_VWT = 976 * MiB;
constexpr size_t WS_END = 984 * MiB;

constexpr int LDS_BYTES = 147456;
constexpr int XL_OFF = 131072;
constexpr int NPHASE = 14;

typedef unsigned short bf16r;
typedef float f32x4 __attribute__((ext_vector_type(4)));
typedef unsigned v4u __attribute__((ext_vector_type(4)));
typedef unsigned v2u __attribute__((ext_vector_type(2)));
#define LAS __attribute__((address_space(3)))

__device__ __forceinline__ unsigned f2bf(float f) { unsigned u = __builtin_bit_cast(unsigned, f); return (u + 0x7fffu + ((u >> 16) & 1u)) >> 16; }
__device__ __forceinline__ unsigned pk2(float lo, float hi) { return f2bf(lo) | (f2bf(hi) << 16); }
__device__ __forceinline__ float bf2f(unsigned short b) { return __builtin_bit_cast(float, (unsigned)b << 16); }
__device__ __forceinline__ float wave_sum(float v) {
#pragma unroll
    for (int o = 1; o < 64; o <<= 1) v += __shfl_xor(v, o);
    return v;
}

__device__ __forceinline__ void transpose_item(const float* W, int N, bf16r* WT, int ldt, int k0, int n0, int drow0, LAS float* scr, int lane) {
#pragma unroll 8
    for (int i = 0; i < 32; ++i) { const int kk = 2 * i + (lane >> 5); scr[kk * 33 + (lane & 31)] = W[(size_t)(k0 + kk) * N + n0 + (lane & 31)]; }
    asm volatile("s_waitcnt lgkmcnt(0)" ::: "memory");
    const int c = lane & 7;
#pragma unroll
    for (int j = 0; j < 4; ++j) { const int n = (lane >> 3) + 8 * j; const LAS float* s = scr + (8 * c) * 33 + n;
        v4u o; o.x = pk2(s[0 * 33], s[1 * 33]); o.y = pk2(s[2 * 33], s[3 * 33]); o.z = pk2(s[4 * 33], s[5 * 33]); o.w = pk2(s[6 * 33], s[7 * 33]);
        *(v4u*)(WT + (size_t)(drow0 + n) * ldt + k0 + 8 * c) = o; }
    asm volatile("s_waitcnt lgkmcnt(0)" ::: "memory");
}
__device__ __forceinline__ void rms_row_bf16(const float* xrow, const float* g, bf16r* orow, int lane) {
    const f32x4* xr = (const f32x4*)xrow + lane; const f32x4* gr = (const f32x4*)g + lane;
    f32x4 v[8]; float s = 0.f;
#pragma unroll
    for (int j = 0; j < 8; ++j) { v[j] = xr[64 * j]; s += (v[j].x * v[j].x + v[j].y * v[j].y) + (v[j].z * v[j].z + v[j].w * v[j].w); }
    const float rstd = rsqrtf(wave_sum(s) * (1.f / DM) + EPS);
    v2u* o8 = (v2u*)orow + lane;
#pragma unroll
    for (int j = 0; j < 8; ++j) { const f32x4 gg = gr[64 * j]; v2u w; w.x = pk2(v[j].x * rstd * gg.x, v[j].y * rstd * gg.y); w.y = pk2(v[j].z * rstd * gg.z, v[j].w * rstd * gg.w); o8[64 * j] = w; }
}
__device__ __forceinline__ void rms_rowb_bf16(const bf16r* xrow, const float* g, bf16r* orow, int lane) {
    const v4u* xr = (const v4u*)xrow + lane; const f32x4* gr = (const f32x4*)g + 2 * lane;
    float v[4][8]; float s = 0.f;
#pragma unroll
    for (int j = 0; j < 4; ++j) { const v4u w = xr[64 * j];
#pragma unroll
        for (int e = 0; e < 4; ++e) { v[j][2 * e] = __builtin_bit_cast(float, w[e] << 16); v[j][2 * e + 1] = __builtin_bit_cast(float, w[e] & 0xffff0000u); }
#pragma unroll
        for (int e = 0; e < 8; ++e) s += v[j][e] * v[j][e]; }
    const float rstd = rsqrtf(wave_sum(s) * (1.f / DM) + EPS);
    v4u* o8 = (v4u*)orow + lane;
#pragma unroll
    for (int j = 0; j < 4; ++j) { const f32x4 g0 = gr[128 * j], g1 = gr[128 * j + 1]; v4u w;
        w.x = pk2(v[j][0] * rstd * g0.x, v[j][1] * rstd * g0.y); w.y = pk2(v[j][2] * rstd * g0.z, v[j][3] * rstd * g0.w);
        w.z = pk2(v[j][4] * rstd * g1.x, v[j][5] * rstd * g1.y); w.w = pk2(v[j][6] * rstd * g1.z, v[j][7] * rstd * g1.w); o8[64 * j] = w; }
}
__device__ __forceinline__ void rms_rowb_f32(const bf16r* xrow, const float* g, float* orow, int lane) {
    const v4u* xr = (const v4u*)xrow + lane; const f32x4* gr = (const f32x4*)g + 2 * lane;
    float v[4][8]; float s = 0.f;
#pragma unroll
    for (int j = 0; j < 4; ++j) { const v4u w = xr[64 * j];
#pragma unroll
        for (int e = 0; e < 4; ++e) { v[j][2 * e] = __builtin_bit_cast(float, w[e] << 16); v[j][2 * e + 1] = __builtin_bit_cast(float, w[e] & 0xffff0000u); }
#pragma unroll
        for (int e = 0; e < 8; ++e) s += v[j][e] * v[j][e]; }
    const float rstd = rsqrtf(wave_sum(s) * (1.f / DM) + EPS);
    f32x4* o4 = (f32x4*)orow + 2 * lane;
#pragma unroll
    for (int j = 0; j < 4; ++j) { const f32x4 g0 = gr[128 * j], g1 = gr[128 * j + 1];
        o4[128 * j] = (f32x4){v[j][0] * rstd * g0.x, v[j][1] * rstd * g0.y, v[j][2] * rstd * g0.z, v[j][3] * rstd * g0.w};
        o4[128 * j + 1] = (f32x4){v[j][4] * rstd * g1.x, v[j][5] * rstd * g1.y, v[j][6] * rstd * g1.z, v[j][7] * rstd * g1.w}; }
}
template <int R> __device__ __forceinline__ void rms_rows_f32_to_bf16(const float* __restrict__ X, const float* __restrict__ g, bf16r* __restrict__ O, int m0, int lane) {
    f32x4 v[R][8]; float ss[R];
#pragma unroll
    for (int r = 0; r < R; ++r) { const f32x4* xr = (const f32x4*)(X + (size_t)(m0 + r) * DM) + lane;
#pragma unroll
        for (int j = 0; j < 8; ++j) v[r][j] = xr[64 * j]; }
#pragma unroll
    for (int r = 0; r < R; ++r) { float s = 0.f;
#pragma unroll
        for (int j = 0; j < 8; ++j) s += (v[r][j].x * v[r][j].x + v[r][j].y * v[r][j].y) + (v[r][j].z * v[r][j].z + v[r][j].w * v[r][j].w);
        ss[r] = s; }
#pragma unroll
    for (int o = 1; o < 64; o <<= 1) {
#pragma unroll
        for (int r = 0; r < R; ++r) ss[r] += __shfl_xor(ss[r], o); }
    const f32x4* gr = (const f32x4*)g + lane;
#pragma unroll
    for (int j = 0; j < 8; ++j) { const f32x4 gg = gr[64 * j];
#pragma unroll
        for (int r = 0; r < R; ++r) { const float rstd = rsqrtf(ss[r] * (1.f / DM) + EPS); v2u w;
            w.x = pk2(v[r][j].x * rstd * gg.x, v[r][j].y * rstd * gg.y); w.y = pk2(v[r][j].z * rstd * gg.z, v[r][j].w * rstd * gg.w);
            ((v2u*)(O + (size_t)(m0 + r) * DM) + lane)[64 * j] = w; } }
}
template <int R, bool OUT_F32> __device__ __forceinline__ void rms_rows_bf16(const bf16r* __restrict__ X, const float* __restrict__ g, void* __restrict__ O, int m0, int lane) {
    v4u w[R][4]; float ss[R];
#pragma unroll
    for (int r = 0; r < R; ++r) { const v4u* xr = (const v4u*)(X + (size_t)(m0 + r) * DM) + lane;
#pragma unroll
        for (int j = 0; j < 4; ++j) w[r][j] = xr[64 * j]; }
#pragma unroll
    for (int r = 0; r < R; ++r) { float s = 0.f;
#pragma unroll
        for (int j = 0; j < 4; ++j)
#pragma unroll
            for (int e = 0; e < 4; ++e) { const float a = __builtin_bit_cast(float, w[r][j][e] << 16), b = __builtin_bit_cast(float, w[r][j][e] & 0xffff0000u); s += a * a + b * b; }
        ss[r] = s; }
#pragma unroll
    for (int o = 1; o < 64; o <<= 1) {
#pragma unroll
        for (int r = 0; r < R; ++r) ss[r] += __shfl_xor(ss[r], o); }
    const f32x4* gr = (const f32x4*)g + 2 * lane;
#pragma unroll
    for (int j = 0; j < 4; ++j) { const f32x4 g0 = gr[128 * j], g1 = gr[128 * j + 1];
#pragma unroll
        for (int r = 0; r < R; ++r) { const float rstd = rsqrtf(ss[r] * (1.f / DM) + EPS); float v[8];
#pragma unroll
            for (int e = 0; e < 4; ++e) { v[2 * e] = __builtin_bit_cast(float, w[r][j][e] << 16) * rstd; v[2 * e + 1] = __builtin_bit_cast(float, w[r][j][e] & 0xffff0000u) * rstd; }
            if constexpr (OUT_F32) { f32x4* o4 = (f32x4*)((float*)O + (size_t)(m0 + r) * DM) + 2 * lane;
                o4[128 * j] = (f32x4){v[0] * g0.x, v[1] * g0.y, v[2] * g0.z, v[3] * g0.w}; o4[128 * j + 1] = (f32x4){v[4] * g1.x, v[5] * g1.y, v[6] * g1.z, v[7] * g1.w}; }
            else { v4u q; q.x = pk2(v[0] * g0.x, v[1] * g0.y); q.y = pk2(v[2] * g0.z, v[3] * g0.w); q.z = pk2(v[4] * g1.x, v[5] * g1.y); q.w = pk2(v[6] * g1.z, v[7] * g1.w);
                ((v4u*)((bf16r*)O + (size_t)(m0 + r) * DM) + lane)[64 * j] = q; } } }
}
__device__ __forceinline__ void rms_row_f32_inplace(float* xrow, const float* g, int lane) {
    f32x4* xr = (f32x4*)xrow + lane; const f32x4* gr = (const f32x4*)g + lane;
    f32x4 v[8]; float s = 0.f;
#pragma unroll
    for (int j = 0; j < 8; ++j) { v[j] = xr[64 * j]; s += (v[j].x * v[j].x + v[j].y * v[j].y) + (v[j].z * v[j].z + v[j].w * v[j].w); }
    const float rstd = rsqrtf(wave_sum(s) * (1.f / DM) + EPS);
#pragma unroll
    for (int j = 0; j < 8; ++j) { const f32x4 gg = gr[64 * j]; xr[64 * j] = (f32x4){v[j].x * rstd * gg.x, v[j].y * rstd * gg.y, v[j].z * rstd * gg.z, v[j].w * rstd * gg.w}; }
}

struct Args { const float* in[22]; float* out; unsigned char* ws; int ph_lo, ph_hi; };
typedef const __attribute__((address_space(4))) unsigned long long* karg_t;
__device__ __forceinline__ unsigned long long ldarg(int i) { karg_t p = (karg_t)__builtin_amdgcn_kernarg_segment_ptr(); asm volatile("" : "+s"(p) :: "memory"); return p[i]; }
#define GASP __attribute__((address_space(1)))
#define AIN(i) ((const float*)(GASP const float*)ldarg(i))
#define AOUT() ((float*)(GASP float*)ldarg(22))
#define AWS() ((unsigned char*)(GASP unsigned char*)ldarg(23))
#define WSP(off) ((bf16r*)(AWS() + (off)))

__global__ void __launch_bounds__(512) fwd_kernel(Args a) {
    extern __shared__ __attribute__((aligned(16))) unsigned char lds[];
    LAS unsigned char* ldsl = (LAS unsigned char*)lds;
    const int wave = __builtin_amdgcn_readfirstlane((int)threadIdx.x >> 6);
#define lane ((int)__builtin_amdgcn_mbcnt_hi(~0u, __builtin_amdgcn_mbcnt_lo(~0u, 0u)))
#define tid (wave * 64 + lane)
    const int G = gridDim.x, bx = blockIdx.x;
    const int gw = bx * 8 + wave, NGW = G * 8;
    const int lo = a.ph_lo, hi = a.ph_hi; int nbar = 0;
#define IN(k) (lo <= (k) && (k) < hi)
#define CBAR() do { asm volatile("s_waitcnt vmcnt(0)" ::: "memory"); ++nbar; __syncthreads(); \
            if (tid == 0) { unsigned* ctr = (unsigned*)AWS(); \
                __builtin_amdgcn_fence(__ATOMIC_RELEASE, "agent"); asm volatile("s_waitcnt vmcnt(0)" ::: "memory"); \
                __hip_atomic_fetch_add(ctr, 1u, __ATOMIC_RELAXED, __HIP_MEMORY_SCOPE_AGENT); \
                const unsigned target = (unsigned)nbar * (unsigned)G; \
                while (__hip_atomic_load(ctr, __ATOMIC_RELAXED, __HIP_MEMORY_SCOPE_AGENT) < target) __builtin_amdgcn_s_sleep(2); \
                __builtin_amdgcn_fence(__ATOMIC_ACQUIRE, "agent"); asm volatile("s_waitcnt vmcnt(0)" ::: "memory"); } \
            __syncthreads(); } while (0)
#define SEAM(k) do { if (IN(k) && IN((k) + 1)) { if ((k) == 0) { asm volatile("s_waitcnt vmcnt(0)" ::: "memory"); cg::this_grid().sync(); } else { CBAR(); } } } while (0)

    if (lo == 0 && hi > 1 && bx == 0 && tid == 0) __hip_atomic_store((unsigned*)AWS(), 0u, __ATOMIC_RELAXED, __HIP_MEMORY_SCOPE_AGENT);
    if (IN(0)) {
        unsigned char* const ws_ = AWS(); bf16r* const WIN = (bf16r*)(ws_ + WS_WIN); bf16r* const WO = (bf16r*)(ws_ + WS_WO); bf16r* const WQX = (bf16r*)(ws_ + WS_WQX); bf16r* const WKV = (bf16r*)(ws_ + WS_WKV); bf16r* const WOX = (bf16r*)(ws_ + WS_WOX); bf16r* const WGU = (bf16r*)(ws_ + WS_WGU); bf16r* const WDN = (bf16r*)(ws_ + WS_WDN); bf16r* const WPOOL = (bf16r*)(ws_ + WS_WPOOL); bf16r* const MN = (bf16r*)(ws_ + WS_MN); bf16r* const HN = (bf16r*)(ws_ + WS_HN);

        LAS float* scr = (LAS float*)(ldsl + wave * 16384);
        constexpr int I_IN = 32 * 128, I_SQ = 32 * 64, I_KV = 32 * 128, I_G = 32 * 176, I_DN = 88 * 64, I_P = 4 * 4 * 8;
        constexpr int NITEMS = I_IN + 3 * I_SQ + I_KV + 2 * I_G + I_DN + I_P;
        for (int it = gw; it < NITEMS; it += NGW) {
            int r = it;
            if (r < I_IN) { const int kb = r / 128, nb = r % 128; transpose_item(AIN(3), DIN, WIN, DM, 64 * kb, 32 * nb, 32 * nb, scr, lane); continue; } r -= I_IN;
            if (r < I_SQ) { const int kb = r / 64, nb = r % 64; transpose_item(AIN(11), DM, WO, DM, 64 * kb, 32 * nb, 32 * nb, scr, lane); continue; } r -= I_SQ;
            if (r < I_SQ) { continue; } r -= I_SQ;
            if (r < I_KV) { const int kb = r / 128, nb = r % 128; transpose_item(AIN(15), 2 * DM, WKV, DM, 64 * kb, 32 * nb, 32 * nb, scr, lane); continue; } r -= I_KV;
            if (r < I_SQ) { const int kb = r / 64, nb = r % 64; transpose_item(AIN(16), DM, WOX, DM, 64 * kb, 32 * nb, 32 * nb, scr, lane); continue; } r -= I_SQ;
            if (r < I_G) { const int kb = r / 176, nb = r % 176, n0 = 32 * nb; transpose_item(AIN(18), DFF, WGU, DM, 64 * kb, n0, 256 * (n0 >> 7) + (n0 & 127), scr, lane); continue; } r -= I_G;
            if (r < I_G) { const int kb = r / 176, nb = r % 176, n0 = 32 * nb; transpose_item(AIN(19), DFF, WGU, DM, 64 * kb, n0, 256 * (n0 >> 7) + 128 + (n0 & 127), scr, lane); continue; } r -= I_G;
            if (r < I_DN) { const int kb = r / 64, nb = r % 64; transpose_item(AIN(20), DM, WDN, DFF, 64 * kb, 32 * nb, 32 * nb, scr, lane); continue; } r -= I_DN;
            { const int gidx = r / 32, q = r % 32, kb = q / 8, nb = q % 8; transpose_item(AIN(9) + (size_t)gidx * 65536, 256, WPOOL + (size_t)gidx * 65536, 256, 64 * kb, 32 * nb, 32 * nb, scr, lane); }
        }
        { const f32x4* src = (const f32x4*)AIN(14); v4u* dst = (v4u*)WQX;
          for (int i = bx * 512 + tid; i < DM * DM / 8; i += G * 512) { const f32x4 a0 = src[2 * i], a1 = src[2 * i + 1]; v4u w; w.x = pk2(a0.x, a0.y); w.y = pk2(a0.z, a0.w); w.z = pk2(a1.x, a1.y); w.w = pk2(a1.z, a1.w); dst[i] = w; } }
        { const float* xin = AIN(0); const float* gin = AIN(2); for (int m = gw * 4; m < M; m += NGW * 4) rms_rows_f32_to_bf16<4>(xin, gin, HN, m, lane); }
        for (int m = gw; m < BATCH * MEM; m += NGW) rms_row_bf16(AIN(1) + (size_t)m * DM, AIN(13), MN + (size_t)m * DM, lane);
        __syncthreads();
    }
    SEAM(0);
    if (IN(1)) {
        unsigned char* const ws_ = AWS(); bf16r* const HN = (bf16r*)(ws_ + WS_HN); bf16r* const WIN = (bf16r*)(ws_ + WS_WIN); bf16r* const PROJ = (bf16r*)(ws_ + WS_PROJ);

        pg8::Gemm g{HN, WIN, DM, DM, DM, 1, 0, 0, 0, 0}; pg8::StaticOrder S; S.init(M, DIN, G, bx);
        pg8::EpiProj E{PROJ, PROJ + (size_t)192 * 1024 * 1024 / 2};
        pg8::gemm_phase<pg8::EpiProj, pg8::StaticOrder, true>(ldsl, ldsl + XL_OFF, g, S, E);
    }
    SEAM(1);
    if (IN(1) && IN(2)) { for (int ps_ = 0; ps_ < PROBE_SEAMS; ++ps_) CBAR(); }
    if (IN(2)) {
        unsigned char* const ws_ = AWS(); bf16r* const PROJ = (bf16r*)(ws_ + WS_PROJ); bf16r* const POOLED = (bf16r*)(ws_ + WS_POOLED); bf16r* const O16 = (bf16r*)(ws_ + WS_O16);

        {
            constexpr int RUN = 32;
            const int ntask = (M / RUN) * 128;
            for (int task = bx * 512 + tid; task < ntask; task += G * 512) {
                const int c8 = task & 127, token0 = (task >> 7) * RUN, t0 = token0 & (SEQ - 1);
                const int wl = 2 << (c8 >> 5);
                const bf16r* up = PROJ + (size_t)192 * 1024 * 1024 / 2 + (size_t)token0 * 1024 + c8 * 8;
                bf16r* op = POOLED + (size_t)token0 * 1024 + c8 * 8;
                float sacc[8];
#pragma unroll
                for (int e = 0; e < 8; ++e) sacc[e] = 0.f;
                for (int j = 1; j < wl; ++j) if (t0 - j >= 0) { const v4u w = *(const v4u*)(up - (size_t)j * 1024);
#pragma unroll
                    for (int e = 0; e < 4; ++e) { sacc[2 * e] += __builtin_bit_cast(float, w[e] << 16); sacc[2 * e + 1] += __builtin_bit_cast(float, w[e] & 0xffff0000u); } }
#pragma unroll 4
                for (int i = 0; i < RUN; ++i) {
                    const v4u w = *(const v4u*)(up + (size_t)i * 1024);
                    const int t = t0 + i; const bool full = (t + 1 >= wl);
                    const v4u wo = *(const v4u*)(up + (size_t)(full ? i - (wl - 1) : i) * 1024);
                    float u0[8];
#pragma unroll
                    for (int e = 0; e < 4; ++e) { u0[2 * e] = __builtin_bit_cast(float, w[e] << 16); u0[2 * e + 1] = __builtin_bit_cast(float, w[e] & 0xffff0000u); }
#pragma unroll
                    for (int e = 0; e < 8; ++e) sacc[e] += u0[e];
                    const float ic = 1.0f / (float)(full ? wl : t + 1);
                    v4u o;
#pragma unroll
                    for (int e = 0; e < 4; ++e) o[e] = pk2(sacc[2 * e] * ic - u0[2 * e], sacc[2 * e + 1] * ic - u0[2 * e + 1]);
                    *(v4u*)(op + (size_t)i * 1024) = o;
                    if (full) {
#pragma unroll
                        for (int e = 0; e < 4; ++e) { sacc[2 * e] -= __builtin_bit_cast(float, wo[e] << 16); sacc[2 * e + 1] -= __builtin_bit_cast(float, wo[e] & 0xffff0000u); } }
                }
            }
        }
        __syncthreads();
        att2::attn_phase2((char*)lds, (const att::bf16*)PROJ, (att::bf16*)O16, G, bx, wave);
        __syncthreads();
    }
    SEAM(2);
    if (IN(3)) {
        unsigned char* const ws_ = AWS(); bf16r* const O16 = (bf16r*)(ws_ + WS_O16); bf16r* const CONCAT = (bf16r*)(ws_ + WS_CONCAT); bf16r* const POOLED = (bf16r*)(ws_ + WS_POOLED); bf16r* const WPOOL = (bf16r*)(ws_ + WS_WPOOL); bf16r* const MN = (bf16r*)(ws_ + WS_MN); bf16r* const WKV = (bf16r*)(ws_ + WS_WKV); bf16r* const KX = (bf16r*)(ws_ + WS_KX); bf16r* const VXT = (bf16r*)(ws_ + WS_VXT);

        {
            const float* lq1 = AIN(4); const float* lk1 = AIN(5); const float* lq2 = AIN(6); const float* lk2 = AIN(7); const float* subln = AIN(8);
            const float s1 = wave_sum(lq1[lane] * lk1[lane] + lq1[lane + 64] * lk1[lane + 64]);
            const float s2 = wave_sum(lq2[lane] * lk2[lane] + lq2[lane + 64] * lk2[lane + 64]);
            const float lam = __expf(s1) - __expf(s2) + LAM_INIT;
            const f32x4 sg = *((const f32x4*)subln + lane);
            for (int m = gw; m < M; m += NGW) {
                const bf16r* orow = O16 + (size_t)m * 2048; bf16r* crow_ = CONCAT + (size_t)m * 2048;
#pragma unroll
                for (int h = 0; h < 4; ++h) {
                    const v2u w1 = *(const v2u*)(orow + h * 512 + 4 * lane), w2 = *(const v2u*)(orow + h * 512 + 256 + 4 * lane);
                    float d[4];
                    d[0] = __builtin_bit_cast(float, w1.x << 16) - lam * __builtin_bit_cast(float, w2.x << 16);
                    d[1] = __builtin_bit_cast(float, w1.x & 0xffff0000u) - lam * __builtin_bit_cast(float, w2.x & 0xffff0000u);
                    d[2] = __builtin_bit_cast(float, w1.y << 16) - lam * __builtin_bit_cast(float, w2.y << 16);
                    d[3] = __builtin_bit_cast(float, w1.y & 0xffff0000u) - lam * __builtin_bit_cast(float, w2.y & 0xffff0000u);
                    const float ss = wave_sum((d[0] * d[0] + d[1] * d[1]) + (d[2] * d[2] + d[3] * d[3]));
                    const float rstd = rsqrtf(ss * (1.f / 256.f) + EPS) * (1.0f - LAM_INIT);
                    v2u o; o.x = pk2(d[0] * rstd * sg.x, d[1] * rstd * sg.y); o.y = pk2(d[2] * rstd * sg.z, d[3] * rstd * sg.w);
                    *(v2u*)(crow_ + h * 256 + 4 * lane) = o;
                }
            }
        }
        __syncthreads();
        {
            pg8::Gemm g{POOLED, WPOOL, 1024, 256, 256, 1, 256, 0, 65536, 0}; pg8::BatchOrder S; S.init(M, 256, 4, G, bx);
            pg8::EpiBf16 E{CONCAT + 1024, DM, 1, 256, 0, AIN(10), 256};
            pg8::gemm_phase<pg8::EpiBf16, pg8::BatchOrder, true>(ldsl, ldsl + XL_OFF, g, S, E);
        }
        {
            pg8::Gemm g{MN, WKV, DM, DM, DM, 1, 0, 0, 0, 0}; pg8::StaticOrder S; S.init(BATCH * MEM, 2 * DM, G, bx);
            pg8::EpiBf16 E{KX, 2 * DM, 1, 0, 0, nullptr, 0};
            pg8::gemm_phase<pg8::EpiBf16, pg8::StaticOrder, true>(ldsl, ldsl + XL_OFF, g, S, E);
        }
    }
    SEAM(3);
    if (IN(4)) {
        unsigned char* const ws_ = AWS(); bf16r* const CONCAT = (bf16r*)(ws_ + WS_CONCAT); bf16r* const WO = (bf16r*)(ws_ + WS_WO); float* const xres = AOUT();

        pg8::Gemm g{CONCAT, WO, DM, DM, DM, 1, 0, 0, 0, 0}; pg8::StaticOrder S; S.init(M, DM, G, bx);
        pg8::EpiResX<false, true> E{AIN(0), ws_ + WS_XB, DM};
        pg8::gemm_phase<pg8::EpiResX<false, true>, pg8::StaticOrder, true>(ldsl, ldsl + XL_OFF, g, S, E);
    }
    SEAM(4);
    if (IN(5)) {
        unsigned char* const ws_ = AWS(); bf16r* const HN = (bf16r*)(ws_ + WS_HN); float* const xres = AOUT();
 { const float* gin = AIN(12); for (int m = gw * 4; m < M; m += NGW * 4) rms_rows_bf16<4, false>((const bf16r*)(ws_ + WS_XB), gin, HN, m, lane); }
        bf16r* const KV = (bf16r*)(ws_ + WS_KX); bf16r* const WQN = (bf16r*)(ws_ + WS_WQX); bf16r* const WOXt = (bf16r*)(ws_ + WS_WOX);
        __syncthreads();
        {   pg8::Gemm g{KV, WQN, 2 * DM, DM, 512, 4, (long)MEM * 2 * DM, 512, 0, 512}; pg8::BatchOrder S; S.init(MEM, DM, 8, G, bx);
            pg8::EpiBf16 E{(bf16r*)(ws_ + WS_WQK), DM, 4, (long)1024 * DM, (long)MEM * DM, nullptr, 0};
            pg8::gemm_phase<pg8::EpiBf16, pg8::BatchOrder, true>(ldsl, ldsl + XL_OFF, g, S, E); }
        {   pg8::Gemm g{WOXt, KV + 2048, DM, 2 * DM, 512, 4, 0, 512, (long)MEM * 2 * DM, 512}; pg8::BatchOrder S; S.init(DM, MEM, 8, G, G - 1 - bx);
            pg8::EpiBf16 E{(bf16r*)(ws_ + WS_VWT), 1024, 4, (long)DM * 1024, MEM, nullptr, 0};
            pg8::gemm_phase<pg8::EpiBf16, pg8::BatchOrder, true>(ldsl, ldsl + XL_OFF, g, S, E); }
    }
    SEAM(5);
    if (IN(6)) {
        unsigned char* const ws_ = AWS(); bf16r* const HN = (bf16r*)(ws_ + WS_HN); bf16r* const PSC = (bf16r*)(ws_ + WS_PSC);
        pg8::Gemm g{HN, (bf16r*)(ws_ + WS_WQK), DM, DM, DM, 1, 0, 0, (long)1024 * DM, 0}; pg8::StaticOrderZ S; S.init(M, 1024, G, bx); S.zdiv = SEQ / 256;
        pg8::EpiSoftmax E{PSC, 0, 0.044194173824159216f * 1.4426950408889634f, 1024};
        pg8::gemm_phase<pg8::EpiSoftmax, pg8::StaticOrderZ, true>(ldsl, ldsl + XL_OFF, g, S, E);
    }
    SEAM(6);
    if (IN(9)) {
        unsigned char* const ws_ = AWS(); bf16r* const PSC = (bf16r*)(ws_ + WS_PSC);
        pg8::Gemm g{PSC, (bf16r*)(ws_ + WS_VWT), 1024, 1024, 1024, 1, 0, 0, (long)DM * 1024, 0}; pg8::StaticOrderZ S; S.init(M, DM, G, bx); S.zdiv = SEQ / 256;
        pg8::EpiResX<true, true> E{ws_ + WS_XB, ws_ + WS_XB, DM};
        pg8::gemm_phase<pg8::EpiResX<true, true>, pg8::StaticOrderZ, true>(ldsl, ldsl + XL_OFF, g, S, E);
    }
    SEAM(9);
    if (IN(10)) {
        unsigned char* const ws_ = AWS(); bf16r* const HN = (bf16r*)(ws_ + WS_HN); float* const xres = AOUT();
 { const float* gin = AIN(17); for (int m = gw * 4; m < M; m += NGW * 4) rms_rows_bf16<4, false>((const bf16r*)(ws_ + WS_XB), gin, HN, m, lane); } }
    SEAM(10);
    if (IN(11)) {
        unsigned char* const ws_ = AWS(); bf16r* const HN = (bf16r*)(ws_ + WS_HN); bf16r* const WGU = (bf16r*)(ws_ + WS_WGU); bf16r* const HID = (bf16r*)(ws_ + WS_HID);

        pg8::Gemm g{HN, WGU, DM, DM, DM, 1, 0, 0, 0, 0}; pg8::StaticOrder S; S.init(M, 2 * DFF, G, bx);
        pg8::EpiSwiGLU E{HID, DFF};
        pg8::gemm_phase<pg8::EpiSwiGLU, pg8::StaticOrder, true>(ldsl, ldsl + XL_OFF, g, S, E);
    }
    SEAM(11);
    if (IN(12)) {
        unsigned char* const ws_ = AWS(); bf16r* const HID = (bf16r*)(ws_ + WS_HID); bf16r* const WDN = (bf16r*)(ws_ + WS_WDN); float* const xres = AOUT();

        pg8::Gemm g{HID, WDN, DFF, DFF, DFF, 1, 0, 0, 0, 0}; pg8::StaticOrder S; S.init(M, DM, G, bx);
        pg8::EpiResX<true, true> E{ws_ + WS_XB, ws_ + WS_XB, DM};
        pg8::gemm_phase<pg8::EpiResX<true, true>, pg8::StaticOrder, true>(ldsl, ldsl + XL_OFF, g, S, E);
    }
    SEAM(12);
    if (IN(13)) {
        unsigned char* const ws_ = AWS(); float* const xres = AOUT();
 { const float* gin = AIN(21); for (int m = gw * 4; m < M; m += NGW * 4) rms_rows_bf16<4, true>((const bf16r*)(ws_ + WS_XB), gin, xres, m, lane); } }
#undef IN
#undef SEAM
#undef lane
#undef tid
}

extern "C" void kernel_launch(void* const* d_in, const int* in_sizes, int n_in, void* d_out, int out_size, void* d_ws, size_t ws_size, hipStream_t stream) {
    static int grid = 0;
    if (grid == 0) {
        if (n_in != 22 || in_sizes[0] != M * DM || out_size != M * DM || ws_size < WS_END) {
            fprintf(stderr, "kernel_launch: unexpected shapes n_in %d in0 %d out %d ws %zu (need %zu)\n", n_in, n_in > 0 ? in_sizes[0] : -1, out_size, ws_size, (size_t)WS_END); grid = -1; return; }
        int dev = 0, cus = 0, per_cu = 0;
        (void)hipGetDevice(&dev); (void)hipDeviceGetAttribute(&cus, hipDeviceAttributeMultiprocessorCount, dev);
        if (hipFuncSetAttribute((const void*)fwd_kernel, hipFuncAttributeMaxDynamicSharedMemorySize, LDS_BYTES) != hipSuccess) { fprintf(stderr, "kernel_launch: hipFuncSetAttribute failed\n"); grid = -1; return; }
        if (hipOccupancyMaxActiveBlocksPerMultiprocessor(&per_cu, (const void*)fwd_kernel, 512, LDS_BYTES) != hipSuccess || per_cu < 1) { fprintf(stderr, "kernel_launch: occupancy query gave %d\n", per_cu); per_cu = 1; }
        (void)hipGetLastError();
        if (cus <= 0) cus = 256;
        grid = cus * per_cu;
        if (grid > 256) grid = 256;
    }
    if (grid < 0) return;
    Args a{};
    for (int i = 0; i < 22; ++i) a.in[i] = (const float*)d_in[i];
    a.out = (float*)d_out; a.ws = (unsigned char*)d_ws;
#if MK_PER_PHASE
    for (int p = 0; p < NPHASE; ++p) { a.ph_lo = p; a.ph_hi = p + 1; hipLaunchKernelGGL(fwd_kernel, dim3(grid), dim3(512), LDS_BYTES, stream, a); }
#else
    const int cuts[4] = {0, PROBE_DUP >= 0 ? PROBE_DUP + 1 : NPHASE, PROBE_DUP >= 0 ? PROBE_DUP + 1 : NPHASE, NPHASE};
    for (int li = 0; li < (PROBE_DUP >= 0 ? 3 : 1); ++li) {
        a.ph_lo = cuts[li]; a.ph_hi = cuts[li + 1];
        if (PROBE_DUP >= 0 && li == 1) { a.ph_lo = PROBE_DUP; a.ph_hi = PROBE_DUP + 1; }
        if (!(a.ph_lo == 0 && a.ph_hi > 1)) (void)hipMemsetAsync(d_ws, 0, 256, stream);
        void* args[] = {&a};
        hipError_t e = hipLaunchCooperativeKernel((const void*)fwd_kernel, dim3(grid), dim3(512), args, LDS_BYTES, stream);
        if (e != hipSuccess) fprintf(stderr, "cooperative launch failed: %s (grid %d)\n", hipGetErrorString(e), grid);
    }
#endif
}
```

```cpp
#include <hip/hip_runtime.h>
#include <hip/hip_bf16.h>
#include <hip/hip_cooperative_groups.h>
#include <cstdio>
#include <cstdint>
namespace cg = cooperative_groups;

#ifndef PROBE_DUP
#define PROBE_DUP -1
#endif
#ifndef PROBE_SEAMS
#define PROBE_SEAMS 0
#endif
#ifndef MK_PER_PHASE
#define MK_PER_PHASE 0
#endif

constexpr int BATCH = 2, SEQ = 16384, DM = 2048, MEM = 256, DIN = 4096, DFF = 5632;
constexpr int M = BATCH * SEQ;
constexpr float EPS = 1e-6f;
constexpr float LAM_INIT = 0.2f;

namespace pg8 {
#define PG8_LAS __attribute__((address_space(3)))
typedef unsigned short bf16_t;
typedef short bf16x8 __attribute__((ext_vector_type(8)));
typedef float f32x4 __attribute__((ext_vector_type(4)));
typedef unsigned u32x4 __attribute__((ext_vector_type(4)));
constexpr int BM = 256, BK = 64, HALF = 128, HTB = HALF * BK * 2, STAGE_BYTES = 8 * HTB, NXCD = 8, WGM = 8;

__host__ __device__ __forceinline__ int lds_byte(int r, int c) { const int st = (r >> 4) * 2 + (c >> 5), rr = r & 15, cc = c & 31, ob = rr * 64 + cc * 2; return st * 1024 + (ob ^ (((ob >> 9) & 1) << 5)); }
__host__ __device__ __forceinline__ void stage_rc(int b, int& R, int& C) { const int st = b / 1024, sb = b % 1024, swz = sb ^ (((sb >> 9) & 1) << 5); R = (st >> 1) * 16 + swz / 64; C = (st & 1) * 32 + (swz % 64) / 2; }
__host__ __device__ __forceinline__ int perm32(int rho) { const int n = rho >> 4, i = rho & 15; return 8 * (i >> 2) + 4 * n + (i & 3); }

struct Unit { int pm, pn, z; };
struct Gemm { const bf16_t* A; const bf16_t* Bt; int lda, ldb, K, ZH; long sAb, sAh, sBb, sBh; };

struct StaticOrder {
    int nM, nN, nwg, G, c;
    __device__ void init(int Mr, int N, int G_, int c_) { nM = Mr / BM; nN = N / BM; nwg = nM * nN; G = G_; c = c_; }
    __device__ bool next(int i, Unit& u) const {
        const long L = (long)i * G + c; if (L >= nwg) return false;
        int wgid = (int)L; { const int q = nwg / NXCD, r = nwg % NXCD, xcd = wgid % NXCD, off = wgid / NXCD; wgid = (xcd < r ? xcd * (q + 1) : r * (q + 1) + (xcd - r) * q) + off; }
        const int nig = WGM * nN, gid = wgid / nig, fm = gid * WGM, gsz = (nM - fm) < WGM ? (nM - fm) : WGM;
        u.pm = fm + ((wgid % nig) % gsz); u.pn = (wgid % nig) / gsz; u.z = 0; return true;
    }
};
struct StaticOrderZ : StaticOrder {
    int zdiv;
    __device__ bool next(int i, Unit& u) const { if (!StaticOrder::next(i, u)) return false; u.z = u.pm / zdiv; return true; }
};
struct BatchOrder {
    int nM, nN, nwg, G, c;
    __device__ void init(int Mr, int N, int Z, int G_, int c_) { nM = Mr / BM; nN = N / BM; nwg = nM * nN * Z; G = G_; c = c_; }
    __device__ bool next(int i, Unit& u) const {
        const long L = (long)i * G + c; if (L >= nwg) return false;
        int l = (int)L; u.pn = l % nN; l /= nN; u.pm = l % nM; u.z = l / nM; return true;
    }
};

__device__ __forceinline__ unsigned cvt_pk_bf16(float lo, float hi) { unsigned r; asm volatile("v_cvt_pk_bf16_f32 %0, %1, %2" : "=v"(r) : "v"(lo), "v"(hi)); return r; }

typedef f32x4 Acc[2][2][4][2];

struct EpiBf16 {
    static constexpr bool PERM = true;
    bf16_t* O; int ldc, ZH; long sOb, sOh; const float* cscale; int nsc;
    __device__ __forceinline__ void operator()(Acc& acc, const Unit& u, int wr, int wc, int fr, int fq, PG8_LAS unsigned char*) const {
        const int row0 = u.pm * BM + wr * 64 + fr, col0 = u.pn * BM + wc * 32 + 8 * fq;
        bf16_t* base = O + (size_t)(u.z / ZH) * sOb + (size_t)(u.z % ZH) * sOh;
        f32x4 sv[2][2];
#pragma unroll
        for (int bj = 0; bj < 2; ++bj)
#pragma unroll
            for (int n = 0; n < 2; ++n) sv[bj][n] = cscale ? *(const f32x4*)(cscale + (size_t)u.z * nsc + col0 + bj * HALF + 4 * n) : (f32x4){1.f, 1.f, 1.f, 1.f};
#pragma unroll
        for (int ai = 0; ai < 2; ++ai)
#pragma unroll
            for (int m = 0; m < 4; ++m) { bf16_t* rowp = base + (size_t)(row0 + ai * HALF + m * 16) * ldc + col0;
#pragma unroll
                for (int bj = 0; bj < 2; ++bj) { f32x4 v0 = acc[ai][bj][m][0] * sv[bj][0], v1 = acc[ai][bj][m][1] * sv[bj][1];
                    u32x4 w; w.x = cvt_pk_bf16(v0[0], v0[1]); w.y = cvt_pk_bf16(v0[2], v0[3]); w.z = cvt_pk_bf16(v1[0], v1[1]); w.w = cvt_pk_bf16(v1[2], v1[3]);
                    *(u32x4*)(rowp + bj * HALF) = w; } }
    }
};
template <bool BASE_BF16, bool OUT_BF16> struct EpiResX {
    static constexpr bool PERM = true;
    const void* base; void* out; int ldc;
    __device__ __forceinline__ void operator()(Acc& acc, const Unit& u, int wr, int wc, int fr, int fq, PG8_LAS unsigned char*) const {
        const int col0 = u.pn * BM + wc * 32 + 8 * fq;
#pragma unroll
        for (int ai = 0; ai < 2; ++ai)
#pragma unroll
            for (int m = 0; m < 4; ++m) { const int r = ai * HALF + wr * 64 + m * 16 + fr; const size_t off = (size_t)(u.pm * BM + r) * ldc + col0;
                f32x4 bs[2][2];
#pragma unroll
                for (int bj = 0; bj < 2; ++bj) {
                    if constexpr (BASE_BF16) { const u32x4 w = *(const u32x4*)((const bf16_t*)base + off + bj * HALF);
                        bs[bj][0] = (f32x4){__builtin_bit_cast(float, w.x << 16), __builtin_bit_cast(float, w.x & 0xffff0000u), __builtin_bit_cast(float, w.y << 16), __builtin_bit_cast(float, w.y & 0xffff0000u)};
                        bs[bj][1] = (f32x4){__builtin_bit_cast(float, w.z << 16), __builtin_bit_cast(float, w.z & 0xffff0000u), __builtin_bit_cast(float, w.w << 16), __builtin_bit_cast(float, w.w & 0xffff0000u)}; }
                    else { bs[bj][0] = *(const f32x4*)((const float*)base + off + bj * HALF); bs[bj][1] = *(const f32x4*)((const float*)base + off + bj * HALF + 4); } }
#pragma unroll
                for (int bj = 0; bj < 2; ++bj) { const f32x4 v0 = bs[bj][0] + acc[ai][bj][m][0], v1 = bs[bj][1] + acc[ai][bj][m][1];
                    if constexpr (OUT_BF16) { u32x4 w; w.x = cvt_pk_bf16(v0[0], v0[1]); w.y = cvt_pk_bf16(v0[2], v0[3]); w.z = cvt_pk_bf16(v1[0], v1[1]); w.w = cvt_pk_bf16(v1[2], v1[3]);
                        *(u32x4*)((bf16_t*)out + off + bj * HALF) = w; }
                    else { *(f32x4*)((float*)out + off + bj * HALF) = v0; *(f32x4*)((float*)out + off + bj * HALF + 4) = v1; } }
                asm volatile("" ::: "memory"); }
    }
};
struct EpiProj {
    static constexpr bool PERM = true;
    bf16_t* QKVH; bf16_t* U;
    __device__ __forceinline__ void operator()(Acc& acc, const Unit& u, int wr, int wc, int fr, int fq, PG8_LAS unsigned char*) const {
        const int row0 = u.pm * BM + wr * 64 + fr, b = (u.pm * BM) / SEQ, s0 = row0 - b * SEQ, cin = wc * 32 + 8 * fq;
#pragma unroll
        for (int ai = 0; ai < 2; ++ai)
#pragma unroll
            for (int m = 0; m < 4; ++m) {
#pragma unroll
                for (int bj = 0; bj < 2; ++bj) { const f32x4 v0 = acc[ai][bj][m][0], v1 = acc[ai][bj][m][1];
                    u32x4 w; w.x = cvt_pk_bf16(v0[0], v0[1]); w.y = cvt_pk_bf16(v0[2], v0[3]); w.z = cvt_pk_bf16(v1[0], v1[1]); w.w = cvt_pk_bf16(v1[2], v1[3]);
                    bf16_t* dst = (u.pn < 12) ? QKVH + ((size_t)(b * 24 + u.pn * 2 + bj) * SEQ + (s0 + ai * HALF + m * 16)) * 128 + cin
                                              : U + (size_t)(row0 + ai * HALF + m * 16) * 1024 + (u.pn - 12) * 256 + bj * HALF + cin;
                    *(u32x4*)dst = w; } }
    }
};
struct EpiResF32 {
    static constexpr bool PERM = false;
    const float* base; float* out; int ldc;
    __device__ __forceinline__ void operator()(Acc& acc, const Unit& u, int wr, int wc, int fr, int fq, PG8_LAS unsigned char*) const {
        const int col0 = u.pn * BM + wc * 32 + 4 * fq;
#pragma unroll
        for (int ai = 0; ai < 2; ++ai)
#pragma unroll
            for (int m = 0; m < 4; ++m) { const int r = ai * HALF + wr * 64 + m * 16 + fr; const size_t off = (size_t)(u.pm * BM + r) * ldc + col0;
                f32x4 bs[2][2];
#pragma unroll
                for (int bj = 0; bj < 2; ++bj)
#pragma unroll
                    for (int n = 0; n < 2; ++n) bs[bj][n] = *(const f32x4*)(base + off + bj * HALF + n * 16);
#pragma unroll
                for (int bj = 0; bj < 2; ++bj)
#pragma unroll
                    for (int n = 0; n < 2; ++n) *(f32x4*)(out + off + bj * HALF + n * 16) = bs[bj][n] + acc[ai][bj][m][n];
                asm volatile("" ::: "memory"); }
    }
};
struct EpiSwiGLU {
    static constexpr bool PERM = true;
    bf16_t* O; int ldc;
    __device__ __forceinline__ void operator()(Acc& acc, const Unit& u, int wr, int wc, int fr, int fq, PG8_LAS unsigned char*) const {
        const int row0 = u.pm * BM + wr * 64 + fr, col0 = u.pn * HALF + wc * 32 + 8 * fq;
#pragma unroll
        for (int ai = 0; ai < 2; ++ai)
#pragma unroll
            for (int m = 0; m < 4; ++m) { bf16_t* rowp = O + (size_t)(row0 + ai * HALF + m * 16) * ldc + col0;
                float h[8];
#pragma unroll
                for (int n = 0; n < 2; ++n)
#pragma unroll
                    for (int e = 0; e < 4; ++e) { const float gt = acc[ai][0][m][n][e], up = acc[ai][1][m][n][e];
                        const float sg = __builtin_amdgcn_rcpf(1.f + __builtin_amdgcn_exp2f(-1.4426950408889634f * gt));
                        h[n * 4 + e] = gt * sg * up; }
                u32x4 w; w.x = cvt_pk_bf16(h[0], h[1]); w.y = cvt_pk_bf16(h[2], h[3]); w.z = cvt_pk_bf16(h[4], h[5]); w.w = cvt_pk_bf16(h[6], h[7]);
                *(u32x4*)rowp = w; }
    }
};
struct EpiSoftmax {
    static constexpr bool PERM = true;
    bf16_t* O; long sOz; float sc2; int ldc;
    __device__ __forceinline__ void operator()(Acc& acc, const Unit& u, int wr, int wc, int fr, int fq, PG8_LAS unsigned char* xl) const {
        PG8_LAS float* MX = (PG8_LAS float*)xl;
        PG8_LAS float* SMv = (PG8_LAS float*)(xl + 4096);
#pragma unroll
        for (int ai = 0; ai < 2; ++ai)
#pragma unroll
            for (int m = 0; m < 4; ++m) { float mx = -3.0e38f;
#pragma unroll
                for (int bj = 0; bj < 2; ++bj)
#pragma unroll
                    for (int n = 0; n < 2; ++n) { f32x4 s = acc[ai][bj][m][n] * sc2; acc[ai][bj][m][n] = s; mx = fmaxf(mx, fmaxf(fmaxf(s[0], s[1]), fmaxf(s[2], s[3]))); }
                mx = fmaxf(mx, __shfl_xor(mx, 16)); mx = fmaxf(mx, __shfl_xor(mx, 32));
                if (fq == 0) MX[(ai * HALF + wr * 64 + m * 16 + fr) * 4 + wc] = mx; }
        asm volatile("s_waitcnt lgkmcnt(0)" ::: "memory"); __builtin_amdgcn_s_barrier(); asm volatile("" ::: "memory");
#pragma unroll
        for (int ai = 0; ai < 2; ++ai)
#pragma unroll
            for (int m = 0; m < 4; ++m) { const int r = ai * HALF + wr * 64 + m * 16 + fr;
                const f32x4 q = *(const PG8_LAS f32x4*)(MX + r * 4); const float rm = fmaxf(fmaxf(q[0], q[1]), fmaxf(q[2], q[3]));
                float sm = 0.f;
#pragma unroll
                for (int bj = 0; bj < 2; ++bj)
#pragma unroll
                    for (int n = 0; n < 2; ++n) { f32x4 s = acc[ai][bj][m][n];
#pragma unroll
                        for (int e = 0; e < 4; ++e) { s[e] = __builtin_amdgcn_exp2f(s[e] - rm); sm += s[e]; }
                        acc[ai][bj][m][n] = s; }
                sm += __shfl_xor(sm, 16); sm += __shfl_xor(sm, 32);
                if (fq == 0) SMv[r * 4 + wc] = sm; }
        asm volatile("s_waitcnt lgkmcnt(0)" ::: "memory"); __builtin_amdgcn_s_barrier(); asm volatile("" ::: "memory");
        const int row0 = u.pm * BM + wr * 64 + fr, col0 = wc * 32 + 8 * fq;
        bf16_t* base = O + (size_t)u.z * sOz;
#pragma unroll
        for (int ai = 0; ai < 2; ++ai)
#pragma unroll
            for (int m = 0; m < 4; ++m) { const int r = ai * HALF + wr * 64 + m * 16 + fr;
                const f32x4 q = *(const PG8_LAS f32x4*)(SMv + r * 4); const float inv = 1.0f / ((q[0] + q[1]) + (q[2] + q[3]));
                bf16_t* rowp = base + (size_t)(row0 + ai * HALF + m * 16) * ldc + u.pn * BM + col0;
#pragma unroll
                for (int bj = 0; bj < 2; ++bj) { const f32x4 v0 = acc[ai][bj][m][0] * inv, v1 = acc[ai][bj][m][1] * inv;
                    u32x4 w; w.x = cvt_pk_bf16(v0[0], v0[1]); w.y = cvt_pk_bf16(v0[2], v0[3]); w.z = cvt_pk_bf16(v1[0], v1[1]); w.w = cvt_pk_bf16(v1[2], v1[3]);
                    *(u32x4*)(rowp + bj * HALF) = w; } }
    }
};

template <class Epi, class Sched, bool ALIGN_EPI>
__device__ __forceinline__ void gemm_phase(PG8_LAS unsigned char* lds, PG8_LAS unsigned char* xl, const Gemm g, const Sched& S, const Epi& E) {
    const int tid = threadIdx.x, wid = __builtin_amdgcn_readfirstlane(tid >> 6), lane = tid & 63, wr = wid >> 2, wc = wid & 3, fr = lane & 15, fq = lane >> 4;
    const int K = g.K, nt = K / BK;
    unsigned voffA[2], voffB[2];
#pragma unroll
    for (int i = 0; i < 2; ++i) { int R, C; stage_rc(tid * 16 + i * 8192, R, C); const int Rb = Epi::PERM ? ((R & ~31) + perm32(R & 31)) : R;
        voffA[i] = (unsigned)(R * g.lda + C) * 2u; voffB[i] = (unsigned)(Rb * g.ldb + C) * 2u; }
    const size_t kstep = (size_t)(BK * 2);
    const size_t hstepA = (size_t)HALF * g.lda * 2, hstepB = (size_t)HALF * g.ldb * 2;
    const unsigned ldsw = (unsigned)wid * 1024u;
    const int aoff = lds_byte(wr * 64 + fr, fq * 8), boff = lds_byte(wc * 32 + fr, fq * 8);
#define PG8_APTR(u_) ((const char*)g.A + 2 * ((size_t)((u_).z / g.ZH) * g.sAb + (size_t)((u_).z % g.ZH) * g.sAh) + (size_t)(u_).pm * 2 * hstepA)
#define PG8_BPTR(u_) ((const char*)g.Bt + 2 * ((size_t)((u_).z / g.ZH) * g.sBb + (size_t)((u_).z % g.ZH) * g.sBh) + (size_t)(u_).pn * 2 * hstepB)
#define PG8_SA(b, h) (((b) * 2 + (h)) * HTB)
#define PG8_SB(b, h) ((4 + (b) * 2 + (h)) * HTB)
#define PG8_STAGE(bufoff, gbase, voff) do { _Pragma("unroll") for (int _i = 0; _i < 2; ++_i) \
        __builtin_amdgcn_global_load_lds((const unsigned*)((const char*)(gbase) + (voff)[_i]), (PG8_LAS unsigned*)(lds + (bufoff) + ldsw + _i * 8192), 16, 0, 0); } while (0)
#define PG8_LDA(dst, b, h) do { _Pragma("unroll") for (int m = 0; m < 4; ++m) _Pragma("unroll") for (int k = 0; k < 2; ++k) dst[m][k] = *(const PG8_LAS bf16x8*)(lds + PG8_SA(b, h) + aoff + m * 2048 + k * 1024); } while (0)
#define PG8_LDB(dst, b, h) do { _Pragma("unroll") for (int n = 0; n < 2; ++n) _Pragma("unroll") for (int k = 0; k < 2; ++k) dst[n][k] = *(const PG8_LAS bf16x8*)(lds + PG8_SB(b, h) + boff + n * 2048 + k * 1024); } while (0)
#define PG8_MMA(ai, bj, At, Bt) do { __builtin_amdgcn_s_setprio(1); _Pragma("unroll") for (int m = 0; m < 4; ++m) _Pragma("unroll") for (int n = 0; n < 2; ++n) _Pragma("unroll") for (int k = 0; k < 2; ++k) \
        acc[ai][bj][m][n] = __builtin_amdgcn_mfma_f32_16x16x32_bf16(Bt[n][k], At[m][k], acc[ai][bj][m][n], 0, 0, 0); __builtin_amdgcn_s_setprio(0); } while (0)
#define PG8_WAIT_V(n) asm volatile("s_waitcnt vmcnt(" #n ")" ::: "memory")
#define PG8_WAIT_L(n) asm volatile("s_waitcnt lgkmcnt(" #n ")" ::: "memory")
#define PG8_BAR __builtin_amdgcn_s_barrier()
#define PG8_SCHED __builtin_amdgcn_sched_barrier(0)
    Unit cur, nxt; int ui = 0;
    if (!S.next(0, cur)) return;
    Acc acc;
#pragma unroll
    for (int a = 0; a < 2; ++a)
#pragma unroll
        for (int b = 0; b < 2; ++b)
#pragma unroll
            for (int m = 0; m < 4; ++m)
#pragma unroll
                for (int n = 0; n < 2; ++n) acc[a][b][m][n] = (f32x4){0.f, 0.f, 0.f, 0.f};
    bf16x8 At[4][2], B0[2][2], B1[2][2];
    const char* cA = PG8_APTR(cur); const char* cB = PG8_BPTR(cur);
    PG8_STAGE(PG8_SB(0, 0), cB, voffB); PG8_STAGE(PG8_SB(0, 1), cB + hstepB, voffB); PG8_STAGE(PG8_SA(0, 0), cA, voffA); PG8_STAGE(PG8_SA(0, 1), cA + hstepA, voffA);
    if (wr == 1) PG8_BAR;
    PG8_WAIT_V(2); PG8_BAR;
    PG8_STAGE(PG8_SB(1, 0), cB + kstep, voffB); PG8_STAGE(PG8_SA(1, 0), cA + kstep, voffA); PG8_STAGE(PG8_SB(1, 1), cB + hstepB + kstep, voffB);
    PG8_WAIT_V(6); PG8_BAR;
    for (;;) {
        const bool has_next = S.next(ui + 1, nxt);
        const char* nA = has_next ? PG8_APTR(nxt) : cA; const char* nB = has_next ? PG8_BPTR(nxt) : cB;
        for (int t = 0; t < nt; t += 2) {
            const bool last = (t == nt - 2);
            const char* a1 = cA + (size_t)(t + 1) * kstep;
            const char* a2 = last ? nA : cA + (size_t)(t + 2) * kstep; const char* b2 = last ? nB : cB + (size_t)(t + 2) * kstep;
            const char* a3 = a2 + kstep; const char* b3 = b2 + kstep;
            PG8_LDB(B0, 0, 0); PG8_LDB(B1, 0, 1); PG8_SCHED; PG8_LDA(At, 0, 0); PG8_STAGE(PG8_SA(1, 1), a1 + hstepA, voffA);
            PG8_WAIT_V(8); PG8_WAIT_L(0); PG8_BAR; PG8_MMA(0, 0, At, B0); PG8_MMA(0, 1, At, B1); PG8_BAR; PG8_SCHED;
            PG8_LDA(At, 0, 1); PG8_STAGE(PG8_SB(0, 0), b2, voffB); PG8_STAGE(PG8_SB(0, 1), b2 + hstepB, voffB); PG8_STAGE(PG8_SA(0, 0), a2, voffA);
            PG8_WAIT_V(8); PG8_WAIT_L(0); PG8_BAR; PG8_MMA(1, 0, At, B0); PG8_MMA(1, 1, At, B1); PG8_BAR; PG8_SCHED;
            PG8_LDB(B0, 1, 0); PG8_LDB(B1, 1, 1); PG8_SCHED; PG8_LDA(At, 1, 0); PG8_STAGE(PG8_SA(0, 1), a2 + hstepA, voffA);
            PG8_WAIT_V(8); PG8_WAIT_L(0); PG8_BAR; PG8_MMA(0, 0, At, B0); PG8_MMA(0, 1, At, B1); PG8_BAR; PG8_SCHED;
            PG8_LDA(At, 1, 1); PG8_STAGE(PG8_SB(1, 0), b3, voffB); PG8_STAGE(PG8_SB(1, 1), b3 + hstepB, voffB); PG8_STAGE(PG8_SA(1, 0), a3, voffA);
            PG8_WAIT_V(8); PG8_WAIT_L(0); PG8_BAR; PG8_MMA(1, 0, At, B0); PG8_MMA(1, 1, At, B1); PG8_BAR; PG8_SCHED;
        }
        if constexpr (ALIGN_EPI) { if (wr == 0) PG8_BAR; }
        E(acc, cur, wr, wc, fr, fq, xl);
        if (!has_next) break;
#pragma unroll
        for (int a = 0; a < 2; ++a)
#pragma unroll
            for (int b = 0; b < 2; ++b)
#pragma unroll
                for (int m = 0; m < 4; ++m)
#pragma unroll
                    for (int n = 0; n < 2; ++n) acc[a][b][m][n] = (f32x4){0.f, 0.f, 0.f, 0.f};
        cur = nxt; cA = nA; cB = nB; ++ui;
        if constexpr (ALIGN_EPI) { if (wr == 1) PG8_BAR; }
    }
    PG8_WAIT_V(0);
    if constexpr (!ALIGN_EPI) { if (wr == 0) PG8_BAR; }
    PG8_BAR;
#undef PG8_APTR
#undef PG8_BPTR
#undef PG8_SA
#undef PG8_SB
#undef PG8_STAGE
#undef PG8_LDA
#undef PG8_LDB
#undef PG8_MMA
#undef PG8_WAIT_V
#undef PG8_WAIT_L
#undef PG8_BAR
#undef PG8_SCHED
}
}

namespace att {
constexpr int D = 128;
constexpr int PIN = DIN;
constexpr int POUT = 2048;
constexpr float SCALE = 0.08838834764831845f;
constexpr float THR = 8.f;
constexpr int NW = 8, QBLK = 32, KVBLK = 64, QB = NW * QBLK;
constexpr int SHM_V = KVBLK * D * 2, SHM_K = KVBLK * D * 2;
constexpr int LDS_BYTES = 2 * SHM_V + 2 * SHM_K + NW * 64 * 4;
using bf16 = __hip_bfloat16;
typedef short bf16x8 __attribute__((ext_vector_type(8)));
typedef short s16x4 __attribute__((ext_vector_type(4)));
typedef float f32x16 __attribute__((ext_vector_type(16)));
typedef float f32x4 __attribute__((ext_vector_type(4)));
typedef unsigned u32x4 __attribute__((ext_vector_type(4)));

#define KSWZ(row, colB) ((row) * 256 + ((colB) ^ (((row) & 7) << 4)))
#define SBAR() __builtin_amdgcn_sched_barrier(0)
__device__ __forceinline__ int v_st(int k, int c) { const int kk = (k & ~0xC) | ((k & 4) << 1) | ((k & 8) >> 1); return ((kk >> 3) * 4 + (c >> 5)) * 512 + ((kk & 7) * 32 + (c & 31)) * 2; }
__device__ __forceinline__ int v_rd_base(int lane) { return ((lane & 3) << 3) | (((lane >> 2) & 3) << 6) | (((lane >> 4) & 1) << 5) | (((lane >> 5) & 1) << 8); }
constexpr int v_rd_off(int d0, int ks, int half) { return d0 * 512 + ks * 4096 + half * 2048; }
__device__ __forceinline__ int crow(int r, int hi) { return (r & 3) + 8 * (r >> 2) + 4 * hi; }
__device__ __forceinline__ unsigned cvtpk(float lo, float hi) { unsigned r; asm volatile("v_cvt_pk_bf16_f32 %0, %1, %2" : "=v"(r) : "v"(lo), "v"(hi)); return r; }
__device__ __forceinline__ bf16x8 load8(const bf16* p) { return *reinterpret_cast<const bf16x8*>(p); }
__device__ __forceinline__ void mask_tile(f32x16& p0, f32x16& p1, int dq, unsigned W) {
    const float NEG = -__builtin_inff();
#pragma unroll
    for (int r = 0; r < 16; ++r) {
        const int c = (r & 3) + 8 * (r >> 2);
        if ((unsigned)(dq - c) >= W) p0[r] = NEG;
        if ((unsigned)(dq - c - 32) >= W) p1[r] = NEG;
    }
}
__device__ __forceinline__ void partialSM(f32x16& p0, f32x16& p1, float& m_reg, float& mn, float& alpha) {
    float pmax = p0[0]; for (int r = 1; r < 16; ++r) pmax = fmaxf(pmax, p0[r]); for (int r = 0; r < 16; ++r) pmax = fmaxf(pmax, p1[r]);
    { auto rr = __builtin_amdgcn_permlane32_swap(__float_as_uint(pmax), __float_as_uint(pmax), false, false);
      pmax = fmaxf(__uint_as_float(rr[0]), __uint_as_float(rr[1])); }
    constexpr float C2 = 1.4426950408889634f * SCALE;
    if (__builtin_expect(__all((pmax - m_reg) * SCALE <= THR), 1)) { mn = m_reg; alpha = 1.f; }
    else { mn = fmaxf(m_reg, pmax); alpha = __builtin_amdgcn_exp2f((m_reg - mn) * C2); m_reg = mn; }
    const float mnL = -mn * C2;
    for (int r = 0; r < 16; ++r) p0[r] = fmaf(p0[r], C2, mnL); for (int r = 0; r < 16; ++r) p1[r] = fmaf(p1[r], C2, mnL);
    for (int r = 0; r < 16; ++r) p0[r] = __builtin_amdgcn_exp2f(p0[r]);
}
__device__ __forceinline__ void finishSM(f32x16& p0, f32x16& p1, float alpha, float& l_reg, bf16x8& pa0, bf16x8& pa1, bf16x8& pa2, bf16x8& pa3) {
    for (int r = 0; r < 16; ++r) p1[r] = __builtin_amdgcn_exp2f(p1[r]);
    float ps = 0; for (int r = 0; r < 16; ++r) ps += p0[r]; for (int r = 0; r < 16; ++r) ps += p1[r];
    { auto rr = __builtin_amdgcn_permlane32_swap(__float_as_uint(ps), __float_as_uint(ps), false, false);
      ps = __uint_as_float(rr[0]) + __uint_as_float(rr[1]); }
    l_reg = l_reg * alpha + ps;
#define PK4(P, B_, OUT) do { unsigned a0 = cvtpk(P[B_+0], P[B_+1]), a1 = cvtpk(P[B_+2], P[B_+3]);                          \
        unsigned b0 = cvtpk(P[B_+4], P[B_+5]), b1 = cvtpk(P[B_+6], P[B_+7]);                                             \
        auto r0 = __builtin_amdgcn_permlane32_swap(a0, b0, false, false); auto r1 = __builtin_amdgcn_permlane32_swap(a1, b1, false, false); \
        u32x4 w = {r0[0], r1[0], r0[1], r1[1]}; OUT = *reinterpret_cast<bf16x8*>(&w); } while (0)
    PK4(p0, 0, pa0); PK4(p0, 8, pa1); PK4(p1, 0, pa2); PK4(p1, 8, pa3);
#undef PK4
}
template <int KB>
__device__ __forceinline__ void qkt(f32x16& p0, f32x16& p1, const char* K_lds, int r32, int hi, const bf16x8* qr) {
    p0 = f32x16{}; p1 = f32x16{};
    const char* kb[4];
#pragma unroll
    for (int dd = 0; dd < 4; ++dd) kb[dd] = K_lds + KB * SHM_K + KSWZ(r32, (dd * 16 + hi * 8) * 2);
#pragma unroll
    for (int d0 = 0; d0 < 8; ++d0) { const char* a = kb[d0 & 3] + (d0 >> 2) * 128;
        bf16x8 b0 = *reinterpret_cast<const bf16x8*>(a);
        bf16x8 b1 = *reinterpret_cast<const bf16x8*>(a + 32 * 256);
        p0 = __builtin_amdgcn_mfma_f32_32x32x16_bf16(b0, qr[d0], p0, 0, 0, 0);
        p1 = __builtin_amdgcn_mfma_f32_32x32x16_bf16(b1, qr[d0], p1, 0, 0, 0); }
}
template <int VB>
__device__ __forceinline__ void pv_tile(f32x16* o, int vb0, bf16x8 pa0, bf16x8 pa1, bf16x8 pa2, bf16x8 pa3) {
#define TRRD(dst, off) asm volatile("ds_read_b64_tr_b16 %0, %1 offset:%2" : "=&v"(dst) : "v"(vb0), "i"(off) : "memory")
#define PV_D0(d0) do { s16x4 l0, l1, l2, l3, h0, h1, h2, h3; constexpr int b_ = VB * SHM_V + v_rd_off(d0, 0, 0); \
        TRRD(l0, b_); TRRD(h0, b_ + 2048); TRRD(l1, b_ + 4096); TRRD(h1, b_ + 6144); TRRD(l2, b_ + 8192); TRRD(h2, b_ + 10240); TRRD(l3, b_ + 12288); TRRD(h3, b_ + 14336); \
        asm volatile("s_waitcnt lgkmcnt(0)" ::: "memory"); SBAR();   \
        o[d0] = __builtin_amdgcn_mfma_f32_32x32x16_bf16(pa0, (bf16x8){l0[0], l0[1], l0[2], l0[3], h0[0], h0[1], h0[2], h0[3]}, o[d0], 0, 0, 0);   \
        o[d0] = __builtin_amdgcn_mfma_f32_32x32x16_bf16(pa1, (bf16x8){l1[0], l1[1], l1[2], l1[3], h1[0], h1[1], h1[2], h1[3]}, o[d0], 0, 0, 0);   \
        o[d0] = __builtin_amdgcn_mfma_f32_32x32x16_bf16(pa2, (bf16x8){l2[0], l2[1], l2[2], l2[3], h2[0], h2[1], h2[2], h2[3]}, o[d0], 0, 0, 0);   \
        o[d0] = __builtin_amdgcn_mfma_f32_32x32x16_bf16(pa3, (bf16x8){l3[0], l3[1], l3[2], l3[3], h3[0], h3[1], h3[2], h3[3]}, o[d0], 0, 0, 0); } while (0)
    PV_D0(0); PV_D0(1); PV_D0(2); PV_D0(3);
#undef PV_D0
#undef TRRD
}

struct BlockRef { const bf16* Q; const bf16* K; const bf16* V; bf16* O; int P0; };
struct Seam { bf16x8 qr[8]; bf16x8 st_v0, st_v1, st_k0, st_k1; };
#define ROW(p, k0, rr) ((p) + (size_t)((k0) + (rr)) * PIN + sc)
#define VMW() asm volatile("s_waitcnt vmcnt(0)" ::: "memory")
#define VMWN(n) asm volatile("s_waitcnt vmcnt(%0)" :: "i"(n) : "memory")
#define SLOAD_H(Kp, Vp, k0) do { S.st_v0 = load8(ROW(Vp, k0, sr)); S.st_v1 = load8(ROW(Vp, k0, 32 + sr));              \
                         S.st_k0 = load8(ROW(Kp, k0, sr)); S.st_k1 = load8(ROW(Kp, k0, 32 + sr)); } while (0)
#define SWRITE_HK(bf) do { *(bf16x8*)(K_lds + (bf) * SHM_K + kws) = S.st_k0; *(bf16x8*)(K_lds + (bf) * SHM_K + kws + 32 * 256) = S.st_k1; } while (0)
#define SWRITE_HV(bf) do { *(bf16x8*)(V_lds + (bf) * SHM_V + vst0) = S.st_v0; *(bf16x8*)(V_lds + (bf) * SHM_V + vst1) = S.st_v1; } while (0)
#define SWRITE_H(bf) do { SWRITE_HV(bf); SWRITE_HK(bf); } while (0)
__device__ __forceinline__ void causal_prime(const BlockRef& cur, char* lds, Seam& S) {
    const int tid = threadIdx.x, wid = __builtin_amdgcn_readfirstlane(tid >> 6), lane = tid & 63, r32 = lane & 31, hi = lane >> 5;
    const int sr = tid >> 4, sc = (tid & 15) * 8, kws = KSWZ(sr, sc * 2); char* K_lds = lds + 2 * SHM_V;
    const int kb0 = 0;
    for (int d0 = 0; d0 < 8; ++d0) S.qr[d0] = load8(cur.Q + (size_t)(wid * QBLK + r32) * PIN + d0 * 16 + hi * 8);
    SLOAD_H(cur.K, cur.V, kb0); VMW(); SWRITE_HK(0);
    __syncthreads();
}
__device__ __forceinline__ void causal_block(const BlockRef& cur, const BlockRef& nxt, int skv, char* lds, Seam& S) {
    const int W = 1 << 30;
    const int tid = threadIdx.x, wid = __builtin_amdgcn_readfirstlane(tid >> 6), lane = tid & 63, r32 = lane & 31, hi = lane >> 5;
    const int j_lo = 0;
    int j_hi = (cur.P0 + QB - 1) / KVBLK + 1; if (j_hi > skv / KVBLK) j_hi = skv / KVBLK;
    const int NT = j_hi - j_lo;
    const int kbn = 0;
    const int qlo = cur.P0 + wid * QBLK, qm = qlo + r32 - 4 * hi;
    char* V_lds = lds; char* K_lds = lds + 2 * SHM_V;
    float* ws = (float*)(lds + 2 * SHM_V + 2 * SHM_K) + wid * 64; float* li_l = ws, * al_l = ws + 32;
    float m_reg = -1e30f, l_reg = 0; f32x16 o[4] = {};
    const int sr = tid >> 4, sc = (tid & 15) * 8, vst0 = v_st(sr, sc), vst1 = v_st(32 + sr, sc), kws = KSWZ(sr, sc * 2);
    const int vb0 = (int)(uintptr_t)V_lds + v_rd_base(lane);
    const bf16* Kh = cur.K; const bf16* Vh = cur.V;
#define RESC(a) do { if (__any((a) < 1.f)) { if (hi == 0) al_l[r32] = (a); asm volatile("s_waitcnt lgkmcnt(0)" ::: "memory");              \
                     for (int d_ = 0; d_ < 4; ++d_) for (int r = 0; r < 16; ++r) o[d_][r] *= al_l[crow(r, hi)]; } } while (0)
#define KBASE(t) ((j_lo + (t)) * KVBLK)
#define MASKT(P0_, P1_, t) do { const int kb_ = KBASE(t); if (kb_ + KVBLK - 1 > qlo) mask_tile(P0_, P1_, qm - kb_, (unsigned)W); } while (0)
    constexpr int NQL = 8;
#define SEAM_K0() do { VMWN(NQL); SWRITE_HK(0); SBAR(); } while (0)
    f32x16 pA0, pA1, pB0, pB1; float mnA, mnB, alA, alB; bf16x8 pa0, pa1, pa2, pa3;
    SWRITE_HV(0); SBAR();
    if (NT > 1) { SLOAD_H(Kh, Vh, KBASE(1)); }
    SBAR(); qkt<0>(pA0, pA1, K_lds, r32, hi, S.qr);
    MASKT(pA0, pA1, 0); partialSM(pA0, pA1, m_reg, mnA, alA);
    if (NT > 1) { VMW(); SWRITE_H(1); }
    __syncthreads();
#define HALF_STEP(PX0, PX1, mnX, alX, PY0, PY1, alY, t, KB, VB, SB) do {                                                      \
        SBAR(); qkt<KB>(PX0, PX1, K_lds, r32, hi, S.qr);                                                                      \
        finishSM(PY0, PY1, alY, l_reg, pa0, pa1, pa2, pa3); SBAR();                                                           \
        if ((t) + 1 < NT) { SLOAD_H(Kh, Vh, KBASE((t) + 1)); SBAR(); }                                                        \
        pv_tile<VB>(o, vb0, pa0, pa1, pa2, pa3); MASKT(PX0, PX1, (t)); partialSM(PX0, PX1, m_reg, mnX, alX);                  \
        __syncthreads();                                                                                                      \
        if ((t) + 1 < NT) { VMW(); SWRITE_H(SB); }                                                                            \
        RESC(alX); __syncthreads(); } while (0)
    for (int t = 1; t + 1 < NT; t += 2) {
        HALF_STEP(pB0, pB1, mnB, alB, pA0, pA1, alA, t, 1, 0, 0);
        HALF_STEP(pA0, pA1, mnA, alA, pB0, pB1, alB, t + 1, 0, 1, 1);
    }
    const bool even = (NT & 1) == 0;
    if (even) { SBAR(); qkt<1>(pB0, pB1, K_lds, r32, hi, S.qr); SBAR(); }
    SLOAD_H(nxt.K, nxt.V, kbn); SBAR();
#pragma unroll
    for (int d0 = 0; d0 < 8; ++d0) S.qr[d0] = load8(nxt.Q + (size_t)(wid * QBLK + r32) * PIN + d0 * 16 + hi * 8);
    SBAR();
    finishSM(pA0, pA1, alA, l_reg, pa0, pa1, pa2, pa3); SBAR();
    pv_tile<0>(o, vb0, pa0, pa1, pa2, pa3);
    if (even) { MASKT(pB0, pB1, NT - 1); partialSM(pB0, pB1, m_reg, mnB, alB); __syncthreads(); RESC(alB);
        finishSM(pB0, pB1, alB, l_reg, pa0, pa1, pa2, pa3); SBAR(); pv_tile<1>(o, vb0, pa0, pa1, pa2, pa3); }
    SBAR(); SEAM_K0();
    if (hi == 0) li_l[r32] = l_reg; asm volatile("s_waitcnt lgkmcnt(0)" ::: "memory");
    float rli[16];
#pragma unroll
    for (int r = 0; r < 16; ++r) rli[r] = __builtin_amdgcn_rcpf(li_l[crow(r, hi)]);
    bf16* Ow = cur.O + (size_t)(wid * QBLK) * POUT;
#pragma unroll
    for (int r = 0; r < 16; ++r) { const int orow = crow(r, hi);
#pragma unroll
        for (int d0 = 0; d0 < 4; ++d0) { const float v = o[d0][r] * rli[r];
            const float vn = __shfl_xor(v, 1);
            if ((r32 & 1) == 0) *(unsigned*)(Ow + (size_t)orow * POUT + d0 * 32 + r32) = cvtpk(v, vn); } }
    __syncthreads();
#undef RESC
#undef KBASE
#undef MASKT
#undef SEAM_K0
#undef HALF_STEP
}
#undef ROW
#undef VMW
#undef VMWN
#undef SLOAD_H
#undef SWRITE_HK
#undef SWRITE_HV
#undef SWRITE_H
#undef KSWZ
#undef SBAR

__device__ __forceinline__ BlockRef make_ref(int L, int pass, const bf16* PROJ, bf16* O16) {
    const int xcd = L & 7, kk = L >> 3, p = xcd * 4 + (kk >> 5), x = kk & 31;
    const int qb = pass ? 63 - x : x;
    const int b = p >> 4, h = (p >> 2) & 3, m = (p >> 1) & 1, vh = p & 1;
    const size_t rb = (size_t)b * SEQ;
    BlockRef r;
    r.Q = PROJ + (rb + (size_t)qb * QB) * PIN + (h * 2 + m) * 128;
    r.K = PROJ + rb * PIN + 1024 + (h * 2 + m) * 128;
    r.V = PROJ + rb * PIN + 2048 + h * 256 + vh * 128;
    r.O = O16 + (rb + (size_t)qb * QB) * POUT + (p & 15) * 128;
    r.P0 = qb * QB;
    return r;
}
__device__ __forceinline__ void attn_phase(char* lds, const bf16* PROJ, bf16* O16, int G, int w) {
    constexpr int total = 1024;
    int L = w; if (L >= total) return;
    int pass = 0;
    BlockRef cur = make_ref(L, 0, PROJ, O16);
    Seam S;
    causal_prime(cur, lds, S);
    for (;;) {
        const bool more_pass = pass == 0, more_item = L + G < total, last = !more_pass && !more_item;
        int passn, Ln;
        if (more_pass) { passn = 1; Ln = L; } else { passn = 0; Ln = more_item ? L + G : L; }
        const BlockRef nxt = last ? cur : make_ref(Ln, passn, PROJ, O16);
        causal_block(cur, nxt, SEQ, lds, S);
        if (last) break;
        cur = nxt; pass = passn; L = Ln;
    }
}
}


namespace att2 {
using namespace att;
constexpr int QB2 = 128;
constexpr int PH = 128;
constexpr long HSTR = (long)SEQ * PH;
constexpr int L_V = 0, L_K = 4 * SHM_V, L_WSF = L_K + 2 * SHM_K, L_XM = L_WSF + 2048, L_XP = L_XM + 2048, L_XL = L_XP + 32768, L_END = L_XL + 1024;
#define KSWZ2(row, colB) ((row) * 256 + ((colB) ^ (((row) & 7) << 4)))
#define SBAR2() __builtin_amdgcn_sched_barrier(0)
struct BlockRef2 { const bf16* Q; const bf16* K; const bf16* V; bf16* O; int P0; };

__device__ __forceinline__ void block2(const BlockRef2& cur, char* lds, int wave) {
    const int lane = (int)__builtin_amdgcn_mbcnt_hi(~0u, __builtin_amdgcn_mbcnt_lo(~0u, 0u)), r32 = lane & 31, hi = lane >> 5, tid = wave * 64 + lane;
    const int rg = wave & 3, c = wave >> 2, pw = wave ^ 4;
    const int NT = (cur.P0 + QB2 - 1) / KVBLK + 1;
    const int qlo = cur.P0 + rg * QBLK, qm = qlo + r32 - 4 * hi;
    char* V_lds = lds + L_V; char* K_lds = lds + L_K;
    float* wsf = (float*)(lds + L_WSF) + wave * 64; float* li_l = wsf; float* al_l = wsf + 32;
    float* xm = (float*)(lds + L_XM);
    char* xp = lds + L_XP;
    float* xl = (float*)(lds + L_XL);
    const int sr = tid >> 4, sc = (tid & 15) * 8, vst0 = v_st(sr, sc), vst1 = v_st(32 + sr, sc), kws = KSWZ2(sr, sc * 2);
    const int vb0 = (int)(uintptr_t)V_lds + c * SHM_V + v_rd_base(lane);
    const bf16* Kh = cur.K; const bf16* Vh = cur.V;
    bf16x8 qr[8];
#pragma unroll
    for (int d0 = 0; d0 < 8; ++d0) qr[d0] = *reinterpret_cast<const bf16x8*>((const char*)(cur.Q + (size_t)(rg * QBLK) * PH) + (unsigned)(r32 * PH + hi * 8) * 2u + d0 * 32);
    bf16x8 sk0, sk1, sv00, sv01, sv10, sv11;
    unsigned voff = (unsigned)(sr * PH + sc) * 2u; asm volatile("" : "+v"(voff));
#define LD16(base_, byteoff_) (*reinterpret_cast<const bf16x8*>((const char*)(base_) + voff + (byteoff_)))
#define KLOAD(k0) do { const bf16* kb0_ = Kh + (size_t)(k0) * PH; const bf16* kb1_ = Kh + (size_t)((k0) + 32) * PH; sk0 = LD16(kb0_, 0); sk1 = LD16(kb1_, 0); } while (0)
#define VLOAD(k0) do { const bf16* vb0_ = Vh + (size_t)(k0) * PH; const bf16* vb1_ = Vh + (size_t)((k0) + 32) * PH; \
                       sv00 = LD16(vb0_, 0); sv01 = LD16(vb1_, 0); sv10 = LD16(vb0_ + HSTR, 0); sv11 = LD16(vb1_ + HSTR, 0); } while (0)
#define KWRITE(bf) do { *(bf16x8*)(K_lds + (bf) * SHM_K + kws) = sk0; *(bf16x8*)(K_lds + (bf) * SHM_K + kws + 32 * 256) = sk1; } while (0)
#define VWRITE(bf) do { *(bf16x8*)(V_lds + ((bf) * 2) * SHM_V + vst0) = sv00; *(bf16x8*)(V_lds + ((bf) * 2) * SHM_V + vst1) = sv01; \
                        *(bf16x8*)(V_lds + ((bf) * 2 + 1) * SHM_V + vst0) = sv10; *(bf16x8*)(V_lds + ((bf) * 2 + 1) * SHM_V + vst1) = sv11; } while (0)
    KLOAD(0); VLOAD(0); KWRITE(0); VWRITE(0);
    KLOAD(KVBLK); VLOAD(KVBLK); KWRITE(1); VWRITE(1);
    if (NT > 2) { KLOAD(2 * KVBLK); VLOAD(2 * KVBLK); }
    float m_reg = -1e30f, l_reg = 0.f; f32x16 o[4] = {};
    f32x16 pA, pB; float alA = 1.f, alB = 1.f; bf16x8 f0, f1;
    constexpr float C2 = 1.4426950408889634f * SCALE;
#define QKT2(P, KB) do { P = f32x16{}; const char* kq_ = K_lds + (KB) * SHM_K + c * (32 * 256); \
        _Pragma("unroll") for (int d0 = 0; d0 < 8; ++d0) { const bf16x8 b_ = *reinterpret_cast<const bf16x8*>(kq_ + KSWZ2(r32, (((d0) & 3) * 16 + hi * 8) * 2) + ((d0) >> 2) * 128); \
            P = __builtin_amdgcn_mfma_f32_32x32x16_bf16(b_, qr[d0], P, 0, 0, 0); } } while (0)
#define MASKMAX(P, t, par) do { const int kb_ = (t) * KVBLK + 32 * c; \
        if (kb_ + 31 > qlo) { const int dq_ = qm - kb_; const float NEG_ = -__builtin_inff(); \
            _Pragma("unroll") for (int r = 0; r < 16; ++r) { if (dq_ - ((r & 3) + 8 * (r >> 2)) < 0) P[r] = NEG_; } } \
        float pm_ = P[0]; _Pragma("unroll") for (int r = 1; r < 16; ++r) pm_ = fmaxf(pm_, P[r]); \
        { auto rr = __builtin_amdgcn_permlane32_swap(__float_as_uint(pm_), __float_as_uint(pm_), false, false); pm_ = fmaxf(__uint_as_float(rr[0]), __uint_as_float(rr[1])); } \
        pmx = pm_; if (hi == 0) xm[((par) * 8 + wave) * 32 + r32] = pm_; } while (0)
#define SOFTMAX(P, par, alX) do { const float pmax_ = fmaxf(pmx, xm[((par) * 8 + pw) * 32 + r32]); float mn_; \
        if (__builtin_expect(__all((pmax_ - m_reg) * SCALE <= THR), 1)) { mn_ = m_reg; alX = 1.f; } \
        else { mn_ = fmaxf(m_reg, pmax_); alX = __builtin_amdgcn_exp2f((m_reg - mn_) * C2); m_reg = mn_; } \
        const float mnL_ = -mn_ * C2; \
        _Pragma("unroll") for (int r = 0; r < 16; ++r) P[r] = __builtin_amdgcn_exp2f(fmaf(P[r], C2, mnL_)); } while (0)
#define PK4B(P, B_, OUT) do { unsigned a0 = cvtpk(P[B_+0], P[B_+1]), a1 = cvtpk(P[B_+2], P[B_+3]); unsigned b0 = cvtpk(P[B_+4], P[B_+5]), b1 = cvtpk(P[B_+6], P[B_+7]); \
        auto r0 = __builtin_amdgcn_permlane32_swap(a0, b0, false, false); auto r1 = __builtin_amdgcn_permlane32_swap(a1, b1, false, false); \
        u32x4 w = {r0[0], r1[0], r0[1], r1[1]}; OUT = *reinterpret_cast<bf16x8*>(&w); } while (0)
#define FINISH(P, alY, par) do { float ps_ = 0; _Pragma("unroll") for (int r = 0; r < 16; ++r) ps_ += P[r]; \
        { auto rr = __builtin_amdgcn_permlane32_swap(__float_as_uint(ps_), __float_as_uint(ps_), false, false); ps_ = __uint_as_float(rr[0]) + __uint_as_float(rr[1]); } \
        l_reg = l_reg * alY + ps_; PK4B(P, 0, f0); PK4B(P, 8, f1); \
        *(bf16x8*)(xp + (((par) * 8 + wave) * 2 + 0) * 1024 + lane * 16) = f0; *(bf16x8*)(xp + (((par) * 8 + wave) * 2 + 1) * 1024 + lane * 16) = f1; } while (0)
#define TRRD2(dst, off) asm volatile("ds_read_b64_tr_b16 %0, %1 offset:%2" : "=&v"(dst) : "v"(vb0), "i"(off) : "memory")
#define PV2_D0(VB, d0) do { s16x4 l0, l1, l2, l3, h0, h1, h2, h3; constexpr int b_ = (VB) * 2 * SHM_V + v_rd_off(d0, 0, 0); \
        TRRD2(l0, b_); TRRD2(h0, b_ + 2048); TRRD2(l1, b_ + 4096); TRRD2(h1, b_ + 6144); TRRD2(l2, b_ + 8192); TRRD2(h2, b_ + 10240); TRRD2(l3, b_ + 12288); TRRD2(h3, b_ + 14336); \
        asm volatile("s_waitcnt lgkmcnt(0)" ::: "memory"); SBAR2(); __builtin_amdgcn_s_setprio(1);  \
        o[d0] = __builtin_amdgcn_mfma_f32_32x32x16_bf16(pa0, (bf16x8){l0[0], l0[1], l0[2], l0[3], h0[0], h0[1], h0[2], h0[3]}, o[d0], 0, 0, 0);   \
        o[d0] = __builtin_amdgcn_mfma_f32_32x32x16_bf16(pa1, (bf16x8){l1[0], l1[1], l1[2], l1[3], h1[0], h1[1], h1[2], h1[3]}, o[d0], 0, 0, 0);   \
        o[d0] = __builtin_amdgcn_mfma_f32_32x32x16_bf16(pa2, (bf16x8){l2[0], l2[1], l2[2], l2[3], h2[0], h2[1], h2[2], h2[3]}, o[d0], 0, 0, 0);   \
        o[d0] = __builtin_amdgcn_mfma_f32_32x32x16_bf16(pa3, (bf16x8){l3[0], l3[1], l3[2], l3[3], h3[0], h3[1], h3[2], h3[3]}, o[d0], 0, 0, 0); __builtin_amdgcn_s_setprio(0); } while (0)
#define PVALL(VB, par) do { const bf16x8 g0_ = *(const bf16x8*)(xp + (((par) * 8 + pw) * 2 + 0) * 1024 + lane * 16), g1_ = *(const bf16x8*)(xp + (((par) * 8 + pw) * 2 + 1) * 1024 + lane * 16); \
        const bf16x8 pa0 = c ? g0_ : f0, pa1 = c ? g1_ : f1, pa2 = c ? f0 : g0_, pa3 = c ? f1 : g1_; \
        PV2_D0(VB, 0); PV2_D0(VB, 1); PV2_D0(VB, 2); PV2_D0(VB, 3); } while (0)
#define RESC2(a) do { if (__any((a) < 1.f)) { if (hi == 0) al_l[r32] = (a); asm volatile("s_waitcnt lgkmcnt(0)" ::: "memory");              \
                     for (int d_ = 0; d_ < 4; ++d_) for (int r = 0; r < 16; ++r) o[d_][r] *= al_l[crow(r, hi)]; } } while (0)
#define QKT2F(PX, KB, PY, alY, par) do { const char* kq_ = K_lds + (KB) * SHM_K + c * (32 * 256); bf16x8 kf_[8]; \
        _Pragma("unroll") for (int d0 = 0; d0 < 8; ++d0) kf_[d0] = *reinterpret_cast<const bf16x8*>(kq_ + KSWZ2(r32, (((d0) & 3) * 16 + hi * 8) * 2) + ((d0) >> 2) * 128); \
        PX = f32x16{}; float ps_ = 0.f; SBAR2(); __builtin_amdgcn_s_setprio(1); \
        PX = __builtin_amdgcn_mfma_f32_32x32x16_bf16(kf_[0], qr[0], PX, 0, 0, 0); SBAR2(); \
        _Pragma("unroll") for (int r = 0; r < 8; ++r) ps_ += PY[r]; SBAR2(); \
        PX = __builtin_amdgcn_mfma_f32_32x32x16_bf16(kf_[1], qr[1], PX, 0, 0, 0); SBAR2(); \
        _Pragma("unroll") for (int r = 8; r < 16; ++r) ps_ += PY[r]; \
        { auto rr = __builtin_amdgcn_permlane32_swap(__float_as_uint(ps_), __float_as_uint(ps_), false, false); ps_ = __uint_as_float(rr[0]) + __uint_as_float(rr[1]); } \
        l_reg = l_reg * alY + ps_; SBAR2(); \
        PX = __builtin_amdgcn_mfma_f32_32x32x16_bf16(kf_[2], qr[2], PX, 0, 0, 0); SBAR2(); \
        PK4B(PY, 0, f0); *(bf16x8*)(xp + (((par) * 8 + wave) * 2 + 0) * 1024 + lane * 16) = f0; SBAR2(); \
        PX = __builtin_amdgcn_mfma_f32_32x32x16_bf16(kf_[3], qr[3], PX, 0, 0, 0); SBAR2(); \
        PK4B(PY, 8, f1); *(bf16x8*)(xp + (((par) * 8 + wave) * 2 + 1) * 1024 + lane * 16) = f1; SBAR2(); \
        PX = __builtin_amdgcn_mfma_f32_32x32x16_bf16(kf_[4], qr[4], PX, 0, 0, 0); \
        PX = __builtin_amdgcn_mfma_f32_32x32x16_bf16(kf_[5], qr[5], PX, 0, 0, 0); \
        PX = __builtin_amdgcn_mfma_f32_32x32x16_bf16(kf_[6], qr[6], PX, 0, 0, 0); \
        PX = __builtin_amdgcn_mfma_f32_32x32x16_bf16(kf_[7], qr[7], PX, 0, 0, 0); __builtin_amdgcn_s_setprio(0); SBAR2(); } while (0)
#define SM_DECIDE(par, alX) do { const float pmax_ = fmaxf(pmx, xm[((par) * 8 + pw) * 32 + r32]); float mn_; \
        if (__builtin_expect(__all((pmax_ - m_reg) * SCALE <= THR), 1)) { mn_ = m_reg; alX = 1.f; } \
        else { mn_ = fmaxf(m_reg, pmax_); alX = __builtin_amdgcn_exp2f((m_reg - mn_) * C2); m_reg = mn_; } \
        mnL = -mn_ * C2; } while (0)
#define SM_EXP4(P, B_) do { _Pragma("unroll") for (int r = (B_); r < (B_) + 4; ++r) P[r] = __builtin_amdgcn_exp2f(fmaf(P[r], C2, mnL)); } while (0)
#define PVSM(VB, par, PX, parX, alX) do { const bf16x8 g0_ = *(const bf16x8*)(xp + (((par) * 8 + pw) * 2 + 0) * 1024 + lane * 16), g1_ = *(const bf16x8*)(xp + (((par) * 8 + pw) * 2 + 1) * 1024 + lane * 16); \
        SM_DECIDE(parX, alX); \
        const bf16x8 pa0 = c ? g0_ : f0, pa1 = c ? g1_ : f1, pa2 = c ? f0 : g0_, pa3 = c ? f1 : g1_; SBAR2(); \
        PV2_D0(VB, 0); SBAR2(); SM_EXP4(PX, 0); SBAR2(); PV2_D0(VB, 1); SBAR2(); SM_EXP4(PX, 4); SBAR2(); \
        PV2_D0(VB, 2); SBAR2(); SM_EXP4(PX, 8); SBAR2(); PV2_D0(VB, 3); SBAR2(); SM_EXP4(PX, 12); SBAR2(); } while (0)
    float pmx, mnL;
    __syncthreads();
    QKT2(pA, 0); MASKMAX(pA, 0, 0);
    __syncthreads();
    SOFTMAX(pA, 0, alA);
#define STEP2(PX, alX, PY, alY, t, KB, VB) do { \
        SBAR2(); QKT2F(PX, KB, PY, alY, VB); \
        MASKMAX(PX, t, KB); \
        __syncthreads(); \
        if ((t) + 1 < NT) { KWRITE(VB); if ((t) + 2 < NT) KLOAD(((t) + 2) * KVBLK); } \
        PVSM(VB, VB, PX, KB, alX); \
        __syncthreads(); \
        if ((t) + 1 < NT) { VWRITE(VB); if ((t) + 2 < NT) VLOAD(((t) + 2) * KVBLK); } \
        RESC2(alX); } while (0)
    for (int t = 1; t + 1 < NT; t += 2) {
        STEP2(pB, alB, pA, alA, t, 1, 0);
        STEP2(pA, alA, pB, alB, t + 1, 0, 1);
    }
    STEP2(pB, alB, pA, alA, NT - 1, 1, 0);
    FINISH(pB, alB, 1);
    if (hi == 0) xl[wave * 32 + r32] = l_reg;
    __syncthreads();
    PVALL(1, 1);
    l_reg += xl[pw * 32 + r32];
    if (hi == 0) li_l[r32] = l_reg; asm volatile("s_waitcnt lgkmcnt(0)" ::: "memory");
    float rli[16];
#pragma unroll
    for (int r = 0; r < 16; ++r) rli[r] = __builtin_amdgcn_rcpf(li_l[crow(r, hi)]);
    { char* stg = lds + (wave < 4 ? L_V + wave * 8192 : L_K + (wave - 4) * 8192);
      unsigned soff = (unsigned)(4 * hi * 256 + r32 * 2); asm volatile("" : "+v"(soff));
#pragma unroll
      for (int r = 0; r < 16; ++r) { const unsigned orow = (unsigned)((r & 3) + 8 * (r >> 2));
#pragma unroll
          for (int d0 = 0; d0 < 4; ++d0) *(bf16*)(stg + soff + orow * 256u + d0 * 64u) = __float2bfloat16(o[d0][r] * rli[r]); }
      asm volatile("s_waitcnt lgkmcnt(0)" ::: "memory");
      char* Ow = (char*)(cur.O + (size_t)(rg * QBLK) * POUT + c * 128);
      unsigned roff = (unsigned)((lane >> 4) * 256 + (lane & 15) * 16), goff = (unsigned)((lane >> 4) * (POUT * 2) + (lane & 15) * 16); asm volatile("" : "+v"(roff), "+v"(goff));
#pragma unroll
      for (int i = 0; i < 8; ++i) { const u32x4 v = *(const u32x4*)(stg + roff + i * 1024u); *(u32x4*)(Ow + goff + (unsigned)i * (4u * POUT * 2u)) = v; } }
    __syncthreads();
#undef LD16
#undef KLOAD
#undef VLOAD
#undef KWRITE
#undef VWRITE
#undef QKT2
#undef MASKMAX
#undef SOFTMAX
#undef PK4B
#undef FINISH
#undef TRRD2
#undef PV2_D0
#undef PVALL
#undef RESC2
#undef STEP2
#undef QKT2F
#undef SM_DECIDE
#undef SM_EXP4
#undef PVSM
}
__device__ __forceinline__ BlockRef2 make_ref2(int L, int pass, const bf16* PROJ, bf16* O16) {
    const int xcd = L & 7, kk = L >> 3, p = xcd * 2 + (kk & 1), x = kk >> 1;
    const int qb = pass ? 127 - x : x;
    const int b = p >> 3, h = (p >> 1) & 3, m = p & 1;
    const size_t rb = (size_t)b * SEQ;
    BlockRef2 r;
    const bf16* hb = PROJ + (size_t)b * 24 * HSTR;
    r.Q = hb + (size_t)(h * 2 + m) * HSTR + (size_t)qb * QB2 * PH;
    r.K = hb + (size_t)(8 + h * 2 + m) * HSTR;
    r.V = hb + (size_t)(16 + h * 2) * HSTR;
    r.O = O16 + (rb + (size_t)qb * QB2) * POUT + h * 512 + m * 256;
    r.P0 = qb * QB2;
    return r;
}
__device__ __forceinline__ void attn_phase2(char* lds, const bf16* PROJ, bf16* O16, int G, int w, int wave) {
    for (int L = w; L < 1024; L += G)
        for (int pass = 0; pass < 2; ++pass) { const BlockRef2 cur = make_ref2(L, pass, PROJ, O16); block2(cur, lds, wave); }
}
#undef KSWZ2
#undef SBAR2
}

constexpr size_t MiB = 1u << 20;
constexpr size_t WS_WIN = 1 * MiB;
constexpr size_t WS_WO = 17 * MiB;
constexpr size_t WS_WQX = 25 * MiB;
constexpr size_t WS_WKV = 33 * MiB;
constexpr size_t WS_WOX = 49 * MiB;
constexpr size_t WS_WGU = 57 * MiB;
constexpr size_t WS_WDN = 101 * MiB;
constexpr size_t WS_WPOOL = 123 * MiB;
constexpr size_t WS_MN = 124 * MiB;
constexpr size_t WS_KX = 126 * MiB;
constexpr size_t WS_VXT = 128 * MiB;
constexpr size_t WS_HN = 144 * MiB;
constexpr size_t WS_PROJ = 272 * MiB;
constexpr size_t WS_O16 = 528 * MiB;
constexpr size_t WS_POOLED = 656 * MiB;
constexpr size_t WS_CONCAT = 720 * MiB;
constexpr size_t WS_QX = 272 * MiB;
constexpr size_t WS_PSC = 400 * MiB;
constexpr size_t WS_OX = 528 * MiB;
constexpr size_t WS_HID = 272 * MiB;
constexpr size_t WS_XB = 848 * MiB;
constexpr size_t WS_WQK = 130 * MiB;
constexpr size_t WS_WINU = 138 * MiB;
constexpr size_t WS_VWT = 976 * MiB;
constexpr size_t WS_END = 984 * MiB;

constexpr int LDS_BYTES = 147456;
constexpr int XL_OFF = 131072;
constexpr int NPHASE = 14;

typedef unsigned short bf16r;
typedef float f32x4 __attribute__((ext_vector_type(4)));
typedef unsigned v4u __attribute__((ext_vector_type(4)));
typedef unsigned v2u __attribute__((ext_vector_type(2)));
#define LAS __attribute__((address_space(3)))

__device__ __forceinline__ unsigned f2bf(float f) { unsigned u = __builtin_bit_cast(unsigned, f); return (u + 0x7fffu + ((u >> 16) & 1u)) >> 16; }
__device__ __forceinline__ unsigned pk2(float lo, float hi) { return f2bf(lo) | (f2bf(hi) << 16); }
__device__ __forceinline__ float bf2f(unsigned short b) { return __builtin_bit_cast(float, (unsigned)b << 16); }
__device__ __forceinline__ float wave_sum(float v) {
#pragma unroll
    for (int o = 1; o < 64; o <<= 1) v += __shfl_xor(v, o);
    return v;
}

__device__ __forceinline__ void transpose_item(const float* W, int N, bf16r* WT, int ldt, int k0, int n0, int drow0, LAS float* scr, int lane, const float* gn = nullptr) {
    const float gg = gn ? gn[n0 + (lane & 31)] : 1.f;
#pragma unroll 8
    for (int i = 0; i < 32; ++i) { const int kk = 2 * i + (lane >> 5); scr[kk * 33 + (lane & 31)] = W[(size_t)(k0 + kk) * N + n0 + (lane & 31)] * gg; }
    asm volatile("s_waitcnt lgkmcnt(0)" ::: "memory");
    const int c = lane & 7;
#pragma unroll
    for (int j = 0; j < 4; ++j) { const int n = (lane >> 3) + 8 * j; const LAS float* s = scr + (8 * c) * 33 + n;
        v4u o; o.x = pk2(s[0 * 33], s[1 * 33]); o.y = pk2(s[2 * 33], s[3 * 33]); o.z = pk2(s[4 * 33], s[5 * 33]); o.w = pk2(s[6 * 33], s[7 * 33]);
        *(v4u*)(WT + (size_t)(drow0 + n) * ldt + k0 + 8 * c) = o; }
    asm volatile("s_waitcnt lgkmcnt(0)" ::: "memory");
}
__device__ __forceinline__ void rms_row_bf16(const float* xrow, const float* g, bf16r* orow, int lane) {
    const f32x4* xr = (const f32x4*)xrow + lane; const f32x4* gr = (const f32x4*)g + lane;
    f32x4 v[8]; float s = 0.f;
#pragma unroll
    for (int j = 0; j < 8; ++j) { v[j] = xr[64 * j]; s += (v[j].x * v[j].x + v[j].y * v[j].y) + (v[j].z * v[j].z + v[j].w * v[j].w); }
    const float rstd = rsqrtf(wave_sum(s) * (1.f / DM) + EPS);
    v2u* o8 = (v2u*)orow + lane;
#pragma unroll
    for (int j = 0; j < 8; ++j) { const f32x4 gg = gr[64 * j]; v2u w; w.x = pk2(v[j].x * rstd * gg.x, v[j].y * rstd * gg.y); w.y = pk2(v[j].z * rstd * gg.z, v[j].w * rstd * gg.w); o8[64 * j] = w; }
}
__device__ __forceinline__ void rms_rowb_bf16(const bf16r* xrow, const float* g, bf16r* orow, int lane) {
    const v4u* xr = (const v4u*)xrow + lane; const f32x4* gr = (const f32x4*)g + 2 * lane;
    float v[4][8]; float s = 0.f;
#pragma unroll
    for (int j = 0; j < 4; ++j) { const v4u w = xr[64 * j];
#pragma unroll
        for (int e = 0; e < 4; ++e) { v[j][2 * e] = __builtin_bit_cast(float, w[e] << 16); v[j][2 * e + 1] = __builtin_bit_cast(float, w[e] & 0xffff0000u); }
#pragma unroll
        for (int e = 0; e < 8; ++e) s += v[j][e] * v[j][e]; }
    const float rstd = rsqrtf(wave_sum(s) * (1.f / DM) + EPS);
    v4u* o8 = (v4u*)orow + lane;
#pragma unroll
    for (int j = 0; j < 4; ++j) { const f32x4 g0 = gr[128 * j], g1 = gr[128 * j + 1]; v4u w;
        w.x = pk2(v[j][0] * rstd * g0.x, v[j][1] * rstd * g0.y); w.y = pk2(v[j][2] * rstd * g0.z, v[j][3] * rstd * g0.w);
        w.z = pk2(v[j][4] * rstd * g1.x, v[j][5] * rstd * g1.y); w.w = pk2(v[j][6] * rstd * g1.z, v[j][7] * rstd * g1.w); o8[64 * j] = w; }
}
__device__ __forceinline__ void rms_rowb_f32(const bf16r* xrow, const float* g, float* orow, int lane) {
    const v4u* xr = (const v4u*)xrow + lane; const f32x4* gr = (const f32x4*)g + 2 * lane;
    float v[4][8]; float s = 0.f;
#pragma unroll
    for (int j = 0; j < 4; ++j) { const v4u w = xr[64 * j];
#pragma unroll
        for (int e = 0; e < 4; ++e) { v[j][2 * e] = __builtin_bit_cast(float, w[e] << 16); v[j][2 * e + 1] = __builtin_bit_cast(float, w[e] & 0xffff0000u); }
#pragma unroll
        for (int e = 0; e < 8; ++e) s += v[j][e] * v[j][e]; }
    const float rstd = rsqrtf(wave_sum(s) * (1.f / DM) + EPS);
    f32x4* o4 = (f32x4*)orow + 2 * lane;
#pragma unroll
    for (int j = 0; j < 4; ++j) { const f32x4 g0 = gr[128 * j], g1 = gr[128 * j + 1];
        o4[128 * j] = (f32x4){v[j][0] * rstd * g0.x, v[j][1] * rstd * g0.y, v[j][2] * rstd * g0.z, v[j][3] * rstd * g0.w};
        o4[128 * j + 1] = (f32x4){v[j][4] * rstd * g1.x, v[j][5] * rstd * g1.y, v[j][6] * rstd * g1.z, v[j][7] * rstd * g1.w}; }
}
template <int R> __device__ __forceinline__ void rms_rows_f32_to_bf16(const float* __restrict__ X, const float* __restrict__ g, bf16r* __restrict__ O, int m0, int lane) {
    f32x4 v[R][8]; float ss[R];
#pragma unroll
    for (int r = 0; r < R; ++r) { const f32x4* xr = (const f32x4*)(X + (size_t)(m0 + r) * DM) + lane;
#pragma unroll
        for (int j = 0; j < 8; ++j) v[r][j] = xr[64 * j]; }
#pragma unroll
    for (int r = 0; r < R; ++r) { float s = 0.f;
#pragma unroll
        for (int j = 0; j < 8; ++j) s += (v[r][j].x * v[r][j].x + v[r][j].y * v[r][j].y) + (v[r][j].z * v[r][j].z + v[r][j].w * v[r][j].w);
        ss[r] = s; }
#pragma unroll
    for (int o = 1; o < 64; o <<= 1) {
#pragma unroll
        for (int r = 0; r < R; ++r) ss[r] += __shfl_xor(ss[r], o); }
    const f32x4* gr = (const f32x4*)g + lane;
#pragma unroll
    for (int j = 0; j < 8; ++j) { const f32x4 gg = gr[64 * j];
#pragma unroll
        for (int r = 0; r < R; ++r) { const float rstd = rsqrtf(ss[r] * (1.f / DM) + EPS); v2u w;
            w.x = pk2(v[r][j].x * rstd * gg.x, v[r][j].y * rstd * gg.y); w.y = pk2(v[r][j].z * rstd * gg.z, v[r][j].w * rstd * gg.w);
            ((v2u*)(O + (size_t)(m0 + r) * DM) + lane)[64 * j] = w; } }
}
template <int R, bool OUT_F32> __device__ __forceinline__ void rms_rows_bf16(const bf16r* __restrict__ X, const float* __restrict__ g, void* __restrict__ O, int m0, int lane) {
    v4u w[R][4]; float ss[R];
#pragma unroll
    for (int r = 0; r < R; ++r) { const v4u* xr = (const v4u*)(X + (size_t)(m0 + r) * DM) + lane;
#pragma unroll
        for (int j = 0; j < 4; ++j) w[r][j] = xr[64 * j]; }
#pragma unroll
    for (int r = 0; r < R; ++r) { float s = 0.f;
#pragma unroll
        for (int j = 0; j < 4; ++j)
#pragma unroll
            for (int e = 0; e < 4; ++e) { const float a = __builtin_bit_cast(float, w[r][j][e] << 16), b = __builtin_bit_cast(float, w[r][j][e] & 0xffff0000u); s += a * a + b * b; }
        ss[r] = s; }
#pragma unroll
    for (int o = 1; o < 64; o <<= 1) {
#pragma unroll
        for (int r = 0; r < R; ++r) ss[r] += __shfl_xor(ss[r], o); }
    const f32x4* gr = (const f32x4*)g + 2 * lane;
#pragma unroll
    for (int j = 0; j < 4; ++j) { const f32x4 g0 = gr[128 * j], g1 = gr[128 * j + 1];
#pragma unroll
        for (int r = 0; r < R; ++r) { const float rstd = rsqrtf(ss[r] * (1.f / DM) + EPS); float v[8];
#pragma unroll
            for (int e = 0; e < 4; ++e) { v[2 * e] = __builtin_bit_cast(float, w[r][j][e] << 16) * rstd; v[2 * e + 1] = __builtin_bit_cast(float, w[r][j][e] & 0xffff0000u) * rstd; }
            if constexpr (OUT_F32) { f32x4* o4 = (f32x4*)((float*)O + (size_t)(m0 + r) * DM) + 2 * lane;
                o4[128 * j] = (f32x4){v[0] * g0.x, v[1] * g0.y, v[2] * g0.z, v[3] * g0.w}; o4[128 * j + 1] = (f32x4){v[4] * g1.x, v[5] * g1.y, v[6] * g1.z, v[7] * g1.w}; }
            else { v4u q; q.x = pk2(v[0] * g0.x, v[1] * g0.y); q.y = pk2(v[2] * g0.z, v[3] * g0.w); q.z = pk2(v[4] * g1.x, v[5] * g1.y); q.w = pk2(v[6] * g1.z, v[7] * g1.w);
                ((v4u*)((bf16r*)O + (size_t)(m0 + r) * DM) + lane)[64 * j] = q; } } }
}
__device__ __forceinline__ void rms_row_f32_inplace(float* xrow, const float* g, int lane) {
    f32x4* xr = (f32x4*)xrow + lane; const f32x4* gr = (const f32x4*)g + lane;
    f32x4 v[8]; float s = 0.f;
#pragma unroll
    for (int j = 0; j < 8; ++j) { v[j] = xr[64 * j]; s += (v[j].x * v[j].x + v[j].y * v[j].y) + (v[j].z * v[j].z + v[j].w * v[j].w); }
    const float rstd = rsqrtf(wave_sum(s) * (1.f / DM) + EPS);
#pragma unroll
    for (int j = 0; j < 8; ++j) { const f32x4 gg = gr[64 * j]; xr[64 * j] = (f32x4){v[j].x * rstd * gg.x, v[j].y * rstd * gg.y, v[j].z * rstd * gg.z, v[j].w * rstd * gg.w}; }
}

struct Args { const float* in[22]; float* out; unsigned char* ws; int ph_lo, ph_hi; };
typedef const __attribute__((address_space(4))) unsigned long long* karg_t;
__device__ __forceinline__ unsigned long long ldarg(int i) { karg_t p = (karg_t)__builtin_amdgcn_kernarg_segment_ptr(); asm volatile("" : "+s"(p) :: "memory"); return p[i]; }
#define GASP __attribute__((address_space(1)))
#define AIN(i) ((const float*)(GASP const float*)ldarg(i))
#define AOUT() ((float*)(GASP float*)ldarg(22))
#define AWS() ((unsigned char*)(GASP unsigned char*)ldarg(23))
#define WSP(off) ((bf16r*)(AWS() + (off)))

__global__ void __launch_bounds__(512) fwd_kernel(Args a) {
    extern __shared__ __attribute__((aligned(16))) unsigned char lds[];
    LAS unsigned char* ldsl = (LAS unsigned char*)lds;
    const int wave = __builtin_amdgcn_readfirstlane((int)threadIdx.x >> 6);
#define lane ((int)__builtin_amdgcn_mbcnt_hi(~0u, __builtin_amdgcn_mbcnt_lo(~0u, 0u)))
#define tid (wave * 64 + lane)
    const int G = gridDim.x, bx = blockIdx.x;
    const int gw = bx * 8 + wave, NGW = G * 8;
    const int lo = a.ph_lo, hi = a.ph_hi; int nbar = 0;
#define IN(k) (lo <= (k) && (k) < hi)
#define CBAR() do { asm volatile("s_waitcnt vmcnt(0)" ::: "memory"); ++nbar; __syncthreads(); \
            if (tid == 0) { unsigned* ctr = (unsigned*)AWS(); \
                __builtin_amdgcn_fence(__ATOMIC_RELEASE, "agent"); asm volatile("s_waitcnt vmcnt(0)" ::: "memory"); \
                __hip_atomic_fetch_add(ctr, 1u, __ATOMIC_RELAXED, __HIP_MEMORY_SCOPE_AGENT); \
                const unsigned target = (unsigned)nbar * (unsigned)G; \
                while (__hip_atomic_load(ctr, __ATOMIC_RELAXED, __HIP_MEMORY_SCOPE_AGENT) < target) __builtin_amdgcn_s_sleep(2); \
                __builtin_amdgcn_fence(__ATOMIC_ACQUIRE, "agent"); asm volatile("s_waitcnt vmcnt(0)" ::: "memory"); } \
            __syncthreads(); } while (0)
#define SEAM(k) do { if (IN(k) && IN((k) + 1)) { if ((k) == 0) { asm volatile("s_waitcnt vmcnt(0)" ::: "memory"); cg::this_grid().sync(); } else { CBAR(); } } } while (0)

    if (lo == 0 && hi > 1 && bx == 0 && tid == 0) __hip_atomic_store((unsigned*)AWS(), 0u, __ATOMIC_RELAXED, __HIP_MEMORY_SCOPE_AGENT);
    if (IN(0)) {
        unsigned char* const ws_ = AWS(); bf16r* const WIN = (bf16r*)(ws_ + WS_WIN); bf16r* const WO = (bf16r*)(ws_ + WS_WO); bf16r* const WQX = (bf16r*)(ws_ + WS_WQX); bf16r* const WKV = (bf16r*)(ws_ + WS_WKV); bf16r* const WOX = (bf16r*)(ws_ + WS_WOX); bf16r* const WGU = (bf16r*)(ws_ + WS_WGU); bf16r* const WDN = (bf16r*)(ws_ + WS_WDN); bf16r* const WPOOL = (bf16r*)(ws_ + WS_WPOOL); bf16r* const MN = (bf16r*)(ws_ + WS_MN); bf16r* const HN = (bf16r*)(ws_ + WS_HN);

        LAS float* scr = (LAS float*)(ldsl + wave * 16384);
        constexpr int I_IN = 32 * 128, I_SQ = 32 * 64, I_KV = 32 * 128, I_G = 32 * 176, I_DN = 88 * 64, I_P = 4 * 4 * 8;
        constexpr int NITEMS = I_IN + 3 * I_SQ + I_KV + 2 * I_G + I_DN + I_P;
        for (int it = gw; it < NITEMS; it += NGW) {
            int r = it;
            if (r < I_IN) { const int kb = r / 128, nb = r % 128; if (nb < 96) transpose_item(AIN(3), DIN, WIN, DM, 64 * kb, 32 * nb, 32 * nb, scr, lane); continue; } r -= I_IN;
            if (r < I_SQ) { const int kb = r / 64, nb = r % 64; transpose_item(AIN(11), DM, WO, DM, 64 * kb, 32 * nb, 32 * nb, scr, lane); continue; } r -= I_SQ;
            if (r < I_SQ) { continue; } r -= I_SQ;
            if (r < I_KV) { const int kb = r / 128, nb = r % 128; transpose_item(AIN(15), 2 * DM, WKV, DM, 64 * kb, 32 * nb, 32 * nb, scr, lane); continue; } r -= I_KV;
            if (r < I_SQ) { const int kb = r / 64, nb = r % 64; transpose_item(AIN(16), DM, WOX, DM, 64 * kb, 32 * nb, 32 * nb, scr, lane); continue; } r -= I_SQ;
            if (r < I_G) { const int kb = r / 176, nb = r % 176, n0 = 32 * nb; transpose_item(AIN(18), DFF, WGU, DM, 64 * kb, n0, 256 * (n0 >> 7) + (n0 & 127), scr, lane); continue; } r -= I_G;
            if (r < I_G) { const int kb = r / 176, nb = r % 176, n0 = 32 * nb; transpose_item(AIN(19), DFF, WGU, DM, 64 * kb, n0, 256 * (n0 >> 7) + 128 + (n0 & 127), scr, lane); continue; } r -= I_G;
            if (r < I_DN) { const int kb = r / 64, nb = r % 64; transpose_item(AIN(20), DM, WDN, DFF, 64 * kb, 32 * nb, 32 * nb, scr, lane); continue; } r -= I_DN;
            { const int gidx = r / 32, q = r % 32, kb = q / 8, nb = q % 8; transpose_item(AIN(9) + (size_t)gidx * 65536, 256, WPOOL + (size_t)gidx * 65536, 256, 64 * kb, 32 * nb, 32 * nb, scr, lane, AIN(10) + gidx * 256); }
        }
        { const float* win = AIN(3); bf16r* winu = (bf16r*)(ws_ + WS_WINU);
          for (int i = bx * 512 + tid; i < DM * 1024 / 8; i += G * 512) { const int k = i >> 7, j8 = (i & 127) * 8; const f32x4* sp = (const f32x4*)(win + (size_t)k * DIN + 3072 + j8);
              const f32x4 a0 = sp[0], a1 = sp[1]; v4u w; w.x = pk2(a0.x, a0.y); w.y = pk2(a0.z, a0.w); w.z = pk2(a1.x, a1.y); w.w = pk2(a1.z, a1.w); *(v4u*)(winu + (size_t)k * 1024 + j8) = w; } }
        { const f32x4* src = (const f32x4*)AIN(14); v4u* dst = (v4u*)WQX;
          for (int i = bx * 512 + tid; i < DM * DM / 8; i += G * 512) { const f32x4 a0 = src[2 * i], a1 = src[2 * i + 1]; v4u w; w.x = pk2(a0.x, a0.y); w.y = pk2(a0.z, a0.w); w.z = pk2(a1.x, a1.y); w.w = pk2(a1.z, a1.w); dst[i] = w; } }
        { const float* xin = AIN(0); const float* gin = AIN(2); for (int m = gw * 4; m < M; m += NGW * 4) rms_rows_f32_to_bf16<4>(xin, gin, HN, m, lane); }
        for (int m = gw; m < BATCH * MEM; m += NGW) rms_row_bf16(AIN(1) + (size_t)m * DM, AIN(13), MN + (size_t)m * DM, lane);
        __syncthreads();
    }
    SEAM(0);
    if (IN(1)) {
        unsigned char* const ws_ = AWS(); bf16r* const HN = (bf16r*)(ws_ + WS_HN); bf16r* const WIN = (bf16r*)(ws_ + WS_WIN); bf16r* const PROJ = (bf16r*)(ws_ + WS_PROJ);

        {
            pg8::Gemm gf{(bf16r*)(ws_ + WS_WPOOL), (bf16r*)(ws_ + WS_WINU), 256, 1024, 256, 1, 65536, 0, 256, 0}; pg8::BatchOrder Sf; Sf.init(256, DM, 4, G, bx);
            pg8::EpiBf16 Ef{WIN + (size_t)3072 * DM, DM, 1, (long)256 * DM, 0, nullptr, 0};
            pg8::gemm_phase<pg8::EpiBf16, pg8::BatchOrder, true>(ldsl, ldsl + XL_OFF, gf, Sf, Ef);
            CBAR();
        }
        pg8::Gemm g{HN, WIN, DM, DM, DM, 1, 0, 0, 0, 0}; pg8::StaticOrder S; S.init(M, DIN, G, bx);
        pg8::EpiProj E{PROJ, PROJ + (size_t)192 * 1024 * 1024 / 2};
        pg8::gemm_phase<pg8::EpiProj, pg8::StaticOrder, true>(ldsl, ldsl + XL_OFF, g, S, E);
    }
    SEAM(1);
    if (IN(1) && IN(2)) { for (int ps_ = 0; ps_ < PROBE_SEAMS; ++ps_) CBAR(); }
    if (IN(2)) {
        unsigned char* const ws_ = AWS(); bf16r* const PROJ = (bf16r*)(ws_ + WS_PROJ); bf16r* const POOLED = (bf16r*)(ws_ + WS_POOLED); bf16r* const O16 = (bf16r*)(ws_ + WS_O16);

        {
            constexpr int RUN = 32;
            const int ntask = (M / RUN) * 128;
            for (int task = bx * 512 + tid; task < ntask; task += G * 512) {
                const int c8 = task & 127, token0 = (task >> 7) * RUN, t0 = token0 & (SEQ - 1);
                const int wl = 2 << (c8 >> 5);
                const bf16r* up = PROJ + (size_t)192 * 1024 * 1024 / 2 + (size_t)token0 * 1024 + c8 * 8;
                bf16r* op = (bf16r*)(ws_ + WS_CONCAT) + (size_t)token0 * DM + 1024 + c8 * 8;
                float sacc[8];
#pragma unroll
                for (int e = 0; e < 8; ++e) sacc[e] = 0.f;
                for (int j = 1; j < wl; ++j) if (t0 - j >= 0) { const v4u w = *(const v4u*)(up - (size_t)j * 1024);
#pragma unroll
                    for (int e = 0; e < 4; ++e) { sacc[2 * e] += __builtin_bit_cast(float, w[e] << 16); sacc[2 * e + 1] += __builtin_bit_cast(float, w[e] & 0xffff0000u); } }
#pragma unroll 4
                for (int i = 0; i < RUN; ++i) {
                    const v4u w = *(const v4u*)(up + (size_t)i * 1024);
                    const int t = t0 + i; const bool full = (t + 1 >= wl);
                    const v4u wo = *(const v4u*)(up + (size_t)(full ? i - (wl - 1) : i) * 1024);
                    float u0[8];
#pragma unroll
                    for (int e = 0; e < 4; ++e) { u0[2 * e] = __builtin_bit_cast(float, w[e] << 16); u0[2 * e + 1] = __builtin_bit_cast(float, w[e] & 0xffff0000u); }
#pragma unroll
                    for (int e = 0; e < 8; ++e) sacc[e] += u0[e];
                    const float ic = 1.0f / (float)(full ? wl : t + 1);
                    v4u o;
#pragma unroll
                    for (int e = 0; e < 4; ++e) o[e] = pk2(sacc[2 * e] * ic - u0[2 * e], sacc[2 * e + 1] * ic - u0[2 * e + 1]);
                    *(v4u*)(op + (size_t)i * DM) = o;
                    if (full) {
#pragma unroll
                        for (int e = 0; e < 4; ++e) { sacc[2 * e] -= __builtin_bit_cast(float, wo[e] << 16); sacc[2 * e + 1] -= __builtin_bit_cast(float, wo[e] & 0xffff0000u); } }
                }
            }
        }
        __syncthreads();
        att2::attn_phase2((char*)lds, (const att::bf16*)PROJ, (att::bf16*)O16, G, bx, wave);
        __syncthreads();
    }
    SEAM(2);
    if (IN(3)) {
        unsigned char* const ws_ = AWS(); bf16r* const O16 = (bf16r*)(ws_ + WS_O16); bf16r* const CONCAT = (bf16r*)(ws_ + WS_CONCAT); bf16r* const POOLED = (bf16r*)(ws_ + WS_POOLED); bf16r* const WPOOL = (bf16r*)(ws_ + WS_WPOOL); bf16r* const MN = (bf16r*)(ws_ + WS_MN); bf16r* const WKV = (bf16r*)(ws_ + WS_WKV); bf16r* const KX = (bf16r*)(ws_ + WS_KX); bf16r* const VXT = (bf16r*)(ws_ + WS_VXT);

        {
            const float* lq1 = AIN(4); const float* lk1 = AIN(5); const float* lq2 = AIN(6); const float* lk2 = AIN(7); const float* subln = AIN(8);
            const float s1 = wave_sum(lq1[lane] * lk1[lane] + lq1[lane + 64] * lk1[lane + 64]);
            const float s2 = wave_sum(lq2[lane] * lk2[lane] + lq2[lane + 64] * lk2[lane + 64]);
            const float lam = __expf(s1) - __expf(s2) + LAM_INIT;
            const f32x4 sg = *((const f32x4*)subln + lane);
            for (int m = gw; m < M; m += NGW) {
                const bf16r* orow = O16 + (size_t)m * 2048; bf16r* crow_ = CONCAT + (size_t)m * 2048;
#pragma unroll
                for (int h = 0; h < 4; ++h) {
                    const v2u w1 = *(const v2u*)(orow + h * 512 + 4 * lane), w2 = *(const v2u*)(orow + h * 512 + 256 + 4 * lane);
                    float d[4];
                    d[0] = __builtin_bit_cast(float, w1.x << 16) - lam * __builtin_bit_cast(float, w2.x << 16);
                    d[1] = __builtin_bit_cast(float, w1.x & 0xffff0000u) - lam * __builtin_bit_cast(float, w2.x & 0xffff0000u);
                    d[2] = __builtin_bit_cast(float, w1.y << 16) - lam * __builtin_bit_cast(float, w2.y << 16);
                    d[3] = __builtin_bit_cast(float, w1.y & 0xffff0000u) - lam * __builtin_bit_cast(float, w2.y & 0xffff0000u);
                    const float ss = wave_sum((d[0] * d[0] + d[1] * d[1]) + (d[2] * d[2] + d[3] * d[3]));
                    const float rstd = rsqrtf(ss * (1.f / 256.f) + EPS) * (1.0f - LAM_INIT);
                    v2u o; o.x = pk2(d[0] * rstd * sg.x, d[1] * rstd * sg.y); o.y = pk2(d[2] * rstd * sg.z, d[3] * rstd * sg.w);
                    *(v2u*)(crow_ + h * 256 + 4 * lane) = o;
                }
            }
        }
        __syncthreads();
        {
            pg8::Gemm g{MN, WKV, DM, DM, DM, 1, 0, 0, 0, 0}; pg8::StaticOrder S; S.init(BATCH * MEM, 2 * DM, G, bx);
            pg8::EpiBf16 E{KX, 2 * DM, 1, 0, 0, nullptr, 0};
            pg8::gemm_phase<pg8::EpiBf16, pg8::StaticOrder, true>(ldsl, ldsl + XL_OFF, g, S, E);
        }
    }
    SEAM(3);
    if (IN(4)) {
        unsigned char* const ws_ = AWS(); bf16r* const CONCAT = (bf16r*)(ws_ + WS_CONCAT); bf16r* const WO = (bf16r*)(ws_ + WS_WO); float* const xres = AOUT();

        pg8::Gemm g{CONCAT, WO, DM, DM, DM, 1, 0, 0, 0, 0}; pg8::StaticOrder S; S.init(M, DM, G, bx);
        pg8::EpiResX<false, true> E{AIN(0), ws_ + WS_XB, DM};
        pg8::gemm_phase<pg8::EpiResX<false, true>, pg8::StaticOrder, true>(ldsl, ldsl + XL_OFF, g, S, E);
    }
    SEAM(4);
    if (IN(5)) {
        unsigned char* const ws_ = AWS(); bf16r* const HN = (bf16r*)(ws_ + WS_HN); float* const xres = AOUT();
 { const float* gin = AIN(12); for (int m = gw * 4; m < M; m += NGW * 4) rms_rows_bf16<4, false>((const bf16r*)(ws_ + WS_XB), gin, HN, m, lane); }
        bf16r* const KV = (bf16r*)(ws_ + WS_KX); bf16r* const WQN = (bf16r*)(ws_ + WS_WQX); bf16r* const WOXt = (bf16r*)(ws_ + WS_WOX);
        __syncthreads();
        {   pg8::Gemm g{KV, WQN, 2 * DM, DM, 512, 4, (long)MEM * 2 * DM, 512, 0, 512}; pg8::BatchOrder S; S.init(MEM, DM, 8, G, bx);
            pg8::EpiBf16 E{(bf16r*)(ws_ + WS_WQK), DM, 4, (long)1024 * DM, (long)MEM * DM, nullptr, 0};
            pg8::gemm_phase<pg8::EpiBf16, pg8::BatchOrder, true>(ldsl, ldsl + XL_OFF, g, S, E); }
        {   pg8::Gemm g{WOXt, KV + 2048, DM, 2 * DM, 512, 4, 0, 512, (long)MEM * 2 * DM, 512}; pg8::BatchOrder S; S.init(DM, MEM, 8, G, G - 1 - bx);
            pg8::EpiBf16 E{(bf16r*)(ws_ + WS_VWT), 1024, 4, (long)DM * 1024, MEM, nullptr, 0};
            pg8::gemm_phase<pg8::EpiBf16, pg8::BatchOrder, true>(ldsl, ldsl + XL_OFF, g, S, E); }
    }
    SEAM(5);
    if (IN(6)) {
        unsigned char* const ws_ = AWS(); bf16r* const HN = (bf16r*)(ws_ + WS_HN); bf16r* const PSC = (bf16r*)(ws_ + WS_PSC);
        pg8::Gemm g{HN, (bf16r*)(ws_ + WS_WQK), DM, DM, DM, 1, 0, 0, (long)1024 * DM, 0}; pg8::StaticOrderZ S; S.init(M, 1024, G, bx); S.zdiv = SEQ / 256;
        pg8::EpiSoftmax E{PSC, 0, 0.044194173824159216f * 1.4426950408889634f, 1024};
        pg8::gemm_phase<pg8::EpiSoftmax, pg8::StaticOrderZ, true>(ldsl, ldsl + XL_OFF, g, S, E);
    }
    SEAM(6);
    if (IN(9)) {
        unsigned char* const ws_ = AWS(); bf16r* const PSC = (bf16r*)(ws_ + WS_PSC);
        pg8::Gemm g{PSC, (bf16r*)(ws_ + WS_VWT), 1024, 1024, 1024, 1, 0, 0, (long)DM * 1024, 0}; pg8::StaticOrderZ S; S.init(M, DM, G, bx); S.zdiv = SEQ / 256;
        pg8::EpiResX<true, true> E{ws_ + WS_XB, ws_ + WS_XB, DM};
        pg8::gemm_phase<pg8::EpiResX<true, true>, pg8::StaticOrderZ, true>(ldsl, ldsl + XL_OFF, g, S, E);
    }
    SEAM(9);
    if (IN(10)) {
        unsigned char* const ws_ = AWS(); bf16r* const HN = (bf16r*)(ws_ + WS_HN); float* const xres = AOUT();
 { const float* gin = AIN(17); for (int m = gw * 4; m < M; m += NGW * 4) rms_rows_bf16<4, false>((const bf16r*)(ws_ + WS_XB), gin, HN, m, lane); } }
    SEAM(10);
    if (IN(11)) {
        unsigned char* const ws_ = AWS(); bf16r* const HN = (bf16r*)(ws_ + WS_HN); bf16r* const WGU = (bf16r*)(ws_ + WS_WGU); bf16r* const HID = (bf16r*)(ws_ + WS_HID);

        pg8::Gemm g{HN, WGU, DM, DM, DM, 1, 0, 0, 0, 0}; pg8::StaticOrder S; S.init(M, 2 * DFF, G, bx);
        pg8::EpiSwiGLU E{HID, DFF};
        pg8::gemm_phase<pg8::EpiSwiGLU, pg8::StaticOrder, true>(ldsl, ldsl + XL_OFF, g, S, E);
    }
    SEAM(11);
    if (IN(12)) {
        unsigned char* const ws_ = AWS(); bf16r* const HID = (bf16r*)(ws_ + WS_HID); bf16r* const WDN = (bf16r*)(ws_ + WS_WDN); float* const xres = AOUT();

        pg8::Gemm g{HID, WDN, DFF, DFF, DFF, 1, 0, 0, 0, 0}; pg8::StaticOrder S; S.init(M, DM, G, bx);
        pg8::EpiResX<true, true> E{ws_ + WS_XB, ws_ + WS_XB, DM};
        pg8::gemm_phase<pg8::EpiResX<true, true>, pg8::StaticOrder, true>(ldsl, ldsl + XL_OFF, g, S, E);
    }
    SEAM(12);
    if (IN(13)) {
        unsigned char* const ws_ = AWS(); float* const xres = AOUT();
 { const float* gin = AIN(21); for (int m = gw * 4; m < M; m += NGW * 4) rms_rows_bf16<4, true>((const bf16r*)(ws_ + WS_XB), gin, xres, m, lane); } }
#undef IN
#undef SEAM
#undef lane
#undef tid
}

extern "C" void kernel_launch(void* const* d_in, const int* in_sizes, int n_in, void* d_out, int out_size, void* d_ws, size_t ws_size, hipStream_t stream) {
    static int grid = 0;
    if (grid == 0) {
        if (n_in != 22 || in_sizes[0] != M * DM || out_size != M * DM || ws_size < WS_END) {
            fprintf(stderr, "kernel_launch: unexpected shapes n_in %d in0 %d out %d ws %zu (need %zu)\n", n_in, n_in > 0 ? in_sizes[0] : -1, out_size, ws_size, (size_t)WS_END); grid = -1; return; }
        int dev = 0, cus = 0, per_cu = 0;
        (void)hipGetDevice(&dev); (void)hipDeviceGetAttribute(&cus, hipDeviceAttributeMultiprocessorCount, dev);
        if (hipFuncSetAttribute((const void*)fwd_kernel, hipFuncAttributeMaxDynamicSharedMemorySize, LDS_BYTES) != hipSuccess) { fprintf(stderr, "kernel_launch: hipFuncSetAttribute failed\n"); grid = -1; return; }
        if (hipOccupancyMaxActiveBlocksPerMultiprocessor(&per_cu, (const void*)fwd_kernel, 512, LDS_BYTES) != hipSuccess || per_cu < 1) { fprintf(stderr, "kernel_launch: occupancy query gave %d\n", per_cu); per_cu = 1; }
        (void)hipGetLastError();
        if (cus <= 0) cus = 256;
        grid = cus * per_cu;
        if (grid > 256) grid = 256;
    }
    if (grid < 0) return;
    Args a{};
    for (int i = 0; i < 22; ++i) a.in[i] = (const float*)d_in[i];
    a.out = (float*)d_out; a.ws = (unsigned char*)d_ws;
#if MK_PER_PHASE
    for (int p = 0; p < NPHASE; ++p) { a.ph_lo = p; a.ph_hi = p + 1; hipLaunchKernelGGL(fwd_kernel, dim3(grid), dim3(512), LDS_BYTES, stream, a); }
#else
    const int cuts[4] = {0, PROBE_DUP >= 0 ? PROBE_DUP + 1 : NPHASE, PROBE_DUP >= 0 ? PROBE_DUP + 1 : NPHASE, NPHASE};
    for (int li = 0; li < (PROBE_DUP >= 0 ? 3 : 1); ++li) {
        a.ph_lo = cuts[li]; a.ph_hi = cuts[li + 1];
        if (PROBE_DUP >= 0 && li == 1) { a.ph_lo = PROBE_DUP; a.ph_hi = PROBE_DUP + 1; }
        if (!(a.ph_lo == 0 && a.ph_hi > 1)) (void)hipMemsetAsync(d_ws, 0, 256, stream);
        void* args[] = {&a};
        hipError_t e = hipLaunchCooperativeKernel((const void*)fwd_kernel, dim3(grid), dim3(512), args, LDS_BYTES, stream);
        if (e != hipSuccess) fprintf(stderr, "cooperative launch failed: %s (grid %d)\n", hipGetErrorString(e), grid);
    }
#endif
}
```

```cpp
#include <hip/hip_runtime.h>
#include <hip/hip_bf16.h>
#include <hip/hip_cooperative_groups.h>
#include <cstdio>
#include <cstdint>
namespace cg = cooperative_groups;

#ifndef PROBE_DUP
#define PROBE_DUP -1
#endif
#ifndef PROBE_SEAMS
#define PROBE_SEAMS 0
#endif
#ifndef MK_PER_PHASE
#define MK_PER_PHASE 0
#endif

constexpr int BATCH = 2, SEQ = 16384, DM = 2048, MEM = 256, DIN = 4096, DFF = 5632;
constexpr int M = BATCH * SEQ;
constexpr float EPS = 1e-6f;
constexpr float LAM_INIT = 0.2f;

namespace pg8 {
#define PG8_LAS __attribute__((address_space(3)))
typedef unsigned short bf16_t;
typedef short bf16x8 __attribute__((ext_vector_type(8)));
typedef float f32x4 __attribute__((ext_vector_type(4)));
typedef unsigned u32x4 __attribute__((ext_vector_type(4)));
constexpr int BM = 256, BK = 64, HALF = 128, HTB = HALF * BK * 2, STAGE_BYTES = 8 * HTB, NXCD = 8, WGM = 8;

__host__ __device__ __forceinline__ int lds_byte(int r, int c) { const int st = (r >> 4) * 2 + (c >> 5), rr = r & 15, cc = c & 31, ob = rr * 64 + cc * 2; return st * 1024 + (ob ^ (((ob >> 9) & 1) << 5)); }
__host__ __device__ __forceinline__ void stage_rc(int b, int& R, int& C) { const int st = b / 1024, sb = b % 1024, swz = sb ^ (((sb >> 9) & 1) << 5); R = (st >> 1) * 16 + swz / 64; C = (st & 1) * 32 + (swz % 64) / 2; }
__host__ __device__ __forceinline__ int perm32(int rho) { const int n = rho >> 4, i = rho & 15; return 8 * (i >> 2) + 4 * n + (i & 3); }

struct Unit { int pm, pn, z; };
struct Gemm { const bf16_t* A; const bf16_t* Bt; int lda, ldb, K, ZH; long sAb, sAh, sBb, sBh; };

struct StaticOrder {
    int nM, nN, nwg, G, c;
    __device__ void init(int Mr, int N, int G_, int c_) { nM = Mr / BM; nN = N / BM; nwg = nM * nN; G = G_; c = c_; }
    __device__ bool next(int i, Unit& u) const {
        const long L = (long)i * G + c; if (L >= nwg) return false;
        int wgid = (int)L; { const int q = nwg / NXCD, r = nwg % NXCD, xcd = wgid % NXCD, off = wgid / NXCD; wgid = (xcd < r ? xcd * (q + 1) : r * (q + 1) + (xcd - r) * q) + off; }
        const int nig = WGM * nN, gid = wgid / nig, fm = gid * WGM, gsz = (nM - fm) < WGM ? (nM - fm) : WGM;
        u.pm = fm + ((wgid % nig) % gsz); u.pn = (wgid % nig) / gsz; u.z = 0; return true;
    }
};
struct StaticOrderZ : StaticOrder {
    int zdiv;
    __device__ bool next(int i, Unit& u) const { if (!StaticOrder::next(i, u)) return false; u.z = u.pm / zdiv; return true; }
};
struct BatchOrder {
    int nM, nN, nwg, G, c;
    __device__ void init(int Mr, int N, int Z, int G_, int c_) { nM = Mr / BM; nN = N / BM; nwg = nM * nN * Z; G = G_; c = c_; }
    __device__ bool next(int i, Unit& u) const {
        const long L = (long)i * G + c; if (L >= nwg) return false;
        int l = (int)L; u.pn = l % nN; l /= nN; u.pm = l % nM; u.z = l / nM; return true;
    }
};

__device__ __forceinline__ unsigned cvt_pk_bf16(float lo, float hi) { unsigned r; asm volatile("v_cvt_pk_bf16_f32 %0, %1, %2" : "=v"(r) : "v"(lo), "v"(hi)); return r; }

typedef f32x4 Acc[2][2][4][2];

struct EpiBf16 {
    static constexpr bool PERM = true;
    bf16_t* O; int ldc, ZH; long sOb, sOh; const float* cscale; int nsc;
    __device__ __forceinline__ void operator()(Acc& acc, const Unit& u, int wr, int wc, int fr, int fq, PG8_LAS unsigned char*) const {
        const int row0 = u.pm * BM + wr * 64 + fr, col0 = u.pn * BM + wc * 32 + 8 * fq;
        bf16_t* base = O + (size_t)(u.z / ZH) * sOb + (size_t)(u.z % ZH) * sOh;
        f32x4 sv[2][2];
#pragma unroll
        for (int bj = 0; bj < 2; ++bj)
#pragma unroll
            for (int n = 0; n < 2; ++n) sv[bj][n] = cscale ? *(const f32x4*)(cscale + (size_t)u.z * nsc + col0 + bj * HALF + 4 * n) : (f32x4){1.f, 1.f, 1.f, 1.f};
#pragma unroll
        for (int ai = 0; ai < 2; ++ai)
#pragma unroll
            for (int m = 0; m < 4; ++m) { bf16_t* rowp = base + (size_t)(row0 + ai * HALF + m * 16) * ldc + col0;
#pragma unroll
                for (int bj = 0; bj < 2; ++bj) { f32x4 v0 = acc[ai][bj][m][0] * sv[bj][0], v1 = acc[ai][bj][m][1] * sv[bj][1];
                    u32x4 w; w.x = cvt_pk_bf16(v0[0], v0[1]); w.y = cvt_pk_bf16(v0[2], v0[3]); w.z = cvt_pk_bf16(v1[0], v1[1]); w.w = cvt_pk_bf16(v1[2], v1[3]);
                    *(u32x4*)(rowp + bj * HALF) = w; } }
    }
};
template <bool BASE_BF16, bool OUT_BF16> struct EpiResX {
    static constexpr bool PERM = true;
    const void* base; void* out; int ldc;
    __device__ __forceinline__ void operator()(Acc& acc, const Unit& u, int wr, int wc, int fr, int fq, PG8_LAS unsigned char*) const {
        const int col0 = u.pn * BM + wc * 32 + 8 * fq;
#pragma unroll
        for (int ai = 0; ai < 2; ++ai)
#pragma unroll
            for (int m = 0; m < 4; ++m) { const int r = ai * HALF + wr * 64 + m * 16 + fr; const size_t off = (size_t)(u.pm * BM + r) * ldc + col0;
                f32x4 bs[2][2];
#pragma unroll
                for (int bj = 0; bj < 2; ++bj) {
                    if constexpr (BASE_BF16) { const u32x4 w = *(const u32x4*)((const bf16_t*)base + off + bj * HALF);
                        bs[bj][0] = (f32x4){__builtin_bit_cast(float, w.x << 16), __builtin_bit_cast(float, w.x & 0xffff0000u), __builtin_bit_cast(float, w.y << 16), __builtin_bit_cast(float, w.y & 0xffff0000u)};
                        bs[bj][1] = (f32x4){__builtin_bit_cast(float, w.z << 16), __builtin_bit_cast(float, w.z & 0xffff0000u), __builtin_bit_cast(float, w.w << 16), __builtin_bit_cast(float, w.w & 0xffff0000u)}; }
                    else { bs[bj][0] = *(const f32x4*)((const float*)base + off + bj * HALF); bs[bj][1] = *(const f32x4*)((const float*)base + off + bj * HALF + 4); } }
#pragma unroll
                for (int bj = 0; bj < 2; ++bj) { const f32x4 v0 = bs[bj][0] + acc[ai][bj][m][0], v1 = bs[bj][1] + acc[ai][bj][m][1];
                    if constexpr (OUT_BF16) { u32x4 w; w.x = cvt_pk_bf16(v0[0], v0[1]); w.y = cvt_pk_bf16(v0[2], v0[3]); w.z = cvt_pk_bf16(v1[0], v1[1]); w.w = cvt_pk_bf16(v1[2], v1[3]);
                        *(u32x4*)((bf16_t*)out + off + bj * HALF) = w; }
                    else { *(f32x4*)((float*)out + off + bj * HALF) = v0; *(f32x4*)((float*)out + off + bj * HALF + 4) = v1; } }
                asm volatile("" ::: "memory"); }
    }
};
struct EpiProj {
    static constexpr bool PERM = true;
    bf16_t* QKVH; bf16_t* U;
    __device__ __forceinline__ void operator()(Acc& acc, const Unit& u, int wr, int wc, int fr, int fq, PG8_LAS unsigned char*) const {
        const int row0 = u.pm * BM + wr * 64 + fr, b = (u.pm * BM) / SEQ, s0 = row0 - b * SEQ, cin = wc * 32 + 8 * fq;
#pragma unroll
        for (int ai = 0; ai < 2; ++ai)
#pragma unroll
            for (int m = 0; m < 4; ++m) {
#pragma unroll
                for (int bj = 0; bj < 2; ++bj) { const f32x4 v0 = acc[ai][bj][m][0], v1 = acc[ai][bj][m][1];
                    u32x4 w; w.x = cvt_pk_bf16(v0[0], v0[1]); w.y = cvt_pk_bf16(v0[2], v0[3]); w.z = cvt_pk_bf16(v1[0], v1[1]); w.w = cvt_pk_bf16(v1[2], v1[3]);
                    bf16_t* dst = (u.pn < 12) ? QKVH + ((size_t)(b * 24 + u.pn * 2 + bj) * SEQ + (s0 + ai * HALF + m * 16)) * 128 + cin
                                              : U + (size_t)(row0 + ai * HALF + m * 16) * 1024 + (u.pn - 12) * 256 + bj * HALF + cin;
                    *(u32x4*)dst = w; } }
    }
};
struct EpiStoreF32 {
    static constexpr bool PERM = false;
    float* O; int ldc; long sOz;
    __device__ __forceinline__ void operator()(Acc& acc, const Unit& u, int wr, int wc, int fr, int fq, PG8_LAS unsigned char*) const {
        const int col0 = u.pn * BM + wc * 32 + 4 * fq; float* base = O + (size_t)u.z * sOz;
#pragma unroll
        for (int ai = 0; ai < 2; ++ai)
#pragma unroll
            for (int m = 0; m < 4; ++m) { const size_t off = (size_t)(u.pm * BM + ai * HALF + wr * 64 + m * 16 + fr) * ldc + col0;
#pragma unroll
                for (int bj = 0; bj < 2; ++bj)
#pragma unroll
                    for (int n = 0; n < 2; ++n) *(f32x4*)(base + off + bj * HALF + n * 16) = acc[ai][bj][m][n]; }
    }
};
struct EpiResF32 {
    static constexpr bool PERM = false;
    const float* base; float* out; int ldc;
    __device__ __forceinline__ void operator()(Acc& acc, const Unit& u, int wr, int wc, int fr, int fq, PG8_LAS unsigned char*) const {
        const int col0 = u.pn * BM + wc * 32 + 4 * fq;
#pragma unroll
        for (int ai = 0; ai < 2; ++ai)
#pragma unroll
            for (int m = 0; m < 4; ++m) { const int r = ai * HALF + wr * 64 + m * 16 + fr; const size_t off = (size_t)(u.pm * BM + r) * ldc + col0;
                f32x4 bs[2][2];
#pragma unroll
                for (int bj = 0; bj < 2; ++bj)
#pragma unroll
                    for (int n = 0; n < 2; ++n) bs[bj][n] = *(const f32x4*)(base + off + bj * HALF + n * 16);
#pragma unroll
                for (int bj = 0; bj < 2; ++bj)
#pragma unroll
                    for (int n = 0; n < 2; ++n) *(f32x4*)(out + off + bj * HALF + n * 16) = bs[bj][n] + acc[ai][bj][m][n];
                asm volatile("" ::: "memory"); }
    }
};
struct EpiSwiGLU {
    static constexpr bool PERM = true;
    bf16_t* O; int ldc;
    __device__ __forceinline__ void operator()(Acc& acc, const Unit& u, int wr, int wc, int fr, int fq, PG8_LAS unsigned char*) const {
        const int row0 = u.pm * BM + wr * 64 + fr, col0 = u.pn * HALF + wc * 32 + 8 * fq;
#pragma unroll
        for (int ai = 0; ai < 2; ++ai)
#pragma unroll
            for (int m = 0; m < 4; ++m) { bf16_t* rowp = O + (size_t)(row0 + ai * HALF + m * 16) * ldc + col0;
                float h[8];
#pragma unroll
                for (int n = 0; n < 2; ++n)
#pragma unroll
                    for (int e = 0; e < 4; ++e) { const float gt = acc[ai][0][m][n][e], up = acc[ai][1][m][n][e];
                        const float sg = __builtin_amdgcn_rcpf(1.f + __builtin_amdgcn_exp2f(-1.4426950408889634f * gt));
                        h[n * 4 + e] = gt * sg * up; }
                u32x4 w; w.x = cvt_pk_bf16(h[0], h[1]); w.y = cvt_pk_bf16(h[2], h[3]); w.z = cvt_pk_bf16(h[4], h[5]); w.w = cvt_pk_bf16(h[6], h[7]);
                *(u32x4*)rowp = w; }
    }
};
struct EpiSoftmax {
    static constexpr bool PERM = true;
    bf16_t* O; long sOz; float sc2; int ldc;
    __device__ __forceinline__ void operator()(Acc& acc, const Unit& u, int wr, int wc, int fr, int fq, PG8_LAS unsigned char* xl) const {
        PG8_LAS float* MX = (PG8_LAS float*)xl;
        PG8_LAS float* SMv = (PG8_LAS float*)(xl + 4096);
#pragma unroll
        for (int ai = 0; ai < 2; ++ai)
#pragma unroll
            for (int m = 0; m < 4; ++m) { float mx = -3.0e38f;
#pragma unroll
                for (int bj = 0; bj < 2; ++bj)
#pragma unroll
                    for (int n = 0; n < 2; ++n) { f32x4 s = acc[ai][bj][m][n] * sc2; acc[ai][bj][m][n] = s; mx = fmaxf(mx, fmaxf(fmaxf(s[0], s[1]), fmaxf(s[2], s[3]))); }
                mx = fmaxf(mx, __shfl_xor(mx, 16)); mx = fmaxf(mx, __shfl_xor(mx, 32));
                if (fq == 0) MX[(ai * HALF + wr * 64 + m * 16 + fr) * 4 + wc] = mx; }
        asm volatile("s_waitcnt lgkmcnt(0)" ::: "memory"); __builtin_amdgcn_s_barrier(); asm volatile("" ::: "memory");
#pragma unroll
        for (int ai = 0; ai < 2; ++ai)
#pragma unroll
            for (int m = 0; m < 4; ++m) { const int r = ai * HALF + wr * 64 + m * 16 + fr;
                const f32x4 q = *(const PG8_LAS f32x4*)(MX + r * 4); const float rm = fmaxf(fmaxf(q[0], q[1]), fmaxf(q[2], q[3]));
                float sm = 0.f;
#pragma unroll
                for (int bj = 0; bj < 2; ++bj)
#pragma unroll
                    for (int n = 0; n < 2; ++n) { f32x4 s = acc[ai][bj][m][n];
#pragma unroll
                        for (int e = 0; e < 4; ++e) { s[e] = __builtin_amdgcn_exp2f(s[e] - rm); sm += s[e]; }
                        acc[ai][bj][m][n] = s; }
                sm += __shfl_xor(sm, 16); sm += __shfl_xor(sm, 32);
                if (fq == 0) SMv[r * 4 + wc] = sm; }
        asm volatile("s_waitcnt lgkmcnt(0)" ::: "memory"); __builtin_amdgcn_s_barrier(); asm volatile("" ::: "memory");
        const int row0 = u.pm * BM + wr * 64 + fr, col0 = wc * 32 + 8 * fq;
        bf16_t* base = O + (size_t)u.z * sOz;
#pragma unroll
        for (int ai = 0; ai < 2; ++ai)
#pragma unroll
            for (int m = 0; m < 4; ++m) { const int r = ai * HALF + wr * 64 + m * 16 + fr;
                const f32x4 q = *(const PG8_LAS f32x4*)(SMv + r * 4); const float inv = 1.0f / ((q[0] + q[1]) + (q[2] + q[3]));
                bf16_t* rowp = base + (size_t)(row0 + ai * HALF + m * 16) * ldc + u.pn * BM + col0;
#pragma unroll
                for (int bj = 0; bj < 2; ++bj) { const f32x4 v0 = acc[ai][bj][m][0] * inv, v1 = acc[ai][bj][m][1] * inv;
                    u32x4 w; w.x = cvt_pk_bf16(v0[0], v0[1]); w.y = cvt_pk_bf16(v0[2], v0[3]); w.z = cvt_pk_bf16(v1[0], v1[1]); w.w = cvt_pk_bf16(v1[2], v1[3]);
                    *(u32x4*)(rowp + bj * HALF) = w; } }
    }
};

template <class Epi, class Sched, bool ALIGN_EPI>
__device__ __forceinline__ void gemm_phase(PG8_LAS unsigned char* lds, PG8_LAS unsigned char* xl, const Gemm g, const Sched& S, const Epi& E) {
    const int tid = threadIdx.x, wid = __builtin_amdgcn_readfirstlane(tid >> 6), lane = tid & 63, wr = wid >> 2, wc = wid & 3, fr = lane & 15, fq = lane >> 4;
    const int K = g.K, nt = K / BK;
    unsigned voffA[2], voffB[2];
#pragma unroll
    for (int i = 0; i < 2; ++i) { int R, C; stage_rc(tid * 16 + i * 8192, R, C); const int Rb = Epi::PERM ? ((R & ~31) + perm32(R & 31)) : R;
        voffA[i] = (unsigned)(R * g.lda + C) * 2u; voffB[i] = (unsigned)(Rb * g.ldb + C) * 2u; }
    const size_t kstep = (size_t)(BK * 2);
    const size_t hstepA = (size_t)HALF * g.lda * 2, hstepB = (size_t)HALF * g.ldb * 2;
    const unsigned ldsw = (unsigned)wid * 1024u;
    const int aoff = lds_byte(wr * 64 + fr, fq * 8), boff = lds_byte(wc * 32 + fr, fq * 8);
#define PG8_APTR(u_) ((const char*)g.A + 2 * ((size_t)((u_).z / g.ZH) * g.sAb + (size_t)((u_).z % g.ZH) * g.sAh) + (size_t)(u_).pm * 2 * hstepA)
#define PG8_BPTR(u_) ((const char*)g.Bt + 2 * ((size_t)((u_).z / g.ZH) * g.sBb + (size_t)((u_).z % g.ZH) * g.sBh) + (size_t)(u_).pn * 2 * hstepB)
#define PG8_SA(b, h) (((b) * 2 + (h)) * HTB)
#define PG8_SB(b, h) ((4 + (b) * 2 + (h)) * HTB)
#define PG8_STAGE(bufoff, gbase, voff) do { _Pragma("unroll") for (int _i = 0; _i < 2; ++_i) \
        __builtin_amdgcn_global_load_lds((const unsigned*)((const char*)(gbase) + (voff)[_i]), (PG8_LAS unsigned*)(lds + (bufoff) + ldsw + _i * 8192), 16, 0, 0); } while (0)
#define PG8_LDA(dst, b, h) do { _Pragma("unroll") for (int m = 0; m < 4; ++m) _Pragma("unroll") for (int k = 0; k < 2; ++k) dst[m][k] = *(const PG8_LAS bf16x8*)(lds + PG8_SA(b, h) + aoff + m * 2048 + k * 1024); } while (0)
#define PG8_LDB(dst, b, h) do { _Pragma("unroll") for (int n = 0; n < 2; ++n) _Pragma("unroll") for (int k = 0; k < 2; ++k) dst[n][k] = *(const PG8_LAS bf16x8*)(lds + PG8_SB(b, h) + boff + n * 2048 + k * 1024); } while (0)
#define PG8_MMA(ai, bj, At, Bt) do { __builtin_amdgcn_s_setprio(1); _Pragma("unroll") for (int m = 0; m < 4; ++m) _Pragma("unroll") for (int n = 0; n < 2; ++n) _Pragma("unroll") for (int k = 0; k < 2; ++k) \
        acc[ai][bj][m][n] = __builtin_amdgcn_mfma_f32_16x16x32_bf16(Bt[n][k], At[m][k], acc[ai][bj][m][n], 0, 0, 0); __builtin_amdgcn_s_setprio(0); } while (0)
#define PG8_WAIT_V(n) asm volatile("s_waitcnt vmcnt(" #n ")" ::: "memory")
#define PG8_WAIT_L(n) asm volatile("s_waitcnt lgkmcnt(" #n ")" ::: "memory")
#define PG8_BAR __builtin_amdgcn_s_barrier()
#define PG8_SCHED __builtin_amdgcn_sched_barrier(0)
    Unit cur, nxt; int ui = 0;
    if (!S.next(0, cur)) return;
    Acc acc;
#pragma unroll
    for (int a = 0; a < 2; ++a)
#pragma unroll
        for (int b = 0; b < 2; ++b)
#pragma unroll
            for (int m = 0; m < 4; ++m)
#pragma unroll
                for (int n = 0; n < 2; ++n) acc[a][b][m][n] = (f32x4){0.f, 0.f, 0.f, 0.f};
    bf16x8 At[4][2], B0[2][2], B1[2][2];
    const char* cA = PG8_APTR(cur); const char* cB = PG8_BPTR(cur);
    PG8_STAGE(PG8_SB(0, 0), cB, voffB); PG8_STAGE(PG8_SB(0, 1), cB + hstepB, voffB); PG8_STAGE(PG8_SA(0, 0), cA, voffA); PG8_STAGE(PG8_SA(0, 1), cA + hstepA, voffA);
    if (wr == 1) PG8_BAR;
    PG8_WAIT_V(2); PG8_BAR;
    PG8_STAGE(PG8_SB(1, 0), cB + kstep, voffB); PG8_STAGE(PG8_SA(1, 0), cA + kstep, voffA); PG8_STAGE(PG8_SB(1, 1), cB + hstepB + kstep, voffB);
    PG8_WAIT_V(6); PG8_BAR;
    for (;;) {
        const bool has_next = S.next(ui + 1, nxt);
        const char* nA = has_next ? PG8_APTR(nxt) : cA; const char* nB = has_next ? PG8_BPTR(nxt) : cB;
        for (int t = 0; t < nt; t += 2) {
            const bool last = (t == nt - 2);
            const char* a1 = cA + (size_t)(t + 1) * kstep;
            const char* a2 = last ? nA : cA + (size_t)(t + 2) * kstep; const char* b2 = last ? nB : cB + (size_t)(t + 2) * kstep;
            const char* a3 = a2 + kstep; const char* b3 = b2 + kstep;
            PG8_LDB(B0, 0, 0); PG8_LDB(B1, 0, 1); PG8_SCHED; PG8_LDA(At, 0, 0); PG8_STAGE(PG8_SA(1, 1), a1 + hstepA, voffA);
            PG8_WAIT_V(8); PG8_WAIT_L(0); PG8_BAR; PG8_MMA(0, 0, At, B0); PG8_MMA(0, 1, At, B1); PG8_BAR; PG8_SCHED;
            PG8_LDA(At, 0, 1); PG8_STAGE(PG8_SB(0, 0), b2, voffB); PG8_STAGE(PG8_SB(0, 1), b2 + hstepB, voffB); PG8_STAGE(PG8_SA(0, 0), a2, voffA);
            PG8_WAIT_V(8); PG8_WAIT_L(0); PG8_BAR; PG8_MMA(1, 0, At, B0); PG8_MMA(1, 1, At, B1); PG8_BAR; PG8_SCHED;
            PG8_LDB(B0, 1, 0); PG8_LDB(B1, 1, 1); PG8_SCHED; PG8_LDA(At, 1, 0); PG8_STAGE(PG8_SA(0, 1), a2 + hstepA, voffA);
            PG8_WAIT_V(8); PG8_WAIT_L(0); PG8_BAR; PG8_MMA(0, 0, At, B0); PG8_MMA(0, 1, At, B1); PG8_BAR; PG8_SCHED;
            PG8_LDA(At, 1, 1); PG8_STAGE(PG8_SB(1, 0), b3, voffB); PG8_STAGE(PG8_SB(1, 1), b3 + hstepB, voffB); PG8_STAGE(PG8_SA(1, 0), a3, voffA);
            PG8_WAIT_V(8); PG8_WAIT_L(0); PG8_BAR; PG8_MMA(1, 0, At, B0); PG8_MMA(1, 1, At, B1); PG8_BAR; PG8_SCHED;
        }
        if constexpr (ALIGN_EPI) { if (wr == 0) PG8_BAR; }
        E(acc, cur, wr, wc, fr, fq, xl);
        if (!has_next) break;
#pragma unroll
        for (int a = 0; a < 2; ++a)
#pragma unroll
            for (int b = 0; b < 2; ++b)
#pragma unroll
                for (int m = 0; m < 4; ++m)
#pragma unroll
                    for (int n = 0; n < 2; ++n) acc[a][b][m][n] = (f32x4){0.f, 0.f, 0.f, 0.f};
        cur = nxt; cA = nA; cB = nB; ++ui;
        if constexpr (ALIGN_EPI) { if (wr == 1) PG8_BAR; }
    }
    PG8_WAIT_V(0);
    if constexpr (!ALIGN_EPI) { if (wr == 0) PG8_BAR; }
    PG8_BAR;
#undef PG8_APTR
#undef PG8_BPTR
#undef PG8_SA
#undef PG8_SB
#undef PG8_STAGE
#undef PG8_LDA
#undef PG8_LDB
#undef PG8_MMA
#undef PG8_WAIT_V
#undef PG8_WAIT_L
#undef PG8_BAR
#undef PG8_SCHED
}
}

namespace att {
constexpr int D = 128;
constexpr int PIN = DIN;
constexpr int POUT = 2048;
constexpr float SCALE = 0.08838834764831845f;
constexpr float THR = 8.f;
constexpr int NW = 8, QBLK = 32, KVBLK = 64, QB = NW * QBLK;
constexpr int SHM_V = KVBLK * D * 2, SHM_K = KVBLK * D * 2;
constexpr int LDS_BYTES = 2 * SHM_V + 2 * SHM_K + NW * 64 * 4;
using bf16 = __hip_bfloat16;
typedef short bf16x8 __attribute__((ext_vector_type(8)));
typedef short s16x4 __attribute__((ext_vector_type(4)));
typedef float f32x16 __attribute__((ext_vector_type(16)));
typedef float f32x4 __attribute__((ext_vector_type(4)));
typedef unsigned u32x4 __attribute__((ext_vector_type(4)));

#define KSWZ(row, colB) ((row) * 256 + ((colB) ^ (((row) & 7) << 4)))
#define SBAR() __builtin_amdgcn_sched_barrier(0)
__device__ __forceinline__ int v_st(int k, int c) { const int kk = (k & ~0xC) | ((k & 4) << 1) | ((k & 8) >> 1); return ((kk >> 3) * 4 + (c >> 5)) * 512 + ((kk & 7) * 32 + (c & 31)) * 2; }
__device__ __forceinline__ int v_rd_base(int lane) { return ((lane & 3) << 3) | (((lane >> 2) & 3) << 6) | (((lane >> 4) & 1) << 5) | (((lane >> 5) & 1) << 8); }
constexpr int v_rd_off(int d0, int ks, int half) { return d0 * 512 + ks * 4096 + half * 2048; }
__device__ __forceinline__ int crow(int r, int hi) { return (r & 3) + 8 * (r >> 2) + 4 * hi; }
__device__ __forceinline__ unsigned cvtpk(float lo, float hi) { unsigned r; asm volatile("v_cvt_pk_bf16_f32 %0, %1, %2" : "=v"(r) : "v"(lo), "v"(hi)); return r; }
__device__ __forceinline__ bf16x8 load8(const bf16* p) { return *reinterpret_cast<const bf16x8*>(p); }
__device__ __forceinline__ void mask_tile(f32x16& p0, f32x16& p1, int dq, unsigned W) {
    const float NEG = -__builtin_inff();
#pragma unroll
    for (int r = 0; r < 16; ++r) {
        const int c = (r & 3) + 8 * (r >> 2);
        if ((unsigned)(dq - c) >= W) p0[r] = NEG;
        if ((unsigned)(dq - c - 32) >= W) p1[r] = NEG;
    }
}
__device__ __forceinline__ void partialSM(f32x16& p0, f32x16& p1, float& m_reg, float& mn, float& alpha) {
    float pmax = p0[0]; for (int r = 1; r < 16; ++r) pmax = fmaxf(pmax, p0[r]); for (int r = 0; r < 16; ++r) pmax = fmaxf(pmax, p1[r]);
    { auto rr = __builtin_amdgcn_permlane32_swap(__float_as_uint(pmax), __float_as_uint(pmax), false, false);
      pmax = fmaxf(__uint_as_float(rr[0]), __uint_as_float(rr[1])); }
    constexpr float C2 = 1.4426950408889634f * SCALE;
    if (__builtin_expect(__all((pmax - m_reg) * SCALE <= THR), 1)) { mn = m_reg; alpha = 1.f; }
    else { mn = fmaxf(m_reg, pmax); alpha = __builtin_amdgcn_exp2f((m_reg - mn) * C2); m_reg = mn; }
    const float mnL = -mn * C2;
    for (int r = 0; r < 16; ++r) p0[r] = fmaf(p0[r], C2, mnL); for (int r = 0; r < 16; ++r) p1[r] = fmaf(p1[r], C2, mnL);
    for (int r = 0; r < 16; ++r) p0[r] = __builtin_amdgcn_exp2f(p0[r]);
}
__device__ __forceinline__ void finishSM(f32x16& p0, f32x16& p1, float alpha, float& l_reg, bf16x8& pa0, bf16x8& pa1, bf16x8& pa2, bf16x8& pa3) {
    for (int r = 0; r < 16; ++r) p1[r] = __builtin_amdgcn_exp2f(p1[r]);
    float ps = 0; for (int r = 0; r < 16; ++r) ps += p0[r]; for (int r = 0; r < 16; ++r) ps += p1[r];
    { auto rr = __builtin_amdgcn_permlane32_swap(__float_as_uint(ps), __float_as_uint(ps), false, false);
      ps = __uint_as_float(rr[0]) + __uint_as_float(rr[1]); }
    l_reg = l_reg * alpha + ps;
#define PK4(P, B_, OUT) do { unsigned a0 = cvtpk(P[B_+0], P[B_+1]), a1 = cvtpk(P[B_+2], P[B_+3]);                          \
        unsigned b0 = cvtpk(P[B_+4], P[B_+5]), b1 = cvtpk(P[B_+6], P[B_+7]);                                             \
        auto r0 = __builtin_amdgcn_permlane32_swap(a0, b0, false, false); auto r1 = __builtin_amdgcn_permlane32_swap(a1, b1, false, false); \
        u32x4 w = {r0[0], r1[0], r0[1], r1[1]}; OUT = *reinterpret_cast<bf16x8*>(&w); } while (0)
    PK4(p0, 0, pa0); PK4(p0, 8, pa1); PK4(p1, 0, pa2); PK4(p1, 8, pa3);
#undef PK4
}
template <int KB>
__device__ __forceinline__ void qkt(f32x16& p0, f32x16& p1, const char* K_lds, int r32, int hi, const bf16x8* qr) {
    p0 = f32x16{}; p1 = f32x16{};
    const char* kb[4];
#pragma unroll
    for (int dd = 0; dd < 4; ++dd) kb[dd] = K_lds + KB * SHM_K + KSWZ(r32, (dd * 16 + hi * 8) * 2);
#pragma unroll
    for (int d0 = 0; d0 < 8; ++d0) { const char* a = kb[d0 & 3] + (d0 >> 2) * 128;
        bf16x8 b0 = *reinterpret_cast<const bf16x8*>(a);
        bf16x8 b1 = *reinterpret_cast<const bf16x8*>(a + 32 * 256);
        p0 = __builtin_amdgcn_mfma_f32_32x32x16_bf16(b0, qr[d0], p0, 0, 0, 0);
        p1 = __builtin_amdgcn_mfma_f32_32x32x16_bf16(b1, qr[d0], p1, 0, 0, 0); }
}
template <int VB>
__device__ __forceinline__ void pv_tile(f32x16* o, int vb0, bf16x8 pa0, bf16x8 pa1, bf16x8 pa2, bf16x8 pa3) {
#define TRRD(dst, off) asm volatile("ds_read_b64_tr_b16 %0, %1 offset:%2" : "=&v"(dst) : "v"(vb0), "i"(off) : "memory")
#define PV_D0(d0) do { s16x4 l0, l1, l2, l3, h0, h1, h2, h3; constexpr int b_ = VB * SHM_V + v_rd_off(d0, 0, 0); \
        TRRD(l0, b_); TRRD(h0, b_ + 2048); TRRD(l1, b_ + 4096); TRRD(h1, b_ + 6144); TRRD(l2, b_ + 8192); TRRD(h2, b_ + 10240); TRRD(l3, b_ + 12288); TRRD(h3, b_ + 14336); \
        asm volatile("s_waitcnt lgkmcnt(0)" ::: "memory"); SBAR();   \
        o[d0] = __builtin_amdgcn_mfma_f32_32x32x16_bf16(pa0, (bf16x8){l0[0], l0[1], l0[2], l0[3], h0[0], h0[1], h0[2], h0[3]}, o[d0], 0, 0, 0);   \
        o[d0] = __builtin_amdgcn_mfma_f32_32x32x16_bf16(pa1, (bf16x8){l1[0], l1[1], l1[2], l1[3], h1[0], h1[1], h1[2], h1[3]}, o[d0], 0, 0, 0);   \
        o[d0] = __builtin_amdgcn_mfma_f32_32x32x16_bf16(pa2, (bf16x8){l2[0], l2[1], l2[2], l2[3], h2[0], h2[1], h2[2], h2[3]}, o[d0], 0, 0, 0);   \
        o[d0] = __builtin_amdgcn_mfma_f32_32x32x16_bf16(pa3, (bf16x8){l3[0], l3[1], l3[2], l3[3], h3[0], h3[1], h3[2], h3[3]}, o[d0], 0, 0, 0); } while (0)
    PV_D0(0); PV_D0(1); PV_D0(2); PV_D0(3);
#undef PV_D0
#undef TRRD
}

struct BlockRef { const bf16* Q; const bf16* K; const bf16* V; bf16* O; int P0; };
struct Seam { bf16x8 qr[8]; bf16x8 st_v0, st_v1, st_k0, st_k1; };
#define ROW(p, k0, rr) ((p) + (size_t)((k0) + (rr)) * PIN + sc)
#define VMW() asm volatile("s_waitcnt vmcnt(0)" ::: "memory")
#define VMWN(n) asm volatile("s_waitcnt vmcnt(%0)" :: "i"(n) : "memory")
#define SLOAD_H(Kp, Vp, k0) do { S.st_v0 = load8(ROW(Vp, k0, sr)); S.st_v1 = load8(ROW(Vp, k0, 32 + sr));              \
                         S.st_k0 = load8(ROW(Kp, k0, sr)); S.st_k1 = load8(ROW(Kp, k0, 32 + sr)); } while (0)
#define SWRITE_HK(bf) do { *(bf16x8*)(K_lds + (bf) * SHM_K + kws) = S.st_k0; *(bf16x8*)(K_lds + (bf) * SHM_K + kws + 32 * 256) = S.st_k1; } while (0)
#define SWRITE_HV(bf) do { *(bf16x8*)(V_lds + (bf) * SHM_V + vst0) = S.st_v0; *(bf16x8*)(V_lds + (bf) * SHM_V + vst1) = S.st_v1; } while (0)
#define SWRITE_H(bf) do { SWRITE_HV(bf); SWRITE_HK(bf); } while (0)
__device__ __forceinline__ void causal_prime(const BlockRef& cur, char* lds, Seam& S) {
    const int tid = threadIdx.x, wid = __builtin_amdgcn_readfirstlane(tid >> 6), lane = tid & 63, r32 = lane & 31, hi = lane >> 5;
    const int sr = tid >> 4, sc = (tid & 15) * 8, kws = KSWZ(sr, sc * 2); char* K_lds = lds + 2 * SHM_V;
    const int kb0 = 0;
    for (int d0 = 0; d0 < 8; ++d0) S.qr[d0] = load8(cur.Q + (size_t)(wid * QBLK + r32) * PIN + d0 * 16 + hi * 8);
    SLOAD_H(cur.K, cur.V, kb0); VMW(); SWRITE_HK(0);
    __syncthreads();
}
__device__ __forceinline__ void causal_block(const BlockRef& cur, const BlockRef& nxt, int skv, char* lds, Seam& S) {
    const int W = 1 << 30;
    const int tid = threadIdx.x, wid = __builtin_amdgcn_readfirstlane(tid >> 6), lane = tid & 63, r32 = lane & 31, hi = lane >> 5;
    const int j_lo = 0;
    int j_hi = (cur.P0 + QB - 1) / KVBLK + 1; if (j_hi > skv / KVBLK) j_hi = skv / KVBLK;
    const int NT = j_hi - j_lo;
    const int kbn = 0;
    const int qlo = cur.P0 + wid * QBLK, qm = qlo + r32 - 4 * hi;
    char* V_lds = lds; char* K_lds = lds + 2 * SHM_V;
    float* ws = (float*)(lds + 2 * SHM_V + 2 * SHM_K) + wid * 64; float* li_l = ws, * al_l = ws + 32;
    float m_reg = -1e30f, l_reg = 0; f32x16 o[4] = {};
    const int sr = tid >> 4, sc = (tid & 15) * 8, vst0 = v_st(sr, sc), vst1 = v_st(32 + sr, sc), kws = KSWZ(sr, sc * 2);
    const int vb0 = (int)(uintptr_t)V_lds + v_rd_base(lane);
    const bf16* Kh = cur.K; const bf16* Vh = cur.V;
#define RESC(a) do { if (__any((a) < 1.f)) { if (hi == 0) al_l[r32] = (a); asm volatile("s_waitcnt lgkmcnt(0)" ::: "memory");              \
                     for (int d_ = 0; d_ < 4; ++d_) for (int r = 0; r < 16; ++r) o[d_][r] *= al_l[crow(r, hi)]; } } while (0)
#define KBASE(t) ((j_lo + (t)) * KVBLK)
#define MASKT(P0_, P1_, t) do { const int kb_ = KBASE(t); if (kb_ + KVBLK - 1 > qlo) mask_tile(P0_, P1_, qm - kb_, (unsigned)W); } while (0)
    constexpr int NQL = 8;
#define SEAM_K0() do { VMWN(NQL); SWRITE_HK(0); SBAR(); } while (0)
    f32x16 pA0, pA1, pB0, pB1; float mnA, mnB, alA, alB; bf16x8 pa0, pa1, pa2, pa3;
    SWRITE_HV(0); SBAR();
    if (NT > 1) { SLOAD_H(Kh, Vh, KBASE(1)); }
    SBAR(); qkt<0>(pA0, pA1, K_lds, r32, hi, S.qr);
    MASKT(pA0, pA1, 0); partialSM(pA0, pA1, m_reg, mnA, alA);
    if (NT > 1) { VMW(); SWRITE_H(1); }
    __syncthreads();
#define HALF_STEP(PX0, PX1, mnX, alX, PY0, PY1, alY, t, KB, VB, SB) do {                                                      \
        SBAR(); qkt<KB>(PX0, PX1, K_lds, r32, hi, S.qr);                                                                      \
        finishSM(PY0, PY1, alY, l_reg, pa0, pa1, pa2, pa3); SBAR();                                                           \
        if ((t) + 1 < NT) { SLOAD_H(Kh, Vh, KBASE((t) + 1)); SBAR(); }                                                        \
        pv_tile<VB>(o, vb0, pa0, pa1, pa2, pa3); MASKT(PX0, PX1, (t)); partialSM(PX0, PX1, m_reg, mnX, alX);                  \
        __syncthreads();                                                                                                      \
        if ((t) + 1 < NT) { VMW(); SWRITE_H(SB); }                                                                            \
        RESC(alX); __syncthreads(); } while (0)
    for (int t = 1; t + 1 < NT; t += 2) {
        HALF_STEP(pB0, pB1, mnB, alB, pA0, pA1, alA, t, 1, 0, 0);
        HALF_STEP(pA0, pA1, mnA, alA, pB0, pB1, alB, t + 1, 0, 1, 1);
    }
    const bool even = (NT & 1) == 0;
    if (even) { SBAR(); qkt<1>(pB0, pB1, K_lds, r32, hi, S.qr); SBAR(); }
    SLOAD_H(nxt.K, nxt.V, kbn); SBAR();
#pragma unroll
    for (int d0 = 0; d0 < 8; ++d0) S.qr[d0] = load8(nxt.Q + (size_t)(wid * QBLK + r32) * PIN + d0 * 16 + hi * 8);
    SBAR();
    finishSM(pA0, pA1, alA, l_reg, pa0, pa1, pa2, pa3); SBAR();
    pv_tile<0>(o, vb0, pa0, pa1, pa2, pa3);
    if (even) { MASKT(pB0, pB1, NT - 1); partialSM(pB0, pB1, m_reg, mnB, alB); __syncthreads(); RESC(alB);
        finishSM(pB0, pB1, alB, l_reg, pa0, pa1, pa2, pa3); SBAR(); pv_tile<1>(o, vb0, pa0, pa1, pa2, pa3); }
    SBAR(); SEAM_K0();
    if (hi == 0) li_l[r32] = l_reg; asm volatile("s_waitcnt lgkmcnt(0)" ::: "memory");
    float rli[16];
#pragma unroll
    for (int r = 0; r < 16; ++r) rli[r] = __builtin_amdgcn_rcpf(li_l[crow(r, hi)]);
    bf16* Ow = cur.O + (size_t)(wid * QBLK) * POUT;
#pragma unroll
    for (int r = 0; r < 16; ++r) { const int orow = crow(r, hi);
#pragma unroll
        for (int d0 = 0; d0 < 4; ++d0) { const float v = o[d0][r] * rli[r];
            const float vn = __shfl_xor(v, 1);
            if ((r32 & 1) == 0) *(unsigned*)(Ow + (size_t)orow * POUT + d0 * 32 + r32) = cvtpk(v, vn); } }
    __syncthreads();
#undef RESC
#undef KBASE
#undef MASKT
#undef SEAM_K0
#undef HALF_STEP
}
#undef ROW
#undef VMW
#undef VMWN
#undef SLOAD_H
#undef SWRITE_HK
#undef SWRITE_HV
#undef SWRITE_H
#undef KSWZ
#undef SBAR

__device__ __forceinline__ BlockRef make_ref(int L, int pass, const bf16* PROJ, bf16* O16) {
    const int xcd = L & 7, kk = L >> 3, p = xcd * 4 + (kk >> 5), x = kk & 31;
    const int qb = pass ? 63 - x : x;
    const int b = p >> 4, h = (p >> 2) & 3, m = (p >> 1) & 1, vh = p & 1;
    const size_t rb = (size_t)b * SEQ;
    BlockRef r;
    r.Q = PROJ + (rb + (size_t)qb * QB) * PIN + (h * 2 + m) * 128;
    r.K = PROJ + rb * PIN + 1024 + (h * 2 + m) * 128;
    r.V = PROJ + rb * PIN + 2048 + h * 256 + vh * 128;
    r.O = O16 + (rb + (size_t)qb * QB) * POUT + (p & 15) * 128;
    r.P0 = qb * QB;
    return r;
}
__device__ __forceinline__ void attn_phase(char* lds, const bf16* PROJ, bf16* O16, int G, int w) {
    constexpr int total = 1024;
    int L = w; if (L >= total) return;
    int pass = 0;
    BlockRef cur = make_ref(L, 0, PROJ, O16);
    Seam S;
    causal_prime(cur, lds, S);
    for (;;) {
        const bool more_pass = pass == 0, more_item = L + G < total, last = !more_pass && !more_item;
        int passn, Ln;
        if (more_pass) { passn = 1; Ln = L; } else { passn = 0; Ln = more_item ? L + G : L; }
        const BlockRef nxt = last ? cur : make_ref(Ln, passn, PROJ, O16);
        causal_block(cur, nxt, SEQ, lds, S);
        if (last) break;
        cur = nxt; pass = passn; L = Ln;
    }
}
}


namespace att2 {
using namespace att;
constexpr int QB2 = 128;
constexpr int PH = 128;
constexpr long HSTR = (long)SEQ * PH;
constexpr int L_V = 0, L_K = 4 * SHM_V, L_WSF = L_K + 2 * SHM_K, L_XM = L_WSF + 2048, L_XP = L_XM + 2048, L_XL = L_XP + 32768, L_END = L_XL + 1024;
#define KSWZ2(row, colB) ((row) * 256 + ((colB) ^ (((row) & 7) << 4)))
#define SBAR2() __builtin_amdgcn_sched_barrier(0)
struct BlockRef2 { const bf16* Q; const bf16* K; const bf16* V; bf16* O; int P0; };

__device__ __forceinline__ void block2(const BlockRef2& cur, char* lds, int wave) {
    const int lane = (int)__builtin_amdgcn_mbcnt_hi(~0u, __builtin_amdgcn_mbcnt_lo(~0u, 0u)), r32 = lane & 31, hi = lane >> 5, tid = wave * 64 + lane;
    const int rg = wave & 3, c = wave >> 2, pw = wave ^ 4;
    const int NT = (cur.P0 + QB2 - 1) / KVBLK + 1;
    const int qlo = cur.P0 + rg * QBLK, qm = qlo + r32 - 4 * hi;
    char* V_lds = lds + L_V; char* K_lds = lds + L_K;
    float* wsf = (float*)(lds + L_WSF) + wave * 64; float* li_l = wsf; float* al_l = wsf + 32;
    float* xm = (float*)(lds + L_XM);
    char* xp = lds + L_XP;
    float* xl = (float*)(lds + L_XL);
    const int sr = tid >> 4, sc = (tid & 15) * 8, vst0 = v_st(sr, sc), vst1 = v_st(32 + sr, sc), kws = KSWZ2(sr, sc * 2);
    const int vb0 = (int)(uintptr_t)V_lds + c * SHM_V + v_rd_base(lane);
    const bf16* Kh = cur.K; const bf16* Vh = cur.V;
    bf16x8 qr[8];
#pragma unroll
    for (int d0 = 0; d0 < 8; ++d0) qr[d0] = *reinterpret_cast<const bf16x8*>((const char*)(cur.Q + (size_t)(rg * QBLK) * PH) + (unsigned)(r32 * PH + hi * 8) * 2u + d0 * 32);
    bf16x8 sk0, sk1, sv00, sv01, sv10, sv11;
    unsigned voff = (unsigned)(sr * PH + sc) * 2u; asm volatile("" : "+v"(voff));
#define LD16(base_, byteoff_) (*reinterpret_cast<const bf16x8*>((const char*)(base_) + voff + (byteoff_)))
#define KLOAD(k0) do { const bf16* kb0_ = Kh + (size_t)(k0) * PH; const bf16* kb1_ = Kh + (size_t)((k0) + 32) * PH; sk0 = LD16(kb0_, 0); sk1 = LD16(kb1_, 0); } while (0)
#define VLOAD(k0) do { const bf16* vb0_ = Vh + (size_t)(k0) * PH; const bf16* vb1_ = Vh + (size_t)((k0) + 32) * PH; \
                       sv00 = LD16(vb0_, 0); sv01 = LD16(vb1_, 0); sv10 = LD16(vb0_ + HSTR, 0); sv11 = LD16(vb1_ + HSTR, 0); } while (0)
#define KWRITE(bf) do { *(bf16x8*)(K_lds + (bf) * SHM_K + kws) = sk0; *(bf16x8*)(K_lds + (bf) * SHM_K + kws + 32 * 256) = sk1; } while (0)
#define VWRITE(bf) do { *(bf16x8*)(V_lds + ((bf) * 2) * SHM_V + vst0) = sv00; *(bf16x8*)(V_lds + ((bf) * 2) * SHM_V + vst1) = sv01; \
                        *(bf16x8*)(V_lds + ((bf) * 2 + 1) * SHM_V + vst0) = sv10; *(bf16x8*)(V_lds + ((bf) * 2 + 1) * SHM_V + vst1) = sv11; } while (0)
    KLOAD(0); VLOAD(0); KWRITE(0); VWRITE(0);
    KLOAD(KVBLK); VLOAD(KVBLK); KWRITE(1); VWRITE(1);
    if (NT > 2) { KLOAD(2 * KVBLK); VLOAD(2 * KVBLK); }
    float m_reg = -1e30f, l_reg = 0.f; f32x16 o[4] = {};
    f32x16 pA, pB; float alA = 1.f, alB = 1.f; bf16x8 f0, f1;
    constexpr float C2 = 1.4426950408889634f * SCALE;
#define QKT2(P, KB) do { P = f32x16{}; const char* kq_ = K_lds + (KB) * SHM_K + c * (32 * 256); \
        _Pragma("unroll") for (int d0 = 0; d0 < 8; ++d0) { const bf16x8 b_ = *reinterpret_cast<const bf16x8*>(kq_ + KSWZ2(r32, (((d0) & 3) * 16 + hi * 8) * 2) + ((d0) >> 2) * 128); \
            P = __builtin_amdgcn_mfma_f32_32x32x16_bf16(b_, qr[d0], P, 0, 0, 0); } } while (0)
#define MASKMAX(P, t, par) do { const int kb_ = (t) * KVBLK + 32 * c; \
        if (kb_ + 31 > qlo) { const int dq_ = qm - kb_; const float NEG_ = -__builtin_inff(); \
            _Pragma("unroll") for (int r = 0; r < 16; ++r) { if (dq_ - ((r & 3) + 8 * (r >> 2)) < 0) P[r] = NEG_; } } \
        float pm_ = P[0]; _Pragma("unroll") for (int r = 1; r < 16; ++r) pm_ = fmaxf(pm_, P[r]); \
        { auto rr = __builtin_amdgcn_permlane32_swap(__float_as_uint(pm_), __float_as_uint(pm_), false, false); pm_ = fmaxf(__uint_as_float(rr[0]), __uint_as_float(rr[1])); } \
        pmx = pm_; if (hi == 0) xm[((par) * 8 + wave) * 32 + r32] = pm_; } while (0)
#define SOFTMAX(P, par, alX) do { const float pmax_ = fmaxf(pmx, xm[((par) * 8 + pw) * 32 + r32]); float mn_; \
        if (__builtin_expect(__all((pmax_ - m_reg) * SCALE <= THR), 1)) { mn_ = m_reg; alX = 1.f; } \
        else { mn_ = fmaxf(m_reg, pmax_); alX = __builtin_amdgcn_exp2f((m_reg - mn_) * C2); m_reg = mn_; } \
        const float mnL_ = -mn_ * C2; \
        _Pragma("unroll") for (int r = 0; r < 16; ++r) P[r] = __builtin_amdgcn_exp2f(fmaf(P[r], C2, mnL_)); } while (0)
#define PK4B(P, B_, OUT) do { unsigned a0 = cvtpk(P[B_+0], P[B_+1]), a1 = cvtpk(P[B_+2], P[B_+3]); unsigned b0 = cvtpk(P[B_+4], P[B_+5]), b1 = cvtpk(P[B_+6], P[B_+7]); \
        auto r0 = __builtin_amdgcn_permlane32_swap(a0, b0, false, false); auto r1 = __builtin_amdgcn_permlane32_swap(a1, b1, false, false); \
        u32x4 w = {r0[0], r1[0], r0[1], r1[1]}; OUT = *reinterpret_cast<bf16x8*>(&w); } while (0)
#define FINISH(P, alY, par) do { float ps_ = 0; _Pragma("unroll") for (int r = 0; r < 16; ++r) ps_ += P[r]; \
        { auto rr = __builtin_amdgcn_permlane32_swap(__float_as_uint(ps_), __float_as_uint(ps_), false, false); ps_ = __uint_as_float(rr[0]) + __uint_as_float(rr[1]); } \
        l_reg = l_reg * alY + ps_; PK4B(P, 0, f0); PK4B(P, 8, f1); \
        *(bf16x8*)(xp + (((par) * 8 + wave) * 2 + 0) * 1024 + lane * 16) = f0; *(bf16x8*)(xp + (((par) * 8 + wave) * 2 + 1) * 1024 + lane * 16) = f1; } while (0)
#define TRRD2(dst, off) asm volatile("ds_read_b64_tr_b16 %0, %1 offset:%2" : "=&v"(dst) : "v"(vb0), "i"(off) : "memory")
#define PV2_D0(VB, d0) do { s16x4 l0, l1, l2, l3, h0, h1, h2, h3; constexpr int b_ = (VB) * 2 * SHM_V + v_rd_off(d0, 0, 0); \
        TRRD2(l0, b_); TRRD2(h0, b_ + 2048); TRRD2(l1, b_ + 4096); TRRD2(h1, b_ + 6144); TRRD2(l2, b_ + 8192); TRRD2(h2, b_ + 10240); TRRD2(l3, b_ + 12288); TRRD2(h3, b_ + 14336); \
        asm volatile("s_waitcnt lgkmcnt(0)" ::: "memory"); SBAR2(); __builtin_amdgcn_s_setprio(1);  \
        o[d0] = __builtin_amdgcn_mfma_f32_32x32x16_bf16(pa0, (bf16x8){l0[0], l0[1], l0[2], l0[3], h0[0], h0[1], h0[2], h0[3]}, o[d0], 0, 0, 0);   \
        o[d0] = __builtin_amdgcn_mfma_f32_32x32x16_bf16(pa1, (bf16x8){l1[0], l1[1], l1[2], l1[3], h1[0], h1[1], h1[2], h1[3]}, o[d0], 0, 0, 0);   \
        o[d0] = __builtin_amdgcn_mfma_f32_32x32x16_bf16(pa2, (bf16x8){l2[0], l2[1], l2[2], l2[3], h2[0], h2[1], h2[2], h2[3]}, o[d0], 0, 0, 0);   \
        o[d0] = __builtin_amdgcn_mfma_f32_32x32x16_bf16(pa3, (bf16x8){l3[0], l3[1], l3[2], l3[3], h3[0], h3[1], h3[2], h3[3]}, o[d0], 0, 0, 0); __builtin_amdgcn_s_setprio(0); } while (0)
#define PVALL(VB, par) do { const bf16x8 g0_ = *(const bf16x8*)(xp + (((par) * 8 + pw) * 2 + 0) * 1024 + lane * 16), g1_ = *(const bf16x8*)(xp + (((par) * 8 + pw) * 2 + 1) * 1024 + lane * 16); \
        const bf16x8 pa0 = c ? g0_ : f0, pa1 = c ? g1_ : f1, pa2 = c ? f0 : g0_, pa3 = c ? f1 : g1_; \
        PV2_D0(VB, 0); PV2_D0(VB, 1); PV2_D0(VB, 2); PV2_D0(VB, 3); } while (0)
#define RESC2(a) do { if (__any((a) < 1.f)) { if (hi == 0) al_l[r32] = (a); asm volatile("s_waitcnt lgkmcnt(0)" ::: "memory");              \
                     for (int d_ = 0; d_ < 4; ++d_) for (int r = 0; r < 16; ++r) o[d_][r] *= al_l[crow(r, hi)]; } } while (0)
#define QKT2F(PX, KB, PY, alY, par) do { const char* kq_ = K_lds + (KB) * SHM_K + c * (32 * 256); bf16x8 kf_[8]; \
        _Pragma("unroll") for (int d0 = 0; d0 < 8; ++d0) kf_[d0] = *reinterpret_cast<const bf16x8*>(kq_ + KSWZ2(r32, (((d0) & 3) * 16 + hi * 8) * 2) + ((d0) >> 2) * 128); \
        PX = f32x16{}; float ps_ = 0.f; SBAR2(); __builtin_amdgcn_s_setprio(1); \
        PX = __builtin_amdgcn_mfma_f32_32x32x16_bf16(kf_[0], qr[0], PX, 0, 0, 0); SBAR2(); \
        _Pragma("unroll") for (int r = 0; r < 8; ++r) ps_ += PY[r]; SBAR2(); \
        PX = __builtin_amdgcn_mfma_f32_32x32x16_bf16(kf_[1], qr[1], PX, 0, 0, 0); SBAR2(); \
        _Pragma("unroll") for (int r = 8; r < 16; ++r) ps_ += PY[r]; \
        { auto rr = __builtin_amdgcn_permlane32_swap(__float_as_uint(ps_), __float_as_uint(ps_), false, false); ps_ = __uint_as_float(rr[0]) + __uint_as_float(rr[1]); } \
        l_reg = l_reg * alY + ps_; SBAR2(); \
        PX = __builtin_amdgcn_mfma_f32_32x32x16_bf16(kf_[2], qr[2], PX, 0, 0, 0); SBAR2(); \
        PK4B(PY, 0, f0); *(bf16x8*)(xp + (((par) * 8 + wave) * 2 + 0) * 1024 + lane * 16) = f0; SBAR2(); \
        PX = __builtin_amdgcn_mfma_f32_32x32x16_bf16(kf_[3], qr[3], PX, 0, 0, 0); SBAR2(); \
        PK4B(PY, 8, f1); *(bf16x8*)(xp + (((par) * 8 + wave) * 2 + 1) * 1024 + lane * 16) = f1; SBAR2(); \
        PX = __builtin_amdgcn_mfma_f32_32x32x16_bf16(kf_[4], qr[4], PX, 0, 0, 0); \
        PX = __builtin_amdgcn_mfma_f32_32x32x16_bf16(kf_[5], qr[5], PX, 0, 0, 0); \
        PX = __builtin_amdgcn_mfma_f32_32x32x16_bf16(kf_[6], qr[6], PX, 0, 0, 0); \
        PX = __builtin_amdgcn_mfma_f32_32x32x16_bf16(kf_[7], qr[7], PX, 0, 0, 0); __builtin_amdgcn_s_setprio(0); SBAR2(); } while (0)
#define SM_DECIDE(par, alX) do { const float pmax_ = fmaxf(pmx, xm[((par) * 8 + pw) * 32 + r32]); float mn_; \
        if (__builtin_expect(__all((pmax_ - m_reg) * SCALE <= THR), 1)) { mn_ = m_reg; alX = 1.f; } \
        else { mn_ = fmaxf(m_reg, pmax_); alX = __builtin_amdgcn_exp2f((m_reg - mn_) * C2); m_reg = mn_; } \
        mnL = -mn_ * C2; } while (0)
#define SM_EXP4(P, B_) do { _Pragma("unroll") for (int r = (B_); r < (B_) + 4; ++r) P[r] = __builtin_amdgcn_exp2f(fmaf(P[r], C2, mnL)); } while (0)
#define PVSM(VB, par, PX, parX, alX) do { const bf16x8 g0_ = *(const bf16x8*)(xp + (((par) * 8 + pw) * 2 + 0) * 1024 + lane * 16), g1_ = *(const bf16x8*)(xp + (((par) * 8 + pw) * 2 + 1) * 1024 + lane * 16); \
        SM_DECIDE(parX, alX); \
        const bf16x8 pa0 = c ? g0_ : f0, pa1 = c ? g1_ : f1, pa2 = c ? f0 : g0_, pa3 = c ? f1 : g1_; SBAR2(); \
        PV2_D0(VB, 0); SBAR2(); SM_EXP4(PX, 0); SBAR2(); PV2_D0(VB, 1); SBAR2(); SM_EXP4(PX, 4); SBAR2(); \
        PV2_D0(VB, 2); SBAR2(); SM_EXP4(PX, 8); SBAR2(); PV2_D0(VB, 3); SBAR2(); SM_EXP4(PX, 12); SBAR2(); } while (0)
    float pmx, mnL;
    __syncthreads();
    QKT2(pA, 0); MASKMAX(pA, 0, 0);
    __syncthreads();
    SOFTMAX(pA, 0, alA);
#define STEP2(PX, alX, PY, alY, t, KB, VB) do { \
        SBAR2(); QKT2F(PX, KB, PY, alY, VB); \
        MASKMAX(PX, t, KB); \
        __syncthreads(); \
        if ((t) + 1 < NT) { KWRITE(VB); if ((t) + 2 < NT) KLOAD(((t) + 2) * KVBLK); } \
        PVSM(VB, VB, PX, KB, alX); \
        __syncthreads(); \
        if ((t) + 1 < NT) { VWRITE(VB); if ((t) + 2 < NT) VLOAD(((t) + 2) * KVBLK); } \
        RESC2(alX); } while (0)
    for (int t = 1; t + 1 < NT; t += 2) {
        STEP2(pB, alB, pA, alA, t, 1, 0);
        STEP2(pA, alA, pB, alB, t + 1, 0, 1);
    }
    STEP2(pB, alB, pA, alA, NT - 1, 1, 0);
    FINISH(pB, alB, 1);
    if (hi == 0) xl[wave * 32 + r32] = l_reg;
    __syncthreads();
    PVALL(1, 1);
    l_reg += xl[pw * 32 + r32];
    if (hi == 0) li_l[r32] = l_reg; asm volatile("s_waitcnt lgkmcnt(0)" ::: "memory");
    float rli[16];
#pragma unroll
    for (int r = 0; r < 16; ++r) rli[r] = __builtin_amdgcn_rcpf(li_l[crow(r, hi)]);
    { char* stg = lds + (wave < 4 ? L_V + wave * 8192 : L_K + (wave - 4) * 8192);
      unsigned soff = (unsigned)(4 * hi * 256 + r32 * 2); asm volatile("" : "+v"(soff));
#pragma unroll
      for (int r = 0; r < 16; ++r) { const unsigned orow = (unsigned)((r & 3) + 8 * (r >> 2));
#pragma unroll
          for (int d0 = 0; d0 < 4; ++d0) *(bf16*)(stg + soff + orow * 256u + d0 * 64u) = __float2bfloat16(o[d0][r] * rli[r]); }
      asm volatile("s_waitcnt lgkmcnt(0)" ::: "memory");
      char* Ow = (char*)(cur.O + (size_t)(rg * QBLK) * POUT + c * 128);
      unsigned roff = (unsigned)((lane >> 4) * 256 + (lane & 15) * 16), goff = (unsigned)((lane >> 4) * (POUT * 2) + (lane & 15) * 16); asm volatile("" : "+v"(roff), "+v"(goff));
#pragma unroll
      for (int i = 0; i < 8; ++i) { const u32x4 v = *(const u32x4*)(stg + roff + i * 1024u); *(u32x4*)(Ow + goff + (unsigned)i * (4u * POUT * 2u)) = v; } }
    __syncthreads();
#undef LD16
#undef KLOAD
#undef VLOAD
#undef KWRITE
#undef VWRITE
#undef QKT2
#undef MASKMAX
#undef SOFTMAX
#undef PK4B
#undef FINISH
#undef TRRD2
#undef PV2_D0
#undef PVALL
#undef RESC2
#undef STEP2
#undef QKT2F
#undef SM_DECIDE
#undef SM_EXP4
#undef PVSM
}
__device__ __forceinline__ BlockRef2 make_ref2(int L, int pass, const bf16* PROJ, bf16* O16) {
    const int xcd = L & 7, kk = L >> 3, p = xcd * 2 + (kk & 1), x = kk >> 1;
    const int qb = pass ? 127 - x : x;
    const int b = p >> 3, h = (p >> 1) & 3, m = p & 1;
    const size_t rb = (size_t)b * SEQ;
    BlockRef2 r;
    const bf16* hb = PROJ + (size_t)b * 24 * HSTR;
    r.Q = hb + (size_t)(h * 2 + m) * HSTR + (size_t)qb * QB2 * PH;
    r.K = hb + (size_t)(8 + h * 2 + m) * HSTR;
    r.V = hb + (size_t)(16 + h * 2) * HSTR;
    r.O = O16 + (rb + (size_t)qb * QB2) * POUT + h * 512 + m * 256;
    r.P0 = qb * QB2;
    return r;
}
__device__ __forceinline__ void attn_phase2(char* lds, const bf16* PROJ, bf16* O16, int G, int w, int wave) {
    for (int L = w; L < 1024; L += G)
        for (int pass = 0; pass < 2; ++pass) { const BlockRef2 cur = make_ref2(L, pass, PROJ, O16); block2(cur, lds, wave); }
}
#undef KSWZ2
#undef SBAR2
}

constexpr size_t MiB = 1u << 20;
constexpr size_t WS_WIN = 1 * MiB;
constexpr size_t WS_WO = 17 * MiB;
constexpr size_t WS_WQX = 25 * MiB;
constexpr size_t WS_WKV = 33 * MiB;
constexpr size_t WS_WOX = 49 * MiB;
constexpr size_t WS_WGU = 57 * MiB;
constexpr size_t WS_WDN = 101 * MiB;
constexpr size_t WS_WPOOL = 123 * MiB;
constexpr size_t WS_MN = 124 * MiB;
constexpr size_t WS_KX = 126 * MiB;
constexpr size_t WS_VXT = 128 * MiB;
constexpr size_t WS_HN = 144 * MiB;
constexpr size_t WS_PROJ = 272 * MiB;
constexpr size_t WS_O16 = 528 * MiB;
constexpr size_t WS_POOLED = 656 * MiB;
constexpr size_t WS_CONCAT = 720 * MiB;
constexpr size_t WS_QX = 272 * MiB;
constexpr size_t WS_PSC = 400 * MiB;
constexpr size_t WS_OX = 528 * MiB;
constexpr size_t WS_HID = 272 * MiB;
constexpr size_t WS_XB = 848 * MiB;
constexpr size_t WS_WQK = 130 * MiB;
constexpr size_t WS_WINU = 138 * MiB;
constexpr size_t WS_KVP = 656 * MiB;
constexpr size_t WS_VWT = 976 * MiB;
constexpr size_t WS_END = 984 * MiB;

constexpr int LDS_BYTES = 147456;
constexpr int XL_OFF = 131072;
constexpr int NPHASE = 14;

typedef unsigned short bf16r;
typedef float f32x4 __attribute__((ext_vector_type(4)));
typedef unsigned v4u __attribute__((ext_vector_type(4)));
typedef unsigned v2u __attribute__((ext_vector_type(2)));
#define LAS __attribute__((address_space(3)))

__device__ __forceinline__ unsigned f2bf(float f) { unsigned u = __builtin_bit_cast(unsigned, f); return (u + 0x7fffu + ((u >> 16) & 1u)) >> 16; }
__device__ __forceinline__ unsigned pk2(float lo, float hi) { return f2bf(lo) | (f2bf(hi) << 16); }
__device__ __forceinline__ float bf2f(unsigned short b) { return __builtin_bit_cast(float, (unsigned)b << 16); }
__device__ __forceinline__ float wave_sum(float v) {
#pragma unroll
    for (int o = 1; o < 64; o <<= 1) v += __shfl_xor(v, o);
    return v;
}

__device__ __forceinline__ void transpose_item(const float* W, int N, bf16r* WT, int ldt, int k0, int n0, int drow0, LAS float* scr, int lane, const float* gn = nullptr) {
    const float gg = gn ? gn[n0 + (lane & 31)] : 1.f;
#pragma unroll 8
    for (int i = 0; i < 32; ++i) { const int kk = 2 * i + (lane >> 5); scr[kk * 33 + (lane & 31)] = W[(size_t)(k0 + kk) * N + n0 + (lane & 31)] * gg; }
    asm volatile("s_waitcnt lgkmcnt(0)" ::: "memory");
    const int c = lane & 7;
#pragma unroll
    for (int j = 0; j < 4; ++j) { const int n = (lane >> 3) + 8 * j; const LAS float* s = scr + (8 * c) * 33 + n;
        v4u o; o.x = pk2(s[0 * 33], s[1 * 33]); o.y = pk2(s[2 * 33], s[3 * 33]); o.z = pk2(s[4 * 33], s[5 * 33]); o.w = pk2(s[6 * 33], s[7 * 33]);
        *(v4u*)(WT + (size_t)(drow0 + n) * ldt + k0 + 8 * c) = o; }
    asm volatile("s_waitcnt lgkmcnt(0)" ::: "memory");
}
__device__ __forceinline__ void rms_row_bf16(const float* xrow, const float* g, bf16r* orow, int lane) {
    const f32x4* xr = (const f32x4*)xrow + lane; const f32x4* gr = (const f32x4*)g + lane;
    f32x4 v[8]; float s = 0.f;
#pragma unroll
    for (int j = 0; j < 8; ++j) { v[j] = xr[64 * j]; s += (v[j].x * v[j].x + v[j].y * v[j].y) + (v[j].z * v[j].z + v[j].w * v[j].w); }
    const float rstd = rsqrtf(wave_sum(s) * (1.f / DM) + EPS);
    v2u* o8 = (v2u*)orow + lane;
#pragma unroll
    for (int j = 0; j < 8; ++j) { const f32x4 gg = gr[64 * j]; v2u w; w.x = pk2(v[j].x * rstd * gg.x, v[j].y * rstd * gg.y); w.y = pk2(v[j].z * rstd * gg.z, v[j].w * rstd * gg.w); o8[64 * j] = w; }
}
__device__ __forceinline__ void rms_rowb_bf16(const bf16r* xrow, const float* g, bf16r* orow, int lane) {
    const v4u* xr = (const v4u*)xrow + lane; const f32x4* gr = (const f32x4*)g + 2 * lane;
    float v[4][8]; float s = 0.f;
#pragma unroll
    for (int j = 0; j < 4; ++j) { const v4u w = xr[64 * j];
#pragma unroll
        for (int e = 0; e < 4; ++e) { v[j][2 * e] = __builtin_bit_cast(float, w[e] << 16); v[j][2 * e + 1] = __builtin_bit_cast(float, w[e] & 0xffff0000u); }
#pragma unroll
        for (int e = 0; e < 8; ++e) s += v[j][e] * v[j][e]; }
    const float rstd = rsqrtf(wave_sum(s) * (1.f / DM) + EPS);
    v4u* o8 = (v4u*)orow + lane;
#pragma unroll
    for (int j = 0; j < 4; ++j) { const f32x4 g0 = gr[128 * j], g1 = gr[128 * j + 1]; v4u w;
        w.x = pk2(v[j][0] * rstd * g0.x, v[j][1] * rstd * g0.y); w.y = pk2(v[j][2] * rstd * g0.z, v[j][3] * rstd * g0.w);
        w.z = pk2(v[j][4] * rstd * g1.x, v[j][5] * rstd * g1.y); w.w = pk2(v[j][6] * rstd * g1.z, v[j][7] * rstd * g1.w); o8[64 * j] = w; }
}
__device__ __forceinline__ void rms_rowb_f32(const bf16r* xrow, const float* g, float* orow, int lane) {
    const v4u* xr = (const v4u*)xrow + lane; const f32x4* gr = (const f32x4*)g + 2 * lane;
    float v[4][8]; float s = 0.f;
#pragma unroll
    for (int j = 0; j < 4; ++j) { const v4u w = xr[64 * j];
#pragma unroll
        for (int e = 0; e < 4; ++e) { v[j][2 * e] = __builtin_bit_cast(float, w[e] << 16); v[j][2 * e + 1] = __builtin_bit_cast(float, w[e] & 0xffff0000u); }
#pragma unroll
        for (int e = 0; e < 8; ++e) s += v[j][e] * v[j][e]; }
    const float rstd = rsqrtf(wave_sum(s) * (1.f / DM) + EPS);
    f32x4* o4 = (f32x4*)orow + 2 * lane;
#pragma unroll
    for (int j = 0; j < 4; ++j) { const f32x4 g0 = gr[128 * j], g1 = gr[128 * j + 1];
        o4[128 * j] = (f32x4){v[j][0] * rstd * g0.x, v[j][1] * rstd * g0.y, v[j][2] * rstd * g0.z, v[j][3] * rstd * g0.w};
        o4[128 * j + 1] = (f32x4){v[j][4] * rstd * g1.x, v[j][5] * rstd * g1.y, v[j][6] * rstd * g1.z, v[j][7] * rstd * g1.w}; }
}
template <int R> __device__ __forceinline__ void rms_rows_f32_to_bf16(const float* __restrict__ X, const float* __restrict__ g, bf16r* __restrict__ O, int m0, int lane) {
    f32x4 v[R][8]; float ss[R];
#pragma unroll
    for (int r = 0; r < R; ++r) { const f32x4* xr = (const f32x4*)(X + (size_t)(m0 + r) * DM) + lane;
#pragma unroll
        for (int j = 0; j < 8; ++j) v[r][j] = xr[64 * j]; }
#pragma unroll
    for (int r = 0; r < R; ++r) { float s = 0.f;
#pragma unroll
        for (int j = 0; j < 8; ++j) s += (v[r][j].x * v[r][j].x + v[r][j].y * v[r][j].y) + (v[r][j].z * v[r][j].z + v[r][j].w * v[r][j].w);
        ss[r] = s; }
#pragma unroll
    for (int o = 1; o < 64; o <<= 1) {
#pragma unroll
        for (int r = 0; r < R; ++r) ss[r] += __shfl_xor(ss[r], o); }
    const f32x4* gr = (const f32x4*)g + lane;
#pragma unroll
    for (int j = 0; j < 8; ++j) { const f32x4 gg = gr[64 * j];
#pragma unroll
        for (int r = 0; r < R; ++r) { const float rstd = rsqrtf(ss[r] * (1.f / DM) + EPS); v2u w;
            w.x = pk2(v[r][j].x * rstd * gg.x, v[r][j].y * rstd * gg.y); w.y = pk2(v[r][j].z * rstd * gg.z, v[r][j].w * rstd * gg.w);
            ((v2u*)(O + (size_t)(m0 + r) * DM) + lane)[64 * j] = w; } }
}
template <int R, bool OUT_F32> __device__ __forceinline__ void rms_rows_bf16(const bf16r* __restrict__ X, const float* __restrict__ g, void* __restrict__ O, int m0, int lane) {
    v4u w[R][4]; float ss[R];
#pragma unroll
    for (int r = 0; r < R; ++r) { const v4u* xr = (const v4u*)(X + (size_t)(m0 + r) * DM) + lane;
#pragma unroll
        for (int j = 0; j < 4; ++j) w[r][j] = xr[64 * j]; }
#pragma unroll
    for (int r = 0; r < R; ++r) { float s = 0.f;
#pragma unroll
        for (int j = 0; j < 4; ++j)
#pragma unroll
            for (int e = 0; e < 4; ++e) { const float a = __builtin_bit_cast(float, w[r][j][e] << 16), b = __builtin_bit_cast(float, w[r][j][e] & 0xffff0000u); s += a * a + b * b; }
        ss[r] = s; }
#pragma unroll
    for (int o = 1; o < 64; o <<= 1) {
#pragma unroll
        for (int r = 0; r < R; ++r) ss[r] += __shfl_xor(ss[r], o); }
    const f32x4* gr = (const f32x4*)g + 2 * lane;
#pragma unroll
    for (int j = 0; j < 4; ++j) { const f32x4 g0 = gr[128 * j], g1 = gr[128 * j + 1];
#pragma unroll
        for (int r = 0; r < R; ++r) { const float rstd = rsqrtf(ss[r] * (1.f / DM) + EPS); float v[8];
#pragma unroll
            for (int e = 0; e < 4; ++e) { v[2 * e] = __builtin_bit_cast(float, w[r][j][e] << 16) * rstd; v[2 * e + 1] = __builtin_bit_cast(float, w[r][j][e] & 0xffff0000u) * rstd; }
            if constexpr (OUT_F32) { f32x4* o4 = (f32x4*)((float*)O + (size_t)(m0 + r) * DM) + 2 * lane;
                o4[128 * j] = (f32x4){v[0] * g0.x, v[1] * g0.y, v[2] * g0.z, v[3] * g0.w}; o4[128 * j + 1] = (f32x4){v[4] * g1.x, v[5] * g1.y, v[6] * g1.z, v[7] * g1.w}; }
            else { v4u q; q.x = pk2(v[0] * g0.x, v[1] * g0.y); q.y = pk2(v[2] * g0.z, v[3] * g0.w); q.z = pk2(v[4] * g1.x, v[5] * g1.y); q.w = pk2(v[6] * g1.z, v[7] * g1.w);
                ((v4u*)((bf16r*)O + (size_t)(m0 + r) * DM) + lane)[64 * j] = q; } } }
}
__device__ __forceinline__ void rms_row_f32_inplace(float* xrow, const float* g, int lane) {
    f32x4* xr = (f32x4*)xrow + lane; const f32x4* gr = (const f32x4*)g + lane;
    f32x4 v[8]; float s = 0.f;
#pragma unroll
    for (int j = 0; j < 8; ++j) { v[j] = xr[64 * j]; s += (v[j].x * v[j].x + v[j].y * v[j].y) + (v[j].z * v[j].z + v[j].w * v[j].w); }
    const float rstd = rsqrtf(wave_sum(s) * (1.f / DM) + EPS);
#pragma unroll
    for (int j = 0; j < 8; ++j) { const f32x4 gg = gr[64 * j]; xr[64 * j] = (f32x4){v[j].x * rstd * gg.x, v[j].y * rstd * gg.y, v[j].z * rstd * gg.z, v[j].w * rstd * gg.w}; }
}

struct Args { const float* in[22]; float* out; unsigned char* ws; int ph_lo, ph_hi; };
typedef const __attribute__((address_space(4))) unsigned long long* karg_t;
__device__ __forceinline__ unsigned long long ldarg(int i) { karg_t p = (karg_t)__builtin_amdgcn_kernarg_segment_ptr(); asm volatile("" : "+s"(p) :: "memory"); return p[i]; }
#define GASP __attribute__((address_space(1)))
#define AIN(i) ((const float*)(GASP const float*)ldarg(i))
#define AOUT() ((float*)(GASP float*)ldarg(22))
#define AWS() ((unsigned char*)(GASP unsigned char*)ldarg(23))
#define WSP(off) ((bf16r*)(AWS() + (off)))

__global__ void __launch_bounds__(512) fwd_kernel(Args a) {
    extern __shared__ __attribute__((aligned(16))) unsigned char lds[];
    LAS unsigned char* ldsl = (LAS unsigned char*)lds;
    const int wave = __builtin_amdgcn_readfirstlane((int)threadIdx.x >> 6);
#define lane ((int)__builtin_amdgcn_mbcnt_hi(~0u, __builtin_amdgcn_mbcnt_lo(~0u, 0u)))
#define tid (wave * 64 + lane)
    const int G = gridDim.x, bx = blockIdx.x;
    const int gw = bx * 8 + wave, NGW = G * 8;
    const int lo = a.ph_lo, hi = a.ph_hi; int nbar = 0;
#define IN(k) (lo <= (k) && (k) < hi)
#define CBAR() do { asm volatile("s_waitcnt vmcnt(0)" ::: "memory"); ++nbar; __syncthreads(); \
            if (tid == 0) { unsigned* ctr = (unsigned*)AWS(); \
                __builtin_amdgcn_fence(__ATOMIC_RELEASE, "agent"); asm volatile("s_waitcnt vmcnt(0)" ::: "memory"); \
                __hip_atomic_fetch_add(ctr, 1u, __ATOMIC_RELAXED, __HIP_MEMORY_SCOPE_AGENT); \
                const unsigned target = (unsigned)nbar * (unsigned)G; \
                while (__hip_atomic_load(ctr, __ATOMIC_RELAXED, __HIP_MEMORY_SCOPE_AGENT) < target) __builtin_amdgcn_s_sleep(2); \
                __builtin_amdgcn_fence(__ATOMIC_ACQUIRE, "agent"); asm volatile("s_waitcnt vmcnt(0)" ::: "memory"); } \
            __syncthreads(); } while (0)
#define SEAM(k) do { if (IN(k) && IN((k) + 1)) { if ((k) == 0) { asm volatile("s_waitcnt vmcnt(0)" ::: "memory"); cg::this_grid().sync(); } else { CBAR(); } } } while (0)

    if (lo == 0 && hi > 1 && bx == 0 && tid == 0) __hip_atomic_store((unsigned*)AWS(), 0u, __ATOMIC_RELAXED, __HIP_MEMORY_SCOPE_AGENT);
    if (IN(0)) {
        unsigned char* const ws_ = AWS(); bf16r* const WIN = (bf16r*)(ws_ + WS_WIN); bf16r* const WO = (bf16r*)(ws_ + WS_WO); bf16r* const WQX = (bf16r*)(ws_ + WS_WQX); bf16r* const WKV = (bf16r*)(ws_ + WS_WKV); bf16r* const WOX = (bf16r*)(ws_ + WS_WOX); bf16r* const WGU = (bf16r*)(ws_ + WS_WGU); bf16r* const WDN = (bf16r*)(ws_ + WS_WDN); bf16r* const WPOOL = (bf16r*)(ws_ + WS_WPOOL); bf16r* const MN = (bf16r*)(ws_ + WS_MN); bf16r* const HN = (bf16r*)(ws_ + WS_HN);

        LAS float* scr = (LAS float*)(ldsl + wave * 16384);
        constexpr int I_IN = 32 * 128, I_SQ = 32 * 64, I_KV = 32 * 128, I_G = 32 * 176, I_DN = 88 * 64, I_P = 4 * 4 * 8;
        constexpr int NITEMS = I_IN + 3 * I_SQ + I_KV + 2 * I_G + I_DN + I_P;
        for (int it = gw; it < NITEMS; it += NGW) {
            int r = it;
            if (r < I_IN) { const int kb = r / 128, nb = r % 128; if (nb < 96) transpose_item(AIN(3), DIN, WIN, DM, 64 * kb, 32 * nb, 32 * nb, scr, lane); continue; } r -= I_IN;
            if (r < I_SQ) { const int kb = r / 64, nb = r % 64; transpose_item(AIN(11), DM, WO, DM, 64 * kb, 32 * nb, 32 * nb, scr, lane); continue; } r -= I_SQ;
            if (r < I_SQ) { continue; } r -= I_SQ;
            if (r < I_KV) { const int kb = r / 128, nb = r % 128; transpose_item(AIN(15), 2 * DM, WKV, DM, 64 * kb, 32 * nb, 32 * nb, scr, lane); continue; } r -= I_KV;
            if (r < I_SQ) { const int kb = r / 64, nb = r % 64; transpose_item(AIN(16), DM, WOX, DM, 64 * kb, 32 * nb, 32 * nb, scr, lane); continue; } r -= I_SQ;
            if (r < I_G) { const int kb = r / 176, nb = r % 176, n0 = 32 * nb; transpose_item(AIN(18), DFF, WGU, DM, 64 * kb, n0, 256 * (n0 >> 7) + (n0 & 127), scr, lane); continue; } r -= I_G;
            if (r < I_G) { const int kb = r / 176, nb = r % 176, n0 = 32 * nb; transpose_item(AIN(19), DFF, WGU, DM, 64 * kb, n0, 256 * (n0 >> 7) + 128 + (n0 & 127), scr, lane); continue; } r -= I_G;
            if (r < I_DN) { const int kb = r / 64, nb = r % 64; transpose_item(AIN(20), DM, WDN, DFF, 64 * kb, 32 * nb, 32 * nb, scr, lane); continue; } r -= I_DN;
            { const int gidx = r / 32, q = r % 32, kb = q / 8, nb = q % 8; transpose_item(AIN(9) + (size_t)gidx * 65536, 256, WPOOL + (size_t)gidx * 65536, 256, 64 * kb, 32 * nb, 32 * nb, scr, lane, AIN(10) + gidx * 256); }
        }
        { const float* win = AIN(3); bf16r* winu = (bf16r*)(ws_ + WS_WINU);
          for (int i = bx * 512 + tid; i < DM * 1024 / 8; i += G * 512) { const int k = i >> 7, j8 = (i & 127) * 8; const f32x4* sp = (const f32x4*)(win + (size_t)k * DIN + 3072 + j8);
              const f32x4 a0 = sp[0], a1 = sp[1]; v4u w; w.x = pk2(a0.x, a0.y); w.y = pk2(a0.z, a0.w); w.z = pk2(a1.x, a1.y); w.w = pk2(a1.z, a1.w); *(v4u*)(winu + (size_t)k * 1024 + j8) = w; } }
        { const f32x4* src = (const f32x4*)AIN(14); v4u* dst = (v4u*)WQX;
          for (int i = bx * 512 + tid; i < DM * DM / 8; i += G * 512) { const f32x4 a0 = src[2 * i], a1 = src[2 * i + 1]; v4u w; w.x = pk2(a0.x, a0.y); w.y = pk2(a0.z, a0.w); w.z = pk2(a1.x, a1.y); w.w = pk2(a1.z, a1.w); dst[i] = w; } }
        { const float* xin = AIN(0); const float* gin = AIN(2); for (int m = gw * 4; m < M; m += NGW * 4) rms_rows_f32_to_bf16<4>(xin, gin, HN, m, lane); }
        for (int m = gw; m < BATCH * MEM; m += NGW) rms_row_bf16(AIN(1) + (size_t)m * DM, AIN(13), MN + (size_t)m * DM, lane);
        __syncthreads();
    }
    SEAM(0);
    if (IN(1)) {
        unsigned char* const ws_ = AWS(); bf16r* const HN = (bf16r*)(ws_ + WS_HN); bf16r* const WIN = (bf16r*)(ws_ + WS_WIN); bf16r* const PROJ = (bf16r*)(ws_ + WS_PROJ);

        {
            pg8::Gemm gf{(bf16r*)(ws_ + WS_WPOOL), (bf16r*)(ws_ + WS_WINU), 256, 1024, 256, 1, 65536, 0, 256, 0}; pg8::BatchOrder Sf; Sf.init(256, DM, 4, G, bx);
            pg8::EpiBf16 Ef{WIN + (size_t)3072 * DM, DM, 1, (long)256 * DM, 0, nullptr, 0};
            pg8::gemm_phase<pg8::EpiBf16, pg8::BatchOrder, true>(ldsl, ldsl + XL_OFF, gf, Sf, Ef);
            CBAR();
        }
        pg8::Gemm g{HN, WIN, DM, DM, DM, 1, 0, 0, 0, 0}; pg8::StaticOrder S; S.init(M, DIN, G, bx);
        pg8::EpiProj E{PROJ, PROJ + (size_t)192 * 1024 * 1024 / 2};
        pg8::gemm_phase<pg8::EpiProj, pg8::StaticOrder, true>(ldsl, ldsl + XL_OFF, g, S, E);
    }
    SEAM(1);
    if (IN(1) && IN(2)) { for (int ps_ = 0; ps_ < PROBE_SEAMS; ++ps_) CBAR(); }
    if (IN(2)) {
        unsigned char* const ws_ = AWS(); bf16r* const PROJ = (bf16r*)(ws_ + WS_PROJ); bf16r* const POOLED = (bf16r*)(ws_ + WS_POOLED); bf16r* const O16 = (bf16r*)(ws_ + WS_O16);

        {
            constexpr int RUN = 32;
            const int ntask = (M / RUN) * 128;
            for (int task = bx * 512 + tid; task < ntask; task += G * 512) {
                const int c8 = task & 127, token0 = (task >> 7) * RUN, t0 = token0 & (SEQ - 1);
                const int wl = 2 << (c8 >> 5);
                const bf16r* up = PROJ + (size_t)192 * 1024 * 1024 / 2 + (size_t)token0 * 1024 + c8 * 8;
                bf16r* op = (bf16r*)(ws_ + WS_CONCAT) + (size_t)token0 * DM + 1024 + c8 * 8;
                float sacc[8];
#pragma unroll
                for (int e = 0; e < 8; ++e) sacc[e] = 0.f;
                for (int j = 1; j < wl; ++j) if (t0 - j >= 0) { const v4u w = *(const v4u*)(up - (size_t)j * 1024);
#pragma unroll
                    for (int e = 0; e < 4; ++e) { sacc[2 * e] += __builtin_bit_cast(float, w[e] << 16); sacc[2 * e + 1] += __builtin_bit_cast(float, w[e] & 0xffff0000u); } }
#pragma unroll 4
                for (int i = 0; i < RUN; ++i) {
                    const v4u w = *(const v4u*)(up + (size_t)i * 1024);
                    const int t = t0 + i; const bool full = (t + 1 >= wl);
                    const v4u wo = *(const v4u*)(up + (size_t)(full ? i - (wl - 1) : i) * 1024);
                    float u0[8];
#pragma unroll
                    for (int e = 0; e < 4; ++e) { u0[2 * e] = __builtin_bit_cast(float, w[e] << 16); u0[2 * e + 1] = __builtin_bit_cast(float, w[e] & 0xffff0000u); }
#pragma unroll
                    for (int e = 0; e < 8; ++e) sacc[e] += u0[e];
                    const float ic = 1.0f / (float)(full ? wl : t + 1);
                    v4u o;
#pragma unroll
                    for (int e = 0; e < 4; ++e) o[e] = pk2(sacc[2 * e] * ic - u0[2 * e], sacc[2 * e + 1] * ic - u0[2 * e + 1]);
                    *(v4u*)(op + (size_t)i * DM) = o;
                    if (full) {
#pragma unroll
                        for (int e = 0; e < 4; ++e) { sacc[2 * e] -= __builtin_bit_cast(float, wo[e] << 16); sacc[2 * e + 1] -= __builtin_bit_cast(float, wo[e] & 0xffff0000u); } }
                }
            }
        }
        __syncthreads();
        att2::attn_phase2((char*)lds, (const att::bf16*)PROJ, (att::bf16*)O16, G, bx, wave);
        __syncthreads();
    }
    SEAM(2);
    if (IN(3)) {
        unsigned char* const ws_ = AWS(); bf16r* const O16 = (bf16r*)(ws_ + WS_O16); bf16r* const CONCAT = (bf16r*)(ws_ + WS_CONCAT); bf16r* const POOLED = (bf16r*)(ws_ + WS_POOLED); bf16r* const WPOOL = (bf16r*)(ws_ + WS_WPOOL); bf16r* const MN = (bf16r*)(ws_ + WS_MN); bf16r* const WKV = (bf16r*)(ws_ + WS_WKV); bf16r* const KX = (bf16r*)(ws_ + WS_KX); bf16r* const VXT = (bf16r*)(ws_ + WS_VXT);

        {
            const float* lq1 = AIN(4); const float* lk1 = AIN(5); const float* lq2 = AIN(6); const float* lk2 = AIN(7); const float* subln = AIN(8);
            const float s1 = wave_sum(lq1[lane] * lk1[lane] + lq1[lane + 64] * lk1[lane + 64]);
            const float s2 = wave_sum(lq2[lane] * lk2[lane] + lq2[lane + 64] * lk2[lane + 64]);
            const float lam = __expf(s1) - __expf(s2) + LAM_INIT;
            const f32x4 sg = *((const f32x4*)subln + lane);
            for (int m = gw; m < M; m += NGW) {
                const bf16r* orow = O16 + (size_t)m * 2048; bf16r* crow_ = CONCAT + (size_t)m * 2048;
#pragma unroll
                for (int h = 0; h < 4; ++h) {
                    const v2u w1 = *(const v2u*)(orow + h * 512 + 4 * lane), w2 = *(const v2u*)(orow + h * 512 + 256 + 4 * lane);
                    float d[4];
                    d[0] = __builtin_bit_cast(float, w1.x << 16) - lam * __builtin_bit_cast(float, w2.x << 16);
                    d[1] = __builtin_bit_cast(float, w1.x & 0xffff0000u) - lam * __builtin_bit_cast(float, w2.x & 0xffff0000u);
                    d[2] = __builtin_bit_cast(float, w1.y << 16) - lam * __builtin_bit_cast(float, w2.y << 16);
                    d[3] = __builtin_bit_cast(float, w1.y & 0xffff0000u) - lam * __builtin_bit_cast(float, w2.y & 0xffff0000u);
                    const float ss = wave_sum((d[0] * d[0] + d[1] * d[1]) + (d[2] * d[2] + d[3] * d[3]));
                    const float rstd = rsqrtf(ss * (1.f / 256.f) + EPS) * (1.0f - LAM_INIT);
                    v2u o; o.x = pk2(d[0] * rstd * sg.x, d[1] * rstd * sg.y); o.y = pk2(d[2] * rstd * sg.z, d[3] * rstd * sg.w);
                    *(v2u*)(crow_ + h * 256 + 4 * lane) = o;
                }
            }
        }
        __syncthreads();
        {
            pg8::Gemm g{MN, WKV, DM, DM, 256, 1, 256, 0, 256, 0}; pg8::BatchOrder S; S.init(BATCH * MEM, 2 * DM, 8, G, bx);
            pg8::EpiStoreF32 E{(float*)(ws_ + WS_KVP), 2 * DM, (long)BATCH * MEM * 2 * DM};
            pg8::gemm_phase<pg8::EpiStoreF32, pg8::BatchOrder, true>(ldsl, ldsl + XL_OFF, g, S, E);
        }
    }
    SEAM(3);
    if (IN(4)) {
        unsigned char* const ws_ = AWS(); bf16r* const CONCAT = (bf16r*)(ws_ + WS_CONCAT); bf16r* const WO = (bf16r*)(ws_ + WS_WO); float* const xres = AOUT();

        { const f32x4* kp = (const f32x4*)(ws_ + WS_KVP); v2u* kv = (v2u*)(ws_ + WS_KX); constexpr int NQ = BATCH * MEM * 2 * DM / 4;
          for (int i = bx * 512 + tid; i < NQ; i += G * 512) { f32x4 acc4 = kp[i];
#pragma unroll
              for (int z = 1; z < 8; ++z) acc4 += kp[i + z * NQ];
              v2u w; w.x = pk2(acc4.x, acc4.y); w.y = pk2(acc4.z, acc4.w); kv[i] = w; } }
        pg8::Gemm g{CONCAT, WO, DM, DM, DM, 1, 0, 0, 0, 0}; pg8::StaticOrder S; S.init(M, DM, G, bx);
        pg8::EpiResX<false, true> E{AIN(0), ws_ + WS_XB, DM};
        pg8::gemm_phase<pg8::EpiResX<false, true>, pg8::StaticOrder, true>(ldsl, ldsl + XL_OFF, g, S, E);
    }
    SEAM(4);
    if (IN(5)) {
        unsigned char* const ws_ = AWS(); bf16r* const HN = (bf16r*)(ws_ + WS_HN); float* const xres = AOUT();
 { const float* gin = AIN(12); for (int m = gw * 4; m < M; m += NGW * 4) rms_rows_bf16<4, false>((const bf16r*)(ws_ + WS_XB), gin, HN, m, lane); }
        bf16r* const KV = (bf16r*)(ws_ + WS_KX); bf16r* const WQN = (bf16r*)(ws_ + WS_WQX); bf16r* const WOXt = (bf16r*)(ws_ + WS_WOX);
        __syncthreads();
        {   pg8::Gemm g{KV, WQN, 2 * DM, DM, 512, 4, (long)MEM * 2 * DM, 512, 0, 512}; pg8::BatchOrder S; S.init(MEM, DM, 8, G, bx);
            pg8::EpiBf16 E{(bf16r*)(ws_ + WS_WQK), DM, 4, (long)1024 * DM, (long)MEM * DM, nullptr, 0};
            pg8::gemm_phase<pg8::EpiBf16, pg8::BatchOrder, true>(ldsl, ldsl + XL_OFF, g, S, E); }
        {   pg8::Gemm g{WOXt, KV + 2048, DM, 2 * DM, 512, 4, 0, 512, (long)MEM * 2 * DM, 512}; pg8::BatchOrder S; S.init(DM, MEM, 8, G, G - 1 - bx);
            pg8::EpiBf16 E{(bf16r*)(ws_ + WS_VWT), 1024, 4, (long)DM * 1024, MEM, nullptr, 0};
            pg8::gemm_phase<pg8::EpiBf16, pg8::BatchOrder, true>(ldsl, ldsl + XL_OFF, g, S, E); }
    }
    SEAM(5);
    if (IN(6)) {
        unsigned char* const ws_ = AWS(); bf16r* const HN = (bf16r*)(ws_ + WS_HN); bf16r* const PSC = (bf16r*)(ws_ + WS_PSC);
        pg8::Gemm g{HN, (bf16r*)(ws_ + WS_WQK), DM, DM, DM, 1, 0, 0, (long)1024 * DM, 0}; pg8::StaticOrderZ S; S.init(M, 1024, G, bx); S.zdiv = SEQ / 256;
        pg8::EpiSoftmax E{PSC, 0, 0.044194173824159216f * 1.4426950408889634f, 1024};
        pg8::gemm_phase<pg8::EpiSoftmax, pg8::StaticOrderZ, true>(ldsl, ldsl + XL_OFF, g, S, E);
    }
    SEAM(6);
    if (IN(9)) {
        unsigned char* const ws_ = AWS(); bf16r* const PSC = (bf16r*)(ws_ + WS_PSC);
        pg8::Gemm g{PSC, (bf16r*)(ws_ + WS_VWT), 1024, 1024, 1024, 1, 0, 0, (long)DM * 1024, 0}; pg8::StaticOrderZ S; S.init(M, DM, G, bx); S.zdiv = SEQ / 256;
        pg8::EpiResX<true, true> E{ws_ + WS_XB, ws_ + WS_XB, DM};
        pg8::gemm_phase<pg8::EpiResX<true, true>, pg8::StaticOrderZ, true>(ldsl, ldsl + XL_OFF, g, S, E);
    }
    SEAM(9);
    if (IN(10)) {
        unsigned char* const ws_ = AWS(); bf16r* const HN = (bf16r*)(ws_ + WS_HN); float* const xres = AOUT();
 { const float* gin = AIN(17); for (int m = gw * 4; m < M; m += NGW * 4) rms_rows_bf16<4, false>((const bf16r*)(ws_ + WS_XB), gin, HN, m, lane); } }
    SEAM(10);
    if (IN(11)) {
        unsigned char* const ws_ = AWS(); bf16r* const HN = (bf16r*)(ws_ + WS_HN); bf16r* const WGU = (bf16r*)(ws_ + WS_WGU); bf16r* const HID = (bf16r*)(ws_ + WS_HID);

        pg8::Gemm g{HN, WGU, DM, DM, DM, 1, 0, 0, 0, 0}; pg8::StaticOrder S; S.init(M, 2 * DFF, G, bx);
        pg8::EpiSwiGLU E{HID, DFF};
        pg8::gemm_phase<pg8::EpiSwiGLU, pg8::StaticOrder, true>(ldsl, ldsl + XL_OFF, g, S, E);
    }
    SEAM(11);
    if (IN(12)) {
        unsigned char* const ws_ = AWS(); bf16r* const HID = (bf16r*)(ws_ + WS_HID); bf16r* const WDN = (bf16r*)(ws_ + WS_WDN); float* const xres = AOUT();

        pg8::Gemm g{HID, WDN, DFF, DFF, DFF, 1, 0, 0, 0, 0}; pg8::StaticOrder S; S.init(M, DM, G, bx);
        pg8::EpiResX<true, true> E{ws_ + WS_XB, ws_ + WS_XB, DM};
        pg8::gemm_phase<pg8::EpiResX<true, true>, pg8::StaticOrder, true>(ldsl, ldsl + XL_OFF, g, S, E);
    }
    SEAM(12);
    if (IN(13)) {
        unsigned char* const ws_ = AWS(); float* const xres = AOUT();
 { const float* gin = AIN(21); for (int m = gw * 4; m < M; m += NGW * 4) rms_rows_bf16<4, true>((const bf16r*)(ws_ + WS_XB), gin, xres, m, lane); } }
#undef IN
#undef SEAM
#undef lane
#undef tid
}

extern "C" void kernel_launch(void* const* d_in, const int* in_sizes, int n_in, void* d_out, int out_size, void* d_ws, size_t ws_size, hipStream_t stream) {
    static int grid = 0;
    if (grid == 0) {
        if (n_in != 22 || in_sizes[0] != M * DM || out_size != M * DM || ws_size < WS_END) {
            fprintf(stderr, "kernel_launch: unexpected shapes n_in %d in0 %d out %d ws %zu (need %zu)\n", n_in, n_in > 0 ? in_sizes[0] : -1, out_size, ws_size, (size_t)WS_END); grid = -1; return; }
        int dev = 0, cus = 0, per_cu = 0;
        (void)hipGetDevice(&dev); (void)hipDeviceGetAttribute(&cus, hipDeviceAttributeMultiprocessorCount, dev);
        if (hipFuncSetAttribute((const void*)fwd_kernel, hipFuncAttributeMaxDynamicSharedMemorySize, LDS_BYTES) != hipSuccess) { fprintf(stderr, "kernel_launch: hipFuncSetAttribute failed\n"); grid = -1; return; }
        if (hipOccupancyMaxActiveBlocksPerMultiprocessor(&per_cu, (const void*)fwd_kernel, 512, LDS_BYTES) != hipSuccess || per_cu < 1) { fprintf(stderr, "kernel_launch: occupancy query gave %d\n", per_cu); per_cu = 1; }
        (void)hipGetLastError();
        if (cus <= 0) cus = 256;
        grid = cus * per_cu;
        if (grid > 256) grid = 256;
    }
    if (grid < 0) return;
    Args a{};
    for (int i = 0; i < 22; ++i) a.in[i] = (const float*)d_in[i];
    a.out = (float*)d_out; a.ws = (unsigned char*)d_ws;
#if MK_PER_PHASE
    for (int p = 0; p < NPHASE; ++p) { a.ph_lo = p; a.ph_hi = p + 1; hipLaunchKernelGGL(fwd_kernel, dim3(grid), dim3(512), LDS_BYTES, stream, a); }
#else
    const int cuts[4] = {0, PROBE_DUP >= 0 ? PROBE_DUP + 1 : NPHASE, PROBE_DUP >= 0 ? PROBE_DUP + 1 : NPHASE, NPHASE};
    for (int li = 0; li < (PROBE_DUP >= 0 ? 3 : 1); ++li) {
        a.ph_lo = cuts[li]; a.ph_hi = cuts[li + 1];
        if (PROBE_DUP >= 0 && li == 1) { a.ph_lo = PROBE_DUP; a.ph_hi = PROBE_DUP + 1; }
        if (!(a.ph_lo == 0 && a.ph_hi > 1)) (void)hipMemsetAsync(d_ws, 0, 256, stream);
        void* args[] = {&a};
        hipError_t e = hipLaunchCooperativeKernel((const void*)fwd_kernel, dim3(grid), dim3(512), args, LDS_BYTES, stream);
        if (e != hipSuccess) fprintf(stderr, "cooperative launch failed: %s (grid %d)\n", hipGetErrorString(e), grid);
    }
#endif
}
```

```cpp
#include <hip/hip_runtime.h>
#include <hip/hip_bf16.h>
#include <hip/hip_cooperative_groups.h>
#include <cstdio>
#include <cstdint>
namespace cg = cooperative_groups;

#ifndef PROBE_DUP
#define PROBE_DUP -1
#endif
#ifndef PROBE_SEAMS
#define PROBE_SEAMS 0
#endif
#ifndef MK_PER_PHASE
#define MK_PER_PHASE 0
#endif

constexpr int BATCH = 2, SEQ = 16384, DM = 2048, MEM = 256, DIN = 4096, DFF = 5632;
constexpr int M = BATCH * SEQ;
constexpr float EPS = 1e-6f;
constexpr float LAM_INIT = 0.2f;

namespace pg8 {
#define PG8_LAS __attribute__((address_space(3)))
typedef unsigned short bf16_t;
typedef short bf16x8 __attribute__((ext_vector_type(8)));
typedef float f32x4 __attribute__((ext_vector_type(4)));
typedef unsigned u32x4 __attribute__((ext_vector_type(4)));
constexpr int BM = 256, BK = 64, HALF = 128, HTB = HALF * BK * 2, STAGE_BYTES = 8 * HTB, NXCD = 8, WGM = 8;

__host__ __device__ __forceinline__ int lds_byte(int r, int c) { const int st = (r >> 4) * 2 + (c >> 5), rr = r & 15, cc = c & 31, ob = rr * 64 + cc * 2; return st * 1024 + (ob ^ (((ob >> 9) & 1) << 5)); }
__host__ __device__ __forceinline__ void stage_rc(int b, int& R, int& C) { const int st = b / 1024, sb = b % 1024, swz = sb ^ (((sb >> 9) & 1) << 5); R = (st >> 1) * 16 + swz / 64; C = (st & 1) * 32 + (swz % 64) / 2; }
__host__ __device__ __forceinline__ int perm32(int rho) { const int n = rho >> 4, i = rho & 15; return 8 * (i >> 2) + 4 * n + (i & 3); }

struct Unit { int pm, pn, z; };
struct Gemm { const bf16_t* A; const bf16_t* Bt; int lda, ldb, K, ZH; long sAb, sAh, sBb, sBh; };

struct StaticOrder {
    int nM, nN, nwg, G, c;
    __device__ void init(int Mr, int N, int G_, int c_) { nM = Mr / BM; nN = N / BM; nwg = nM * nN; G = G_; c = c_; }
    __device__ bool next(int i, Unit& u) const {
        const long L = (long)i * G + c; if (L >= nwg) return false;
        int wgid = (int)L; { const int q = nwg / NXCD, r = nwg % NXCD, xcd = wgid % NXCD, off = wgid / NXCD; wgid = (xcd < r ? xcd * (q + 1) : r * (q + 1) + (xcd - r) * q) + off; }
        const int nig = WGM * nN, gid = wgid / nig, fm = gid * WGM, gsz = (nM - fm) < WGM ? (nM - fm) : WGM;
        u.pm = fm + ((wgid % nig) % gsz); u.pn = (wgid % nig) / gsz; u.z = 0; return true;
    }
};
struct StaticOrderZ : StaticOrder {
    int zdiv;
    __device__ bool next(int i, Unit& u) const { if (!StaticOrder::next(i, u)) return false; u.z = u.pm / zdiv; return true; }
};
struct BatchOrder {
    int nM, nN, nwg, G, c;
    __device__ void init(int Mr, int N, int Z, int G_, int c_) { nM = Mr / BM; nN = N / BM; nwg = nM * nN * Z; G = G_; c = c_; }
    __device__ bool next(int i, Unit& u) const {
        const long L = (long)i * G + c; if (L >= nwg) return false;
        int l = (int)L; u.pn = l % nN; l /= nN; u.pm = l % nM; u.z = l / nM; return true;
    }
};

__device__ __forceinline__ unsigned cvt_pk_bf16(float lo, float hi) { unsigned r; asm volatile("v_cvt_pk_bf16_f32 %0, %1, %2" : "=v"(r) : "v"(lo), "v"(hi)); return r; }

typedef f32x4 Acc[2][2][4][2];

struct EpiBf16 {
    static constexpr bool PERM = true;
    bf16_t* O; int ldc, ZH; long sOb, sOh; const float* cscale; int nsc;
    __device__ __forceinline__ void operator()(Acc& acc, const Unit& u, int wr, int wc, int fr, int fq, PG8_LAS unsigned char*) const {
        const int row0 = u.pm * BM + wr * 64 + fr, col0 = u.pn * BM + wc * 32 + 8 * fq;
        bf16_t* base = O + (size_t)(u.z / ZH) * sOb + (size_t)(u.z % ZH) * sOh;
        f32x4 sv[2][2];
#pragma unroll
        for (int bj = 0; bj < 2; ++bj)
#pragma unroll
            for (int n = 0; n < 2; ++n) sv[bj][n] = cscale ? *(const f32x4*)(cscale + (size_t)u.z * nsc + col0 + bj * HALF + 4 * n) : (f32x4){1.f, 1.f, 1.f, 1.f};
#pragma unroll
        for (int ai = 0; ai < 2; ++ai)
#pragma unroll
            for (int m = 0; m < 4; ++m) { bf16_t* rowp = base + (size_t)(row0 + ai * HALF + m * 16) * ldc + col0;
#pragma unroll
                for (int bj = 0; bj < 2; ++bj) { f32x4 v0 = acc[ai][bj][m][0] * sv[bj][0], v1 = acc[ai][bj][m][1] * sv[bj][1];
                    u32x4 w; w.x = cvt_pk_bf16(v0[0], v0[1]); w.y = cvt_pk_bf16(v0[2], v0[3]); w.z = cvt_pk_bf16(v1[0], v1[1]); w.w = cvt_pk_bf16(v1[2], v1[3]);
                    *(u32x4*)(rowp + bj * HALF) = w; } }
    }
};
template <bool BASE_BF16, bool OUT_BF16> struct EpiResX {
    static constexpr bool PERM = true;
    const void* base; void* out; int ldc; float* ssp;
    __device__ __forceinline__ void operator()(Acc& acc, const Unit& u, int wr, int wc, int fr, int fq, PG8_LAS unsigned char*) const {
        const int col0 = u.pn * BM + wc * 32 + 8 * fq;
#pragma unroll
        for (int ai = 0; ai < 2; ++ai)
#pragma unroll
            for (int m = 0; m < 4; ++m) { const int r = ai * HALF + wr * 64 + m * 16 + fr; const size_t off = (size_t)(u.pm * BM + r) * ldc + col0;
                float q_ = 0.f;
                f32x4 bs[2][2];
#pragma unroll
                for (int bj = 0; bj < 2; ++bj) {
                    if constexpr (BASE_BF16) { const u32x4 w = *(const u32x4*)((const bf16_t*)base + off + bj * HALF);
                        bs[bj][0] = (f32x4){__builtin_bit_cast(float, w.x << 16), __builtin_bit_cast(float, w.x & 0xffff0000u), __builtin_bit_cast(float, w.y << 16), __builtin_bit_cast(float, w.y & 0xffff0000u)};
                        bs[bj][1] = (f32x4){__builtin_bit_cast(float, w.z << 16), __builtin_bit_cast(float, w.z & 0xffff0000u), __builtin_bit_cast(float, w.w << 16), __builtin_bit_cast(float, w.w & 0xffff0000u)}; }
                    else { bs[bj][0] = *(const f32x4*)((const float*)base + off + bj * HALF); bs[bj][1] = *(const f32x4*)((const float*)base + off + bj * HALF + 4); } }
#pragma unroll
                for (int bj = 0; bj < 2; ++bj) { const f32x4 v0 = bs[bj][0] + acc[ai][bj][m][0], v1 = bs[bj][1] + acc[ai][bj][m][1];
                    q_ += ((v0[0] * v0[0] + v0[1] * v0[1]) + (v0[2] * v0[2] + v0[3] * v0[3])) + ((v1[0] * v1[0] + v1[1] * v1[1]) + (v1[2] * v1[2] + v1[3] * v1[3]));
                    if constexpr (OUT_BF16) { u32x4 w; w.x = cvt_pk_bf16(v0[0], v0[1]); w.y = cvt_pk_bf16(v0[2], v0[3]); w.z = cvt_pk_bf16(v1[0], v1[1]); w.w = cvt_pk_bf16(v1[2], v1[3]);
                        *(u32x4*)((bf16_t*)out + off + bj * HALF) = w; }
                    else { *(f32x4*)((float*)out + off + bj * HALF) = v0; *(f32x4*)((float*)out + off + bj * HALF + 4) = v1; } }
                if (ssp) { q_ += __shfl_xor(q_, 16); q_ += __shfl_xor(q_, 32); if (fq == 0) ssp[(size_t)(u.pm * BM + r) * 32 + u.pn * 4 + wc] = q_; }
                asm volatile("" ::: "memory"); }
    }
};
struct EpiProj {
    static constexpr bool PERM = true;
    bf16_t* QKVH; bf16_t* U;
    __device__ __forceinline__ void operator()(Acc& acc, const Unit& u, int wr, int wc, int fr, int fq, PG8_LAS unsigned char*) const {
        const int row0 = u.pm * BM + wr * 64 + fr, b = (u.pm * BM) / SEQ, s0 = row0 - b * SEQ, cin = wc * 32 + 8 * fq;
#pragma unroll
        for (int ai = 0; ai < 2; ++ai)
#pragma unroll
            for (int m = 0; m < 4; ++m) {
#pragma unroll
                for (int bj = 0; bj < 2; ++bj) { const f32x4 v0 = acc[ai][bj][m][0], v1 = acc[ai][bj][m][1];
                    u32x4 w; w.x = cvt_pk_bf16(v0[0], v0[1]); w.y = cvt_pk_bf16(v0[2], v0[3]); w.z = cvt_pk_bf16(v1[0], v1[1]); w.w = cvt_pk_bf16(v1[2], v1[3]);
                    bf16_t* dst = (u.pn < 12) ? QKVH + ((size_t)(b * 24 + u.pn * 2 + bj) * SEQ + (s0 + ai * HALF + m * 16)) * 128 + cin
                                              : U + (size_t)(row0 + ai * HALF + m * 16) * 1024 + (u.pn - 12) * 256 + bj * HALF + cin;
                    *(u32x4*)dst = w; } }
    }
};
struct EpiResF32 {
    static constexpr bool PERM = false;
    const float* base; float* out; int ldc;
    __device__ __forceinline__ void operator()(Acc& acc, const Unit& u, int wr, int wc, int fr, int fq, PG8_LAS unsigned char*) const {
        const int col0 = u.pn * BM + wc * 32 + 4 * fq;
#pragma unroll
        for (int ai = 0; ai < 2; ++ai)
#pragma unroll
            for (int m = 0; m < 4; ++m) { const int r = ai * HALF + wr * 64 + m * 16 + fr; const size_t off = (size_t)(u.pm * BM + r) * ldc + col0;
                f32x4 bs[2][2];
#pragma unroll
                for (int bj = 0; bj < 2; ++bj)
#pragma unroll
                    for (int n = 0; n < 2; ++n) bs[bj][n] = *(const f32x4*)(base + off + bj * HALF + n * 16);
#pragma unroll
                for (int bj = 0; bj < 2; ++bj)
#pragma unroll
                    for (int n = 0; n < 2; ++n) *(f32x4*)(out + off + bj * HALF + n * 16) = bs[bj][n] + acc[ai][bj][m][n];
                asm volatile("" ::: "memory"); }
    }
};
struct EpiSwiGLU {
    static constexpr bool PERM = true;
    bf16_t* O; int ldc; int pm0;
    __device__ __forceinline__ void operator()(Acc& acc, const Unit& u, int wr, int wc, int fr, int fq, PG8_LAS unsigned char* xl) const {
        const int row0 = u.pm * BM + wr * 64 + fr, col0 = u.pn * HALF + wc * 32 + 8 * fq;
        const PG8_LAS float* T_ = (const PG8_LAS float*)(xl + 8192) + ((u.pm - pm0) >> 3) * 256 + wr * 64 + fr;
#pragma unroll
        for (int ai = 0; ai < 2; ++ai)
#pragma unroll
            for (int m = 0; m < 4; ++m) { bf16_t* rowp = O + (size_t)(row0 + ai * HALF + m * 16) * ldc + col0;
                float h[8];
#pragma unroll
                for (int n = 0; n < 2; ++n)
#pragma unroll
                    for (int e = 0; e < 4; ++e) { const float rs_ = T_[ai * HALF + m * 16]; const float gt = acc[ai][0][m][n][e] * rs_, up = acc[ai][1][m][n][e] * rs_;
                        const float sg = __builtin_amdgcn_rcpf(1.f + __builtin_amdgcn_exp2f(-1.4426950408889634f * gt));
                        h[n * 4 + e] = gt * sg * up; }
                u32x4 w; w.x = cvt_pk_bf16(h[0], h[1]); w.y = cvt_pk_bf16(h[2], h[3]); w.z = cvt_pk_bf16(h[4], h[5]); w.w = cvt_pk_bf16(h[6], h[7]);
                *(u32x4*)rowp = w; }
    }
};
struct EpiSoftmax {
    static constexpr bool PERM = true;
    bf16_t* O; long sOz; float sc2; int ldc; int pm0;
    __device__ __forceinline__ void operator()(Acc& acc, const Unit& u, int wr, int wc, int fr, int fq, PG8_LAS unsigned char* xl) const {
        PG8_LAS float* MX = (PG8_LAS float*)xl;
        PG8_LAS float* SMv = (PG8_LAS float*)(xl + 4096);
#pragma unroll
        for (int ai = 0; ai < 2; ++ai)
#pragma unroll
            for (int m = 0; m < 4; ++m) { float mx = -3.0e38f;
#pragma unroll
                for (int bj = 0; bj < 2; ++bj)
#pragma unroll
                    for (int n = 0; n < 2; ++n) { f32x4 s = acc[ai][bj][m][n] * (sc2 * ((const PG8_LAS float*)(xl + 8192))[((u.pm - pm0) >> 3) * 256 + ai * HALF + wr * 64 + m * 16 + fr]); acc[ai][bj][m][n] = s; mx = fmaxf(mx, fmaxf(fmaxf(s[0], s[1]), fmaxf(s[2], s[3]))); }
                mx = fmaxf(mx, __shfl_xor(mx, 16)); mx = fmaxf(mx, __shfl_xor(mx, 32));
                if (fq == 0) MX[(ai * HALF + wr * 64 + m * 16 + fr) * 4 + wc] = mx; }
        asm volatile("s_waitcnt lgkmcnt(0)" ::: "memory"); __builtin_amdgcn_s_barrier(); asm volatile("" ::: "memory");
#pragma unroll
        for (int ai = 0; ai < 2; ++ai)
#pragma unroll
            for (int m = 0; m < 4; ++m) { const int r = ai * HALF + wr * 64 + m * 16 + fr;
                const f32x4 q = *(const PG8_LAS f32x4*)(MX + r * 4); const float rm = fmaxf(fmaxf(q[0], q[1]), fmaxf(q[2], q[3]));
                float sm = 0.f;
#pragma unroll
                for (int bj = 0; bj < 2; ++bj)
#pragma unroll
                    for (int n = 0; n < 2; ++n) { f32x4 s = acc[ai][bj][m][n];
#pragma unroll
                        for (int e = 0; e < 4; ++e) { s[e] = __builtin_amdgcn_exp2f(s[e] - rm); sm += s[e]; }
                        acc[ai][bj][m][n] = s; }
                sm += __shfl_xor(sm, 16); sm += __shfl_xor(sm, 32);
                if (fq == 0) SMv[r * 4 + wc] = sm; }
        asm volatile("s_waitcnt lgkmcnt(0)" ::: "memory"); __builtin_amdgcn_s_barrier(); asm volatile("" ::: "memory");
        const int row0 = u.pm * BM + wr * 64 + fr, col0 = wc * 32 + 8 * fq;
        bf16_t* base = O + (size_t)u.z * sOz;
#pragma unroll
        for (int ai = 0; ai < 2; ++ai)
#pragma unroll
            for (int m = 0; m < 4; ++m) { const int r = ai * HALF + wr * 64 + m * 16 + fr;
                const f32x4 q = *(const PG8_LAS f32x4*)(SMv + r * 4); const float inv = 1.0f / ((q[0] + q[1]) + (q[2] + q[3]));
                bf16_t* rowp = base + (size_t)(row0 + ai * HALF + m * 16) * ldc + u.pn * BM + col0;
#pragma unroll
                for (int bj = 0; bj < 2; ++bj) { const f32x4 v0 = acc[ai][bj][m][0] * inv, v1 = acc[ai][bj][m][1] * inv;
                    u32x4 w; w.x = cvt_pk_bf16(v0[0], v0[1]); w.y = cvt_pk_bf16(v0[2], v0[3]); w.z = cvt_pk_bf16(v1[0], v1[1]); w.w = cvt_pk_bf16(v1[2], v1[3]);
                    *(u32x4*)(rowp + bj * HALF) = w; } }
    }
};

template <class Epi, class Sched, bool ALIGN_EPI>
__device__ __forceinline__ void gemm_phase(PG8_LAS unsigned char* lds, PG8_LAS unsigned char* xl, const Gemm g, const Sched& S, const Epi& E) {
    const int tid = threadIdx.x, wid = __builtin_amdgcn_readfirstlane(tid >> 6), lane = tid & 63, wr = wid >> 2, wc = wid & 3, fr = lane & 15, fq = lane >> 4;
    const int K = g.K, nt = K / BK;
    unsigned voffA[2], voffB[2];
#pragma unroll
    for (int i = 0; i < 2; ++i) { int R, C; stage_rc(tid * 16 + i * 8192, R, C); const int Rb = Epi::PERM ? ((R & ~31) + perm32(R & 31)) : R;
        voffA[i] = (unsigned)(R * g.lda + C) * 2u; voffB[i] = (unsigned)(Rb * g.ldb + C) * 2u; }
    const size_t kstep = (size_t)(BK * 2);
    const size_t hstepA = (size_t)HALF * g.lda * 2, hstepB = (size_t)HALF * g.ldb * 2;
    const unsigned ldsw = (unsigned)wid * 1024u;
    const int aoff = lds_byte(wr * 64 + fr, fq * 8), boff = lds_byte(wc * 32 + fr, fq * 8);
#define PG8_APTR(u_) ((const char*)g.A + 2 * ((size_t)((u_).z / g.ZH) * g.sAb + (size_t)((u_).z % g.ZH) * g.sAh) + (size_t)(u_).pm * 2 * hstepA)
#define PG8_BPTR(u_) ((const char*)g.Bt + 2 * ((size_t)((u_).z / g.ZH) * g.sBb + (size_t)((u_).z % g.ZH) * g.sBh) + (size_t)(u_).pn * 2 * hstepB)
#define PG8_SA(b, h) (((b) * 2 + (h)) * HTB)
#define PG8_SB(b, h) ((4 + (b) * 2 + (h)) * HTB)
#define PG8_STAGE(bufoff, gbase, voff) do { _Pragma("unroll") for (int _i = 0; _i < 2; ++_i) \
        __builtin_amdgcn_global_load_lds((const unsigned*)((const char*)(gbase) + (voff)[_i]), (PG8_LAS unsigned*)(lds + (bufoff) + ldsw + _i * 8192), 16, 0, 0); } while (0)
#define PG8_LDA(dst, b, h) do { _Pragma("unroll") for (int m = 0; m < 4; ++m) _Pragma("unroll") for (int k = 0; k < 2; ++k) dst[m][k] = *(const PG8_LAS bf16x8*)(lds + PG8_SA(b, h) + aoff + m * 2048 + k * 1024); } while (0)
#define PG8_LDB(dst, b, h) do { _Pragma("unroll") for (int n = 0; n < 2; ++n) _Pragma("unroll") for (int k = 0; k < 2; ++k) dst[n][k] = *(const PG8_LAS bf16x8*)(lds + PG8_SB(b, h) + boff + n * 2048 + k * 1024); } while (0)
#define PG8_MMA(ai, bj, At, Bt) do { __builtin_amdgcn_s_setprio(1); _Pragma("unroll") for (int m = 0; m < 4; ++m) _Pragma("unroll") for (int n = 0; n < 2; ++n) _Pragma("unroll") for (int k = 0; k < 2; ++k) \
        acc[ai][bj][m][n] = __builtin_amdgcn_mfma_f32_16x16x32_bf16(Bt[n][k], At[m][k], acc[ai][bj][m][n], 0, 0, 0); __builtin_amdgcn_s_setprio(0); } while (0)
#define PG8_WAIT_V(n) asm volatile("s_waitcnt vmcnt(" #n ")" ::: "memory")
#define PG8_WAIT_L(n) asm volatile("s_waitcnt lgkmcnt(" #n ")" ::: "memory")
#define PG8_BAR __builtin_amdgcn_s_barrier()
#define PG8_SCHED __builtin_amdgcn_sched_barrier(0)
    Unit cur, nxt; int ui = 0;
    if (!S.next(0, cur)) return;
    Acc acc;
#pragma unroll
    for (int a = 0; a < 2; ++a)
#pragma unroll
        for (int b = 0; b < 2; ++b)
#pragma unroll
            for (int m = 0; m < 4; ++m)
#pragma unroll
                for (int n = 0; n < 2; ++n) acc[a][b][m][n] = (f32x4){0.f, 0.f, 0.f, 0.f};
    bf16x8 At[4][2], B0[2][2], B1[2][2];
    const char* cA = PG8_APTR(cur); const char* cB = PG8_BPTR(cur);
    PG8_STAGE(PG8_SB(0, 0), cB, voffB); PG8_STAGE(PG8_SB(0, 1), cB + hstepB, voffB); PG8_STAGE(PG8_SA(0, 0), cA, voffA); PG8_STAGE(PG8_SA(0, 1), cA + hstepA, voffA);
    if (wr == 1) PG8_BAR;
    PG8_WAIT_V(2); PG8_BAR;
    PG8_STAGE(PG8_SB(1, 0), cB + kstep, voffB); PG8_STAGE(PG8_SA(1, 0), cA + kstep, voffA); PG8_STAGE(PG8_SB(1, 1), cB + hstepB + kstep, voffB);
    PG8_WAIT_V(6); PG8_BAR;
    for (;;) {
        const bool has_next = S.next(ui + 1, nxt);
        const char* nA = has_next ? PG8_APTR(nxt) : cA; const char* nB = has_next ? PG8_BPTR(nxt) : cB;
        for (int t = 0; t < nt; t += 2) {
            const bool last = (t == nt - 2);
            const char* a1 = cA + (size_t)(t + 1) * kstep;
            const char* a2 = last ? nA : cA + (size_t)(t + 2) * kstep; const char* b2 = last ? nB : cB + (size_t)(t + 2) * kstep;
            const char* a3 = a2 + kstep; const char* b3 = b2 + kstep;
            PG8_LDB(B0, 0, 0); PG8_LDB(B1, 0, 1); PG8_SCHED; PG8_LDA(At, 0, 0); PG8_STAGE(PG8_SA(1, 1), a1 + hstepA, voffA);
            PG8_WAIT_V(8); PG8_WAIT_L(0); PG8_BAR; PG8_MMA(0, 0, At, B0); PG8_MMA(0, 1, At, B1); PG8_BAR; PG8_SCHED;
            PG8_LDA(At, 0, 1); PG8_STAGE(PG8_SB(0, 0), b2, voffB); PG8_STAGE(PG8_SB(0, 1), b2 + hstepB, voffB); PG8_STAGE(PG8_SA(0, 0), a2, voffA);
            PG8_WAIT_V(8); PG8_WAIT_L(0); PG8_BAR; PG8_MMA(1, 0, At, B0); PG8_MMA(1, 1, At, B1); PG8_BAR; PG8_SCHED;
            PG8_LDB(B0, 1, 0); PG8_LDB(B1, 1, 1); PG8_SCHED; PG8_LDA(At, 1, 0); PG8_STAGE(PG8_SA(0, 1), a2 + hstepA, voffA);
            PG8_WAIT_V(8); PG8_WAIT_L(0); PG8_BAR; PG8_MMA(0, 0, At, B0); PG8_MMA(0, 1, At, B1); PG8_BAR; PG8_SCHED;
            PG8_LDA(At, 1, 1); PG8_STAGE(PG8_SB(1, 0), b3, voffB); PG8_STAGE(PG8_SB(1, 1), b3 + hstepB, voffB); PG8_STAGE(PG8_SA(1, 0), a3, voffA);
            PG8_WAIT_V(8); PG8_WAIT_L(0); PG8_BAR; PG8_MMA(1, 0, At, B0); PG8_MMA(1, 1, At, B1); PG8_BAR; PG8_SCHED;
        }
        if constexpr (ALIGN_EPI) { if (wr == 0) PG8_BAR; }
        E(acc, cur, wr, wc, fr, fq, xl);
        if (!has_next) break;
#pragma unroll
        for (int a = 0; a < 2; ++a)
#pragma unroll
            for (int b = 0; b < 2; ++b)
#pragma unroll
                for (int m = 0; m < 4; ++m)
#pragma unroll
                    for (int n = 0; n < 2; ++n) acc[a][b][m][n] = (f32x4){0.f, 0.f, 0.f, 0.f};
        cur = nxt; cA = nA; cB = nB; ++ui;
        if constexpr (ALIGN_EPI) { if (wr == 1) PG8_BAR; }
    }
    PG8_WAIT_V(0);
    if constexpr (!ALIGN_EPI) { if (wr == 0) PG8_BAR; }
    PG8_BAR;
#undef PG8_APTR
#undef PG8_BPTR
#undef PG8_SA
#undef PG8_SB
#undef PG8_STAGE
#undef PG8_LDA
#undef PG8_LDB
#undef PG8_MMA
#undef PG8_WAIT_V
#undef PG8_WAIT_L
#undef PG8_BAR
#undef PG8_SCHED
}
}

namespace att {
constexpr int D = 128;
constexpr int PIN = DIN;
constexpr int POUT = 2048;
constexpr float SCALE = 0.08838834764831845f;
constexpr float THR = 8.f;
constexpr int NW = 8, QBLK = 32, KVBLK = 64, QB = NW * QBLK;
constexpr int SHM_V = KVBLK * D * 2, SHM_K = KVBLK * D * 2;
constexpr int LDS_BYTES = 2 * SHM_V + 2 * SHM_K + NW * 64 * 4;
using bf16 = __hip_bfloat16;
typedef short bf16x8 __attribute__((ext_vector_type(8)));
typedef short s16x4 __attribute__((ext_vector_type(4)));
typedef float f32x16 __attribute__((ext_vector_type(16)));
typedef float f32x4 __attribute__((ext_vector_type(4)));
typedef unsigned u32x4 __attribute__((ext_vector_type(4)));

#define KSWZ(row, colB) ((row) * 256 + ((colB) ^ (((row) & 7) << 4)))
#define SBAR() __builtin_amdgcn_sched_barrier(0)
__device__ __forceinline__ int v_st(int k, int c) { const int kk = (k & ~0xC) | ((k & 4) << 1) | ((k & 8) >> 1); return ((kk >> 3) * 4 + (c >> 5)) * 512 + ((kk & 7) * 32 + (c & 31)) * 2; }
__device__ __forceinline__ int v_rd_base(int lane) { return ((lane & 3) << 3) | (((lane >> 2) & 3) << 6) | (((lane >> 4) & 1) << 5) | (((lane >> 5) & 1) << 8); }
constexpr int v_rd_off(int d0, int ks, int half) { return d0 * 512 + ks * 4096 + half * 2048; }
__device__ __forceinline__ int crow(int r, int hi) { return (r & 3) + 8 * (r >> 2) + 4 * hi; }
__device__ __forceinline__ unsigned cvtpk(float lo, float hi) { unsigned r; asm volatile("v_cvt_pk_bf16_f32 %0, %1, %2" : "=v"(r) : "v"(lo), "v"(hi)); return r; }
__device__ __forceinline__ bf16x8 load8(const bf16* p) { return *reinterpret_cast<const bf16x8*>(p); }
__device__ __forceinline__ void mask_tile(f32x16& p0, f32x16& p1, int dq, unsigned W) {
    const float NEG = -__builtin_inff();
#pragma unroll
    for (int r = 0; r < 16; ++r) {
        const int c = (r & 3) + 8 * (r >> 2);
        if ((unsigned)(dq - c) >= W) p0[r] = NEG;
        if ((unsigned)(dq - c - 32) >= W) p1[r] = NEG;
    }
}
__device__ __forceinline__ void partialSM(f32x16& p0, f32x16& p1, float& m_reg, float& mn, float& alpha) {
    float pmax = p0[0]; for (int r = 1; r < 16; ++r) pmax = fmaxf(pmax, p0[r]); for (int r = 0; r < 16; ++r) pmax = fmaxf(pmax, p1[r]);
    { auto rr = __builtin_amdgcn_permlane32_swap(__float_as_uint(pmax), __float_as_uint(pmax), false, false);
      pmax = fmaxf(__uint_as_float(rr[0]), __uint_as_float(rr[1])); }
    constexpr float C2 = 1.4426950408889634f * SCALE;
    if (__builtin_expect(__all((pmax - m_reg) * SCALE <= THR), 1)) { mn = m_reg; alpha = 1.f; }
    else { mn = fmaxf(m_reg, pmax); alpha = __builtin_amdgcn_exp2f((m_reg - mn) * C2); m_reg = mn; }
    const float mnL = -mn * C2;
    for (int r = 0; r < 16; ++r) p0[r] = fmaf(p0[r], C2, mnL); for (int r = 0; r < 16; ++r) p1[r] = fmaf(p1[r], C2, mnL);
    for (int r = 0; r < 16; ++r) p0[r] = __builtin_amdgcn_exp2f(p0[r]);
}
__device__ __forceinline__ void finishSM(f32x16& p0, f32x16& p1, float alpha, float& l_reg, bf16x8& pa0, bf16x8& pa1, bf16x8& pa2, bf16x8& pa3) {
    for (int r = 0; r < 16; ++r) p1[r] = __builtin_amdgcn_exp2f(p1[r]);
    float ps = 0; for (int r = 0; r < 16; ++r) ps += p0[r]; for (int r = 0; r < 16; ++r) ps += p1[r];
    { auto rr = __builtin_amdgcn_permlane32_swap(__float_as_uint(ps), __float_as_uint(ps), false, false);
      ps = __uint_as_float(rr[0]) + __uint_as_float(rr[1]); }
    l_reg = l_reg * alpha + ps;
#define PK4(P, B_, OUT) do { unsigned a0 = cvtpk(P[B_+0], P[B_+1]), a1 = cvtpk(P[B_+2], P[B_+3]);                          \
        unsigned b0 = cvtpk(P[B_+4], P[B_+5]), b1 = cvtpk(P[B_+6], P[B_+7]);                                             \
        auto r0 = __builtin_amdgcn_permlane32_swap(a0, b0, false, false); auto r1 = __builtin_amdgcn_permlane32_swap(a1, b1, false, false); \
        u32x4 w = {r0[0], r1[0], r0[1], r1[1]}; OUT = *reinterpret_cast<bf16x8*>(&w); } while (0)
    PK4(p0, 0, pa0); PK4(p0, 8, pa1); PK4(p1, 0, pa2); PK4(p1, 8, pa3);
#undef PK4
}
template <int KB>
__device__ __forceinline__ void qkt(f32x16& p0, f32x16& p1, const char* K_lds, int r32, int hi, const bf16x8* qr) {
    p0 = f32x16{}; p1 = f32x16{};
    const char* kb[4];
#pragma unroll
    for (int dd = 0; dd < 4; ++dd) kb[dd] = K_lds + KB * SHM_K + KSWZ(r32, (dd * 16 + hi * 8) * 2);
#pragma unroll
    for (int d0 = 0; d0 < 8; ++d0) { const char* a = kb[d0 & 3] + (d0 >> 2) * 128;
        bf16x8 b0 = *reinterpret_cast<const bf16x8*>(a);
        bf16x8 b1 = *reinterpret_cast<const bf16x8*>(a + 32 * 256);
        p0 = __builtin_amdgcn_mfma_f32_32x32x16_bf16(b0, qr[d0], p0, 0, 0, 0);
        p1 = __builtin_amdgcn_mfma_f32_32x32x16_bf16(b1, qr[d0], p1, 0, 0, 0); }
}
template <int VB>
__device__ __forceinline__ void pv_tile(f32x16* o, int vb0, bf16x8 pa0, bf16x8 pa1, bf16x8 pa2, bf16x8 pa3) {
#define TRRD(dst, off) asm volatile("ds_read_b64_tr_b16 %0, %1 offset:%2" : "=&v"(dst) : "v"(vb0), "i"(off) : "memory")
#define PV_D0(d0) do { s16x4 l0, l1, l2, l3, h0, h1, h2, h3; constexpr int b_ = VB * SHM_V + v_rd_off(d0, 0, 0); \
        TRRD(l0, b_); TRRD(h0, b_ + 2048); TRRD(l1, b_ + 4096); TRRD(h1, b_ + 6144); TRRD(l2, b_ + 8192); TRRD(h2, b_ + 10240); TRRD(l3, b_ + 12288); TRRD(h3, b_ + 14336); \
        asm volatile("s_waitcnt lgkmcnt(0)" ::: "memory"); SBAR();   \
        o[d0] = __builtin_amdgcn_mfma_f32_32x32x16_bf16(pa0, (bf16x8){l0[0], l0[1], l0[2], l0[3], h0[0], h0[1], h0[2], h0[3]}, o[d0], 0, 0, 0);   \
        o[d0] = __builtin_amdgcn_mfma_f32_32x32x16_bf16(pa1, (bf16x8){l1[0], l1[1], l1[2], l1[3], h1[0], h1[1], h1[2], h1[3]}, o[d0], 0, 0, 0);   \
        o[d0] = __builtin_amdgcn_mfma_f32_32x32x16_bf16(pa2, (bf16x8){l2[0], l2[1], l2[2], l2[3], h2[0], h2[1], h2[2], h2[3]}, o[d0], 0, 0, 0);   \
        o[d0] = __builtin_amdgcn_mfma_f32_32x32x16_bf16(pa3, (bf16x8){l3[0], l3[1], l3[2], l3[3], h3[0], h3[1], h3[2], h3[3]}, o[d0], 0, 0, 0); } while (0)
    PV_D0(0); PV_D0(1); PV_D0(2); PV_D0(3);
#undef PV_D0
#undef TRRD
}

struct BlockRef { const bf16* Q; const bf16* K; const bf16* V; bf16* O; int P0; };
struct Seam { bf16x8 qr[8]; bf16x8 st_v0, st_v1, st_k0, st_k1; };
#define ROW(p, k0, rr) ((p) + (size_t)((k0) + (rr)) * PIN + sc)
#define VMW() asm volatile("s_waitcnt vmcnt(0)" ::: "memory")
#define VMWN(n) asm volatile("s_waitcnt vmcnt(%0)" :: "i"(n) : "memory")
#define SLOAD_H(Kp, Vp, k0) do { S.st_v0 = load8(ROW(Vp, k0, sr)); S.st_v1 = load8(ROW(Vp, k0, 32 + sr));              \
                         S.st_k0 = load8(ROW(Kp, k0, sr)); S.st_k1 = load8(ROW(Kp, k0, 32 + sr)); } while (0)
#define SWRITE_HK(bf) do { *(bf16x8*)(K_lds + (bf) * SHM_K + kws) = S.st_k0; *(bf16x8*)(K_lds + (bf) * SHM_K + kws + 32 * 256) = S.st_k1; } while (0)
#define SWRITE_HV(bf) do { *(bf16x8*)(V_lds + (bf) * SHM_V + vst0) = S.st_v0; *(bf16x8*)(V_lds + (bf) * SHM_V + vst1) = S.st_v1; } while (0)
#define SWRITE_H(bf) do { SWRITE_HV(bf); SWRITE_HK(bf); } while (0)
__device__ __forceinline__ void causal_prime(const BlockRef& cur, char* lds, Seam& S) {
    const int tid = threadIdx.x, wid = __builtin_amdgcn_readfirstlane(tid >> 6), lane = tid & 63, r32 = lane & 31, hi = lane >> 5;
    const int sr = tid >> 4, sc = (tid & 15) * 8, kws = KSWZ(sr, sc * 2); char* K_lds = lds + 2 * SHM_V;
    const int kb0 = 0;
    for (int d0 = 0; d0 < 8; ++d0) S.qr[d0] = load8(cur.Q + (size_t)(wid * QBLK + r32) * PIN + d0 * 16 + hi * 8);
    SLOAD_H(cur.K, cur.V, kb0); VMW(); SWRITE_HK(0);
    __syncthreads();
}
__device__ __forceinline__ void causal_block(const BlockRef& cur, const BlockRef& nxt, int skv, char* lds, Seam& S) {
    const int W = 1 << 30;
    const int tid = threadIdx.x, wid = __builtin_amdgcn_readfirstlane(tid >> 6), lane = tid & 63, r32 = lane & 31, hi = lane >> 5;
    const int j_lo = 0;
    int j_hi = (cur.P0 + QB - 1) / KVBLK + 1; if (j_hi > skv / KVBLK) j_hi = skv / KVBLK;
    const int NT = j_hi - j_lo;
    const int kbn = 0;
    const int qlo = cur.P0 + wid * QBLK, qm = qlo + r32 - 4 * hi;
    char* V_lds = lds; char* K_lds = lds + 2 * SHM_V;
    float* ws = (float*)(lds + 2 * SHM_V + 2 * SHM_K) + wid * 64; float* li_l = ws, * al_l = ws + 32;
    float m_reg = -1e30f, l_reg = 0; f32x16 o[4] = {};
    const int sr = tid >> 4, sc = (tid & 15) * 8, vst0 = v_st(sr, sc), vst1 = v_st(32 + sr, sc), kws = KSWZ(sr, sc * 2);
    const int vb0 = (int)(uintptr_t)V_lds + v_rd_base(lane);
    const bf16* Kh = cur.K; const bf16* Vh = cur.V;
#define RESC(a) do { if (__any((a) < 1.f)) { if (hi == 0) al_l[r32] = (a); asm volatile("s_waitcnt lgkmcnt(0)" ::: "memory");              \
                     for (int d_ = 0; d_ < 4; ++d_) for (int r = 0; r < 16; ++r) o[d_][r] *= al_l[crow(r, hi)]; } } while (0)
#define KBASE(t) ((j_lo + (t)) * KVBLK)
#define MASKT(P0_, P1_, t) do { const int kb_ = KBASE(t); if (kb_ + KVBLK - 1 > qlo) mask_tile(P0_, P1_, qm - kb_, (unsigned)W); } while (0)
    constexpr int NQL = 8;
#define SEAM_K0() do { VMWN(NQL); SWRITE_HK(0); SBAR(); } while (0)
    f32x16 pA0, pA1, pB0, pB1; float mnA, mnB, alA, alB; bf16x8 pa0, pa1, pa2, pa3;
    SWRITE_HV(0); SBAR();
    if (NT > 1) { SLOAD_H(Kh, Vh, KBASE(1)); }
    SBAR(); qkt<0>(pA0, pA1, K_lds, r32, hi, S.qr);
    MASKT(pA0, pA1, 0); partialSM(pA0, pA1, m_reg, mnA, alA);
    if (NT > 1) { VMW(); SWRITE_H(1); }
    __syncthreads();
#define HALF_STEP(PX0, PX1, mnX, alX, PY0, PY1, alY, t, KB, VB, SB) do {                                                      \
        SBAR(); qkt<KB>(PX0, PX1, K_lds, r32, hi, S.qr);                                                                      \
        finishSM(PY0, PY1, alY, l_reg, pa0, pa1, pa2, pa3); SBAR();                                                           \
        if ((t) + 1 < NT) { SLOAD_H(Kh, Vh, KBASE((t) + 1)); SBAR(); }                                                        \
        pv_tile<VB>(o, vb0, pa0, pa1, pa2, pa3); MASKT(PX0, PX1, (t)); partialSM(PX0, PX1, m_reg, mnX, alX);                  \
        __syncthreads();                                                                                                      \
        if ((t) + 1 < NT) { VMW(); SWRITE_H(SB); }                                                                            \
        RESC(alX); __syncthreads(); } while (0)
    for (int t = 1; t + 1 < NT; t += 2) {
        HALF_STEP(pB0, pB1, mnB, alB, pA0, pA1, alA, t, 1, 0, 0);
        HALF_STEP(pA0, pA1, mnA, alA, pB0, pB1, alB, t + 1, 0, 1, 1);
    }
    const bool even = (NT & 1) == 0;
    if (even) { SBAR(); qkt<1>(pB0, pB1, K_lds, r32, hi, S.qr); SBAR(); }
    SLOAD_H(nxt.K, nxt.V, kbn); SBAR();
#pragma unroll
    for (int d0 = 0; d0 < 8; ++d0) S.qr[d0] = load8(nxt.Q + (size_t)(wid * QBLK + r32) * PIN + d0 * 16 + hi * 8);
    SBAR();
    finishSM(pA0, pA1, alA, l_reg, pa0, pa1, pa2, pa3); SBAR();
    pv_tile<0>(o, vb0, pa0, pa1, pa2, pa3);
    if (even) { MASKT(pB0, pB1, NT - 1); partialSM(pB0, pB1, m_reg, mnB, alB); __syncthreads(); RESC(alB);
        finishSM(pB0, pB1, alB, l_reg, pa0, pa1, pa2, pa3); SBAR(); pv_tile<1>(o, vb0, pa0, pa1, pa2, pa3); }
    SBAR(); SEAM_K0();
    if (hi == 0) li_l[r32] = l_reg; asm volatile("s_waitcnt lgkmcnt(0)" ::: "memory");
    float rli[16];
#pragma unroll
    for (int r = 0; r < 16; ++r) rli[r] = __builtin_amdgcn_rcpf(li_l[crow(r, hi)]);
    bf16* Ow = cur.O + (size_t)(wid * QBLK) * POUT;
#pragma unroll
    for (int r = 0; r < 16; ++r) { const int orow = crow(r, hi);
#pragma unroll
        for (int d0 = 0; d0 < 4; ++d0) { const float v = o[d0][r] * rli[r];
            const float vn = __shfl_xor(v, 1);
            if ((r32 & 1) == 0) *(unsigned*)(Ow + (size_t)orow * POUT + d0 * 32 + r32) = cvtpk(v, vn); } }
    __syncthreads();
#undef RESC
#undef KBASE
#undef MASKT
#undef SEAM_K0
#undef HALF_STEP
}
#undef ROW
#undef VMW
#undef VMWN
#undef SLOAD_H
#undef SWRITE_HK
#undef SWRITE_HV
#undef SWRITE_H
#undef KSWZ
#undef SBAR

__device__ __forceinline__ BlockRef make_ref(int L, int pass, const bf16* PROJ, bf16* O16) {
    const int xcd = L & 7, kk = L >> 3, p = xcd * 4 + (kk >> 5), x = kk & 31;
    const int qb = pass ? 63 - x : x;
    const int b = p >> 4, h = (p >> 2) & 3, m = (p >> 1) & 1, vh = p & 1;
    const size_t rb = (size_t)b * SEQ;
    BlockRef r;
    r.Q = PROJ + (rb + (size_t)qb * QB) * PIN + (h * 2 + m) * 128;
    r.K = PROJ + rb * PIN + 1024 + (h * 2 + m) * 128;
    r.V = PROJ + rb * PIN + 2048 + h * 256 + vh * 128;
    r.O = O16 + (rb + (size_t)qb * QB) * POUT + (p & 15) * 128;
    r.P0 = qb * QB;
    return r;
}
__device__ __forceinline__ void attn_phase(char* lds, const bf16* PROJ, bf16* O16, int G, int w) {
    constexpr int total = 1024;
    int L = w; if (L >= total) return;
    int pass = 0;
    BlockRef cur = make_ref(L, 0, PROJ, O16);
    Seam S;
    causal_prime(cur, lds, S);
    for (;;) {
        const bool more_pass = pass == 0, more_item = L + G < total, last = !more_pass && !more_item;
        int passn, Ln;
        if (more_pass) { passn = 1; Ln = L; } else { passn = 0; Ln = more_item ? L + G : L; }
        const BlockRef nxt = last ? cur : make_ref(Ln, passn, PROJ, O16);
        causal_block(cur, nxt, SEQ, lds, S);
        if (last) break;
        cur = nxt; pass = passn; L = Ln;
    }
}
}


namespace att2 {
using namespace att;
constexpr int QB2 = 128;
constexpr int PH = 128;
constexpr long HSTR = (long)SEQ * PH;
constexpr int L_V = 0, L_K = 4 * SHM_V, L_WSF = L_K + 2 * SHM_K, L_XM = L_WSF + 2048, L_XP = L_XM + 2048, L_XL = L_XP + 32768, L_END = L_XL + 1024;
#define KSWZ2(row, colB) ((row) * 256 + ((colB) ^ (((row) & 7) << 4)))
#define SBAR2() __builtin_amdgcn_sched_barrier(0)
struct BlockRef2 { const bf16* Q; const bf16* K; const bf16* V; bf16* O; int P0; };

__device__ __forceinline__ void block2(const BlockRef2& cur, char* lds, int wave) {
    const int lane = (int)__builtin_amdgcn_mbcnt_hi(~0u, __builtin_amdgcn_mbcnt_lo(~0u, 0u)), r32 = lane & 31, hi = lane >> 5, tid = wave * 64 + lane;
    const int rg = wave & 3, c = wave >> 2, pw = wave ^ 4;
    const int NT = (cur.P0 + QB2 - 1) / KVBLK + 1;
    const int qlo = cur.P0 + rg * QBLK, qm = qlo + r32 - 4 * hi;
    char* V_lds = lds + L_V; char* K_lds = lds + L_K;
    float* wsf = (float*)(lds + L_WSF) + wave * 64; float* li_l = wsf; float* al_l = wsf + 32;
    float* xm = (float*)(lds + L_XM);
    char* xp = lds + L_XP;
    float* xl = (float*)(lds + L_XL);
    const int sr = tid >> 4, sc = (tid & 15) * 8, vst0 = v_st(sr, sc), vst1 = v_st(32 + sr, sc), kws = KSWZ2(sr, sc * 2);
    const int vb0 = (int)(uintptr_t)V_lds + c * SHM_V + v_rd_base(lane);
    const bf16* Kh = cur.K; const bf16* Vh = cur.V;
    bf16x8 qr[8];
#pragma unroll
    for (int d0 = 0; d0 < 8; ++d0) qr[d0] = *reinterpret_cast<const bf16x8*>((const char*)(cur.Q + (size_t)(rg * QBLK) * PH) + (unsigned)(r32 * PH + hi * 8) * 2u + d0 * 32);
    bf16x8 sk0, sk1, sv00, sv01, sv10, sv11;
    unsigned voff = (unsigned)(sr * PH + sc) * 2u; asm volatile("" : "+v"(voff));
#define LD16(base_, byteoff_) (*reinterpret_cast<const bf16x8*>((const char*)(base_) + voff + (byteoff_)))
#define KLOAD(k0) do { const bf16* kb0_ = Kh + (size_t)(k0) * PH; const bf16* kb1_ = Kh + (size_t)((k0) + 32) * PH; sk0 = LD16(kb0_, 0); sk1 = LD16(kb1_, 0); } while (0)
#define VLOAD(k0) do { const bf16* vb0_ = Vh + (size_t)(k0) * PH; const bf16* vb1_ = Vh + (size_t)((k0) + 32) * PH; \
                       sv00 = LD16(vb0_, 0); sv01 = LD16(vb1_, 0); sv10 = LD16(vb0_ + HSTR, 0); sv11 = LD16(vb1_ + HSTR, 0); } while (0)
#define KWRITE(bf) do { *(bf16x8*)(K_lds + (bf) * SHM_K + kws) = sk0; *(bf16x8*)(K_lds + (bf) * SHM_K + kws + 32 * 256) = sk1; } while (0)
#define VWRITE(bf) do { *(bf16x8*)(V_lds + ((bf) * 2) * SHM_V + vst0) = sv00; *(bf16x8*)(V_lds + ((bf) * 2) * SHM_V + vst1) = sv01; \
                        *(bf16x8*)(V_lds + ((bf) * 2 + 1) * SHM_V + vst0) = sv10; *(bf16x8*)(V_lds + ((bf) * 2 + 1) * SHM_V + vst1) = sv11; } while (0)
    KLOAD(0); VLOAD(0); KWRITE(0); VWRITE(0);
    KLOAD(KVBLK); VLOAD(KVBLK); KWRITE(1); VWRITE(1);
    if (NT > 2) { KLOAD(2 * KVBLK); VLOAD(2 * KVBLK); }
    float m_reg = -1e30f, l_reg = 0.f; f32x16 o[4] = {};
    f32x16 pA, pB; float alA = 1.f, alB = 1.f; bf16x8 f0, f1;
    constexpr float C2 = 1.4426950408889634f * SCALE;
#define QKT2(P, KB) do { P = f32x16{}; const char* kq_ = K_lds + (KB) * SHM_K + c * (32 * 256); \
        _Pragma("unroll") for (int d0 = 0; d0 < 8; ++d0) { const bf16x8 b_ = *reinterpret_cast<const bf16x8*>(kq_ + KSWZ2(r32, (((d0) & 3) * 16 + hi * 8) * 2) + ((d0) >> 2) * 128); \
            P = __builtin_amdgcn_mfma_f32_32x32x16_bf16(b_, qr[d0], P, 0, 0, 0); } } while (0)
#define MASKMAX(P, t, par) do { const int kb_ = (t) * KVBLK + 32 * c; \
        if (kb_ + 31 > qlo) { const int dq_ = qm - kb_; const float NEG_ = -__builtin_inff(); \
            _Pragma("unroll") for (int r = 0; r < 16; ++r) { if (dq_ - ((r & 3) + 8 * (r >> 2)) < 0) P[r] = NEG_; } } \
        float pm_ = P[0]; _Pragma("unroll") for (int r = 1; r < 16; ++r) pm_ = fmaxf(pm_, P[r]); \
        { auto rr = __builtin_amdgcn_permlane32_swap(__float_as_uint(pm_), __float_as_uint(pm_), false, false); pm_ = fmaxf(__uint_as_float(rr[0]), __uint_as_float(rr[1])); } \
        pmx = pm_; if (hi == 0) xm[((par) * 8 + wave) * 32 + r32] = pm_; } while (0)
#define SOFTMAX(P, par, alX) do { const float pmax_ = fmaxf(pmx, xm[((par) * 8 + pw) * 32 + r32]); float mn_; \
        if (__builtin_expect(__all((pmax_ - m_reg) * SCALE <= THR), 1)) { mn_ = m_reg; alX = 1.f; } \
        else { mn_ = fmaxf(m_reg, pmax_); alX = __builtin_amdgcn_exp2f((m_reg - mn_) * C2); m_reg = mn_; } \
        const float mnL_ = -mn_ * C2; \
        _Pragma("unroll") for (int r = 0; r < 16; ++r) P[r] = __builtin_amdgcn_exp2f(fmaf(P[r], C2, mnL_)); } while (0)
#define PK4B(P, B_, OUT) do { unsigned a0 = cvtpk(P[B_+0], P[B_+1]), a1 = cvtpk(P[B_+2], P[B_+3]); unsigned b0 = cvtpk(P[B_+4], P[B_+5]), b1 = cvtpk(P[B_+6], P[B_+7]); \
        auto r0 = __builtin_amdgcn_permlane32_swap(a0, b0, false, false); auto r1 = __builtin_amdgcn_permlane32_swap(a1, b1, false, false); \
        u32x4 w = {r0[0], r1[0], r0[1], r1[1]}; OUT = *reinterpret_cast<bf16x8*>(&w); } while (0)
#define FINISH(P, alY, par) do { float ps_ = 0; _Pragma("unroll") for (int r = 0; r < 16; ++r) ps_ += P[r]; \
        { auto rr = __builtin_amdgcn_permlane32_swap(__float_as_uint(ps_), __float_as_uint(ps_), false, false); ps_ = __uint_as_float(rr[0]) + __uint_as_float(rr[1]); } \
        l_reg = l_reg * alY + ps_; PK4B(P, 0, f0); PK4B(P, 8, f1); \
        *(bf16x8*)(xp + (((par) * 8 + wave) * 2 + 0) * 1024 + lane * 16) = f0; *(bf16x8*)(xp + (((par) * 8 + wave) * 2 + 1) * 1024 + lane * 16) = f1; } while (0)
#define TRRD2(dst, off) asm volatile("ds_read_b64_tr_b16 %0, %1 offset:%2" : "=&v"(dst) : "v"(vb0), "i"(off) : "memory")
#define PV2_D0(VB, d0) do { s16x4 l0, l1, l2, l3, h0, h1, h2, h3; constexpr int b_ = (VB) * 2 * SHM_V + v_rd_off(d0, 0, 0); \
        TRRD2(l0, b_); TRRD2(h0, b_ + 2048); TRRD2(l1, b_ + 4096); TRRD2(h1, b_ + 6144); TRRD2(l2, b_ + 8192); TRRD2(h2, b_ + 10240); TRRD2(l3, b_ + 12288); TRRD2(h3, b_ + 14336); \
        asm volatile("s_waitcnt lgkmcnt(0)" ::: "memory"); SBAR2(); __builtin_amdgcn_s_setprio(1);  \
        o[d0] = __builtin_amdgcn_mfma_f32_32x32x16_bf16(pa0, (bf16x8){l0[0], l0[1], l0[2], l0[3], h0[0], h0[1], h0[2], h0[3]}, o[d0], 0, 0, 0);   \
        o[d0] = __builtin_amdgcn_mfma_f32_32x32x16_bf16(pa1, (bf16x8){l1[0], l1[1], l1[2], l1[3], h1[0], h1[1], h1[2], h1[3]}, o[d0], 0, 0, 0);   \
        o[d0] = __builtin_amdgcn_mfma_f32_32x32x16_bf16(pa2, (bf16x8){l2[0], l2[1], l2[2], l2[3], h2[0], h2[1], h2[2], h2[3]}, o[d0], 0, 0, 0);   \
        o[d0] = __builtin_amdgcn_mfma_f32_32x32x16_bf16(pa3, (bf16x8){l3[0], l3[1], l3[2], l3[3], h3[0], h3[1], h3[2], h3[3]}, o[d0], 0, 0, 0); __builtin_amdgcn_s_setprio(0); } while (0)
#define PVALL(VB, par) do { const bf16x8 g0_ = *(const bf16x8*)(xp + (((par) * 8 + pw) * 2 + 0) * 1024 + lane * 16), g1_ = *(const bf16x8*)(xp + (((par) * 8 + pw) * 2 + 1) * 1024 + lane * 16); \
        const bf16x8 pa0 = c ? g0_ : f0, pa1 = c ? g1_ : f1, pa2 = c ? f0 : g0_, pa3 = c ? f1 : g1_; \
        PV2_D0(VB, 0); PV2_D0(VB, 1); PV2_D0(VB, 2); PV2_D0(VB, 3); } while (0)
#define RESC2(a) do { if (__any((a) < 1.f)) { if (hi == 0) al_l[r32] = (a); asm volatile("s_waitcnt lgkmcnt(0)" ::: "memory");              \
                     for (int d_ = 0; d_ < 4; ++d_) for (int r = 0; r < 16; ++r) o[d_][r] *= al_l[crow(r, hi)]; } } while (0)
#define QKT2F(PX, KB, PY, alY, par) do { const char* kq_ = K_lds + (KB) * SHM_K + c * (32 * 256); bf16x8 kf_[8]; \
        _Pragma("unroll") for (int d0 = 0; d0 < 8; ++d0) kf_[d0] = *reinterpret_cast<const bf16x8*>(kq_ + KSWZ2(r32, (((d0) & 3) * 16 + hi * 8) * 2) + ((d0) >> 2) * 128); \
        PX = f32x16{}; float ps_ = 0.f; SBAR2(); __builtin_amdgcn_s_setprio(1); \
        PX = __builtin_amdgcn_mfma_f32_32x32x16_bf16(kf_[0], qr[0], PX, 0, 0, 0); SBAR2(); \
        _Pragma("unroll") for (int r = 0; r < 8; ++r) ps_ += PY[r]; SBAR2(); \
        PX = __builtin_amdgcn_mfma_f32_32x32x16_bf16(kf_[1], qr[1], PX, 0, 0, 0); SBAR2(); \
        _Pragma("unroll") for (int r = 8; r < 16; ++r) ps_ += PY[r]; \
        { auto rr = __builtin_amdgcn_permlane32_swap(__float_as_uint(ps_), __float_as_uint(ps_), false, false); ps_ = __uint_as_float(rr[0]) + __uint_as_float(rr[1]); } \
        l_reg = l_reg * alY + ps_; SBAR2(); \
        PX = __builtin_amdgcn_mfma_f32_32x32x16_bf16(kf_[2], qr[2], PX, 0, 0, 0); SBAR2(); \
        PK4B(PY, 0, f0); *(bf16x8*)(xp + (((par) * 8 + wave) * 2 + 0) * 1024 + lane * 16) = f0; SBAR2(); \
        PX = __builtin_amdgcn_mfma_f32_32x32x16_bf16(kf_[3], qr[3], PX, 0, 0, 0); SBAR2(); \
        PK4B(PY, 8, f1); *(bf16x8*)(xp + (((par) * 8 + wave) * 2 + 1) * 1024 + lane * 16) = f1; SBAR2(); \
        PX = __builtin_amdgcn_mfma_f32_32x32x16_bf16(kf_[4], qr[4], PX, 0, 0, 0); \
        PX = __builtin_amdgcn_mfma_f32_32x32x16_bf16(kf_[5], qr[5], PX, 0, 0, 0); \
        PX = __builtin_amdgcn_mfma_f32_32x32x16_bf16(kf_[6], qr[6], PX, 0, 0, 0); \
        PX = __builtin_amdgcn_mfma_f32_32x32x16_bf16(kf_[7], qr[7], PX, 0, 0, 0); __builtin_amdgcn_s_setprio(0); SBAR2(); } while (0)
#define SM_DECIDE(par, alX) do { const float pmax_ = fmaxf(pmx, xm[((par) * 8 + pw) * 32 + r32]); float mn_; \
        if (__builtin_expect(__all((pmax_ - m_reg) * SCALE <= THR), 1)) { mn_ = m_reg; alX = 1.f; } \
        else { mn_ = fmaxf(m_reg, pmax_); alX = __builtin_amdgcn_exp2f((m_reg - mn_) * C2); m_reg = mn_; } \
        mnL = -mn_ * C2; } while (0)
#define SM_EXP4(P, B_) do { _Pragma("unroll") for (int r = (B_); r < (B_) + 4; ++r) P[r] = __builtin_amdgcn_exp2f(fmaf(P[r], C2, mnL)); } while (0)
#define PVSM(VB, par, PX, parX, alX) do { const bf16x8 g0_ = *(const bf16x8*)(xp + (((par) * 8 + pw) * 2 + 0) * 1024 + lane * 16), g1_ = *(const bf16x8*)(xp + (((par) * 8 + pw) * 2 + 1) * 1024 + lane * 16); \
        SM_DECIDE(parX, alX); \
        const bf16x8 pa0 = c ? g0_ : f0, pa1 = c ? g1_ : f1, pa2 = c ? f0 : g0_, pa3 = c ? f1 : g1_; SBAR2(); \
        PV2_D0(VB, 0); SBAR2(); SM_EXP4(PX, 0); SBAR2(); PV2_D0(VB, 1); SBAR2(); SM_EXP4(PX, 4); SBAR2(); \
        PV2_D0(VB, 2); SBAR2(); SM_EXP4(PX, 8); SBAR2(); PV2_D0(VB, 3); SBAR2(); SM_EXP4(PX, 12); SBAR2(); } while (0)
    float pmx, mnL;
    __syncthreads();
    QKT2(pA, 0); MASKMAX(pA, 0, 0);
    __syncthreads();
    SOFTMAX(pA, 0, alA);
#define STEP2(PX, alX, PY, alY, t, KB, VB) do { \
        SBAR2(); QKT2F(PX, KB, PY, alY, VB); \
        MASKMAX(PX, t, KB); \
        __syncthreads(); \
        if ((t) + 1 < NT) { KWRITE(VB); if ((t) + 2 < NT) KLOAD(((t) + 2) * KVBLK); } \
        PVSM(VB, VB, PX, KB, alX); \
        __syncthreads(); \
        if ((t) + 1 < NT) { VWRITE(VB); if ((t) + 2 < NT) VLOAD(((t) + 2) * KVBLK); } \
        RESC2(alX); } while (0)
    for (int t = 1; t + 1 < NT; t += 2) {
        STEP2(pB, alB, pA, alA, t, 1, 0);
        STEP2(pA, alA, pB, alB, t + 1, 0, 1);
    }
    STEP2(pB, alB, pA, alA, NT - 1, 1, 0);
    FINISH(pB, alB, 1);
    if (hi == 0) xl[wave * 32 + r32] = l_reg;
    __syncthreads();
    PVALL(1, 1);
    l_reg += xl[pw * 32 + r32];
    if (hi == 0) li_l[r32] = l_reg; asm volatile("s_waitcnt lgkmcnt(0)" ::: "memory");
    float rli[16];
#pragma unroll
    for (int r = 0; r < 16; ++r) rli[r] = __builtin_amdgcn_rcpf(li_l[crow(r, hi)]);
    { char* stg = lds + (wave < 4 ? L_V + wave * 8192 : L_K + (wave - 4) * 8192);
      unsigned soff = (unsigned)(4 * hi * 256 + r32 * 2); asm volatile("" : "+v"(soff));
#pragma unroll
      for (int r = 0; r < 16; ++r) { const unsigned orow = (unsigned)((r & 3) + 8 * (r >> 2));
#pragma unroll
          for (int d0 = 0; d0 < 4; ++d0) *(bf16*)(stg + soff + orow * 256u + d0 * 64u) = __float2bfloat16(o[d0][r] * rli[r]); }
      asm volatile("s_waitcnt lgkmcnt(0)" ::: "memory");
      char* Ow = (char*)(cur.O + (size_t)(rg * QBLK) * POUT + c * 128);
      unsigned roff = (unsigned)((lane >> 4) * 256 + (lane & 15) * 16), goff = (unsigned)((lane >> 4) * (POUT * 2) + (lane & 15) * 16); asm volatile("" : "+v"(roff), "+v"(goff));
#pragma unroll
      for (int i = 0; i < 8; ++i) { const u32x4 v = *(const u32x4*)(stg + roff + i * 1024u); *(u32x4*)(Ow + goff + (unsigned)i * (4u * POUT * 2u)) = v; } }
    __syncthreads();
#undef LD16
#undef KLOAD
#undef VLOAD
#undef KWRITE
#undef VWRITE
#undef QKT2
#undef MASKMAX
#undef SOFTMAX
#undef PK4B
#undef FINISH
#undef TRRD2
#undef PV2_D0
#undef PVALL
#undef RESC2
#undef STEP2
#undef QKT2F
#undef SM_DECIDE
#undef SM_EXP4
#undef PVSM
}
__device__ __forceinline__ BlockRef2 make_ref2(int L, int pass, const bf16* PROJ, bf16* O16) {
    const int xcd = L & 7, kk = L >> 3, p = xcd * 2 + (kk & 1), x = kk >> 1;
    const int qb = pass ? 127 - x : x;
    const int b = p >> 3, h = (p >> 1) & 3, m = p & 1;
    const size_t rb = (size_t)b * SEQ;
    BlockRef2 r;
    const bf16* hb = PROJ + (size_t)b * 24 * HSTR;
    r.Q = hb + (size_t)(h * 2 + m) * HSTR + (size_t)qb * QB2 * PH;
    r.K = hb + (size_t)(8 + h * 2 + m) * HSTR;
    r.V = hb + (size_t)(16 + h * 2) * HSTR;
    r.O = O16 + (rb + (size_t)qb * QB2) * POUT + h * 512 + m * 256;
    r.P0 = qb * QB2;
    return r;
}
__device__ __forceinline__ void attn_phase2(char* lds, const bf16* PROJ, bf16* O16, int G, int w, int wave) {
    for (int L = w; L < 1024; L += G)
        for (int pass = 0; pass < 2; ++pass) { const BlockRef2 cur = make_ref2(L, pass, PROJ, O16); block2(cur, lds, wave); }
}
#undef KSWZ2
#undef SBAR2
}

constexpr size_t MiB = 1u << 20;
constexpr size_t WS_WIN = 1 * MiB;
constexpr size_t WS_WO = 17 * MiB;
constexpr size_t WS_WQX = 25 * MiB;
constexpr size_t WS_WKV = 33 * MiB;
constexpr size_t WS_WOX = 49 * MiB;
constexpr size_t WS_WGU = 57 * MiB;
constexpr size_t WS_WDN = 101 * MiB;
constexpr size_t WS_WPOOL = 123 * MiB;
constexpr size_t WS_MN = 124 * MiB;
constexpr size_t WS_KX = 126 * MiB;
constexpr size_t WS_VXT = 128 * MiB;
constexpr size_t WS_HN = 144 * MiB;
constexpr size_t WS_PROJ = 272 * MiB;
constexpr size_t WS_O16 = 528 * MiB;
constexpr size_t WS_POOLED = 656 * MiB;
constexpr size_t WS_CONCAT = 720 * MiB;
constexpr size_t WS_QX = 272 * MiB;
constexpr size_t WS_PSC = 400 * MiB;
constexpr size_t WS_OX = 528 * MiB;
constexpr size_t WS_HID = 272 * MiB;
constexpr size_t WS_XB = 848 * MiB;
constexpr size_t WS_WQK = 130 * MiB;
constexpr size_t WS_WINU = 138 * MiB;
constexpr size_t WS_SSP = 656 * MiB;
constexpr size_t WS_VWT = 976 * MiB;
constexpr size_t WS_END = 984 * MiB;

constexpr int LDS_BYTES = 147456;
constexpr int XL_OFF = 131072;
constexpr int NPHASE = 14;

typedef unsigned short bf16r;
typedef float f32x4 __attribute__((ext_vector_type(4)));
typedef unsigned v4u __attribute__((ext_vector_type(4)));
typedef unsigned v2u __attribute__((ext_vector_type(2)));
#define LAS __attribute__((address_space(3)))

__device__ __forceinline__ unsigned f2bf(float f) { unsigned u = __builtin_bit_cast(unsigned, f); return (u + 0x7fffu + ((u >> 16) & 1u)) >> 16; }
__device__ __forceinline__ unsigned pk2(float lo, float hi) { return f2bf(lo) | (f2bf(hi) << 16); }
__device__ __forceinline__ float bf2f(unsigned short b) { return __builtin_bit_cast(float, (unsigned)b << 16); }
__device__ __forceinline__ float wave_sum(float v) {
#pragma unroll
    for (int o = 1; o < 64; o <<= 1) v += __shfl_xor(v, o);
    return v;
}

__device__ __forceinline__ void transpose_item(const float* W, int N, bf16r* WT, int ldt, int k0, int n0, int drow0, LAS float* scr, int lane, const float* gn = nullptr, const float* gk = nullptr) {
    const float gg = gn ? gn[n0 + (lane & 31)] : 1.f;
#pragma unroll 8
    for (int i = 0; i < 32; ++i) { const int kk = 2 * i + (lane >> 5); const float g2 = gk ? gk[k0 + kk] : 1.f; scr[kk * 33 + (lane & 31)] = W[(size_t)(k0 + kk) * N + n0 + (lane & 31)] * (gg * g2); }
    asm volatile("s_waitcnt lgkmcnt(0)" ::: "memory");
    const int c = lane & 7;
#pragma unroll
    for (int j = 0; j < 4; ++j) { const int n = (lane >> 3) + 8 * j; const LAS float* s = scr + (8 * c) * 33 + n;
        v4u o; o.x = pk2(s[0 * 33], s[1 * 33]); o.y = pk2(s[2 * 33], s[3 * 33]); o.z = pk2(s[4 * 33], s[5 * 33]); o.w = pk2(s[6 * 33], s[7 * 33]);
        *(v4u*)(WT + (size_t)(drow0 + n) * ldt + k0 + 8 * c) = o; }
    asm volatile("s_waitcnt lgkmcnt(0)" ::: "memory");
}
__device__ __forceinline__ void rms_row_bf16(const float* xrow, const float* g, bf16r* orow, int lane) {
    const f32x4* xr = (const f32x4*)xrow + lane; const f32x4* gr = (const f32x4*)g + lane;
    f32x4 v[8]; float s = 0.f;
#pragma unroll
    for (int j = 0; j < 8; ++j) { v[j] = xr[64 * j]; s += (v[j].x * v[j].x + v[j].y * v[j].y) + (v[j].z * v[j].z + v[j].w * v[j].w); }
    const float rstd = rsqrtf(wave_sum(s) * (1.f / DM) + EPS);
    v2u* o8 = (v2u*)orow + lane;
#pragma unroll
    for (int j = 0; j < 8; ++j) { const f32x4 gg = gr[64 * j]; v2u w; w.x = pk2(v[j].x * rstd * gg.x, v[j].y * rstd * gg.y); w.y = pk2(v[j].z * rstd * gg.z, v[j].w * rstd * gg.w); o8[64 * j] = w; }
}
__device__ __forceinline__ void rms_rowb_bf16(const bf16r* xrow, const float* g, bf16r* orow, int lane) {
    const v4u* xr = (const v4u*)xrow + lane; const f32x4* gr = (const f32x4*)g + 2 * lane;
    float v[4][8]; float s = 0.f;
#pragma unroll
    for (int j = 0; j < 4; ++j) { const v4u w = xr[64 * j];
#pragma unroll
        for (int e = 0; e < 4; ++e) { v[j][2 * e] = __builtin_bit_cast(float, w[e] << 16); v[j][2 * e + 1] = __builtin_bit_cast(float, w[e] & 0xffff0000u); }
#pragma unroll
        for (int e = 0; e < 8; ++e) s += v[j][e] * v[j][e]; }
    const float rstd = rsqrtf(wave_sum(s) * (1.f / DM) + EPS);
    v4u* o8 = (v4u*)orow + lane;
#pragma unroll
    for (int j = 0; j < 4; ++j) { const f32x4 g0 = gr[128 * j], g1 = gr[128 * j + 1]; v4u w;
        w.x = pk2(v[j][0] * rstd * g0.x, v[j][1] * rstd * g0.y); w.y = pk2(v[j][2] * rstd * g0.z, v[j][3] * rstd * g0.w);
        w.z = pk2(v[j][4] * rstd * g1.x, v[j][5] * rstd * g1.y); w.w = pk2(v[j][6] * rstd * g1.z, v[j][7] * rstd * g1.w); o8[64 * j] = w; }
}
__device__ __forceinline__ void rms_rowb_f32(const bf16r* xrow, const float* g, float* orow, int lane) {
    const v4u* xr = (const v4u*)xrow + lane; const f32x4* gr = (const f32x4*)g + 2 * lane;
    float v[4][8]; float s = 0.f;
#pragma unroll
    for (int j = 0; j < 4; ++j) { const v4u w = xr[64 * j];
#pragma unroll
        for (int e = 0; e < 4; ++e) { v[j][2 * e] = __builtin_bit_cast(float, w[e] << 16); v[j][2 * e + 1] = __builtin_bit_cast(float, w[e] & 0xffff0000u); }
#pragma unroll
        for (int e = 0; e < 8; ++e) s += v[j][e] * v[j][e]; }
    const float rstd = rsqrtf(wave_sum(s) * (1.f / DM) + EPS);
    f32x4* o4 = (f32x4*)orow + 2 * lane;
#pragma unroll
    for (int j = 0; j < 4; ++j) { const f32x4 g0 = gr[128 * j], g1 = gr[128 * j + 1];
        o4[128 * j] = (f32x4){v[j][0] * rstd * g0.x, v[j][1] * rstd * g0.y, v[j][2] * rstd * g0.z, v[j][3] * rstd * g0.w};
        o4[128 * j + 1] = (f32x4){v[j][4] * rstd * g1.x, v[j][5] * rstd * g1.y, v[j][6] * rstd * g1.z, v[j][7] * rstd * g1.w}; }
}
template <int R> __device__ __forceinline__ void rms_rows_f32_to_bf16(const float* __restrict__ X, const float* __restrict__ g, bf16r* __restrict__ O, int m0, int lane) {
    f32x4 v[R][8]; float ss[R];
#pragma unroll
    for (int r = 0; r < R; ++r) { const f32x4* xr = (const f32x4*)(X + (size_t)(m0 + r) * DM) + lane;
#pragma unroll
        for (int j = 0; j < 8; ++j) v[r][j] = xr[64 * j]; }
#pragma unroll
    for (int r = 0; r < R; ++r) { float s = 0.f;
#pragma unroll
        for (int j = 0; j < 8; ++j) s += (v[r][j].x * v[r][j].x + v[r][j].y * v[r][j].y) + (v[r][j].z * v[r][j].z + v[r][j].w * v[r][j].w);
        ss[r] = s; }
#pragma unroll
    for (int o = 1; o < 64; o <<= 1) {
#pragma unroll
        for (int r = 0; r < R; ++r) ss[r] += __shfl_xor(ss[r], o); }
    const f32x4* gr = (const f32x4*)g + lane;
#pragma unroll
    for (int j = 0; j < 8; ++j) { const f32x4 gg = gr[64 * j];
#pragma unroll
        for (int r = 0; r < R; ++r) { const float rstd = rsqrtf(ss[r] * (1.f / DM) + EPS); v2u w;
            w.x = pk2(v[r][j].x * rstd * gg.x, v[r][j].y * rstd * gg.y); w.y = pk2(v[r][j].z * rstd * gg.z, v[r][j].w * rstd * gg.w);
            ((v2u*)(O + (size_t)(m0 + r) * DM) + lane)[64 * j] = w; } }
}
template <int R, bool OUT_F32> __device__ __forceinline__ void rms_rows_bf16(const bf16r* __restrict__ X, const float* __restrict__ g, void* __restrict__ O, int m0, int lane) {
    v4u w[R][4]; float ss[R];
#pragma unroll
    for (int r = 0; r < R; ++r) { const v4u* xr = (const v4u*)(X + (size_t)(m0 + r) * DM) + lane;
#pragma unroll
        for (int j = 0; j < 4; ++j) w[r][j] = xr[64 * j]; }
#pragma unroll
    for (int r = 0; r < R; ++r) { float s = 0.f;
#pragma unroll
        for (int j = 0; j < 4; ++j)
#pragma unroll
            for (int e = 0; e < 4; ++e) { const float a = __builtin_bit_cast(float, w[r][j][e] << 16), b = __builtin_bit_cast(float, w[r][j][e] & 0xffff0000u); s += a * a + b * b; }
        ss[r] = s; }
#pragma unroll
    for (int o = 1; o < 64; o <<= 1) {
#pragma unroll
        for (int r = 0; r < R; ++r) ss[r] += __shfl_xor(ss[r], o); }
    const f32x4* gr = (const f32x4*)g + 2 * lane;
#pragma unroll
    for (int j = 0; j < 4; ++j) { const f32x4 g0 = gr[128 * j], g1 = gr[128 * j + 1];
#pragma unroll
        for (int r = 0; r < R; ++r) { const float rstd = rsqrtf(ss[r] * (1.f / DM) + EPS); float v[8];
#pragma unroll
            for (int e = 0; e < 4; ++e) { v[2 * e] = __builtin_bit_cast(float, w[r][j][e] << 16) * rstd; v[2 * e + 1] = __builtin_bit_cast(float, w[r][j][e] & 0xffff0000u) * rstd; }
            if constexpr (OUT_F32) { f32x4* o4 = (f32x4*)((float*)O + (size_t)(m0 + r) * DM) + 2 * lane;
                o4[128 * j] = (f32x4){v[0] * g0.x, v[1] * g0.y, v[2] * g0.z, v[3] * g0.w}; o4[128 * j + 1] = (f32x4){v[4] * g1.x, v[5] * g1.y, v[6] * g1.z, v[7] * g1.w}; }
            else { v4u q; q.x = pk2(v[0] * g0.x, v[1] * g0.y); q.y = pk2(v[2] * g0.z, v[3] * g0.w); q.z = pk2(v[4] * g1.x, v[5] * g1.y); q.w = pk2(v[6] * g1.z, v[7] * g1.w);
                ((v4u*)((bf16r*)O + (size_t)(m0 + r) * DM) + lane)[64 * j] = q; } } }
}
__device__ __forceinline__ void rms_row_f32_inplace(float* xrow, const float* g, int lane) {
    f32x4* xr = (f32x4*)xrow + lane; const f32x4* gr = (const f32x4*)g + lane;
    f32x4 v[8]; float s = 0.f;
#pragma unroll
    for (int j = 0; j < 8; ++j) { v[j] = xr[64 * j]; s += (v[j].x * v[j].x + v[j].y * v[j].y) + (v[j].z * v[j].z + v[j].w * v[j].w); }
    const float rstd = rsqrtf(wave_sum(s) * (1.f / DM) + EPS);
#pragma unroll
    for (int j = 0; j < 8; ++j) { const f32x4 gg = gr[64 * j]; xr[64 * j] = (f32x4){v[j].x * rstd * gg.x, v[j].y * rstd * gg.y, v[j].z * rstd * gg.z, v[j].w * rstd * gg.w}; }
}

__device__ __forceinline__ void load_row_scales(LAS unsigned char* xl, const float* ssp, int pm0, int nM, int t) {
    LAS float* T = (LAS float*)(xl + 8192);
    for (int i = t; i < 1024; i += 512) { const int pm = pm0 + 8 * (i >> 8); float sum = 0.f;
        if (pm < nM) { const f32x4* q = (const f32x4*)(ssp + (size_t)(pm * 256 + (i & 255)) * 32);
#pragma unroll
            for (int j = 0; j < 8; ++j) { const f32x4 v = q[j]; sum += (v.x + v.y) + (v.z + v.w); } }
        T[i] = rsqrtf(sum * (1.f / DM) + EPS); }
    __syncthreads();
}
struct Args { const float* in[22]; float* out; unsigned char* ws; int ph_lo, ph_hi; };
typedef const __attribute__((address_space(4))) unsigned long long* karg_t;
__device__ __forceinline__ unsigned long long ldarg(int i) { karg_t p = (karg_t)__builtin_amdgcn_kernarg_segment_ptr(); asm volatile("" : "+s"(p) :: "memory"); return p[i]; }
#define GASP __attribute__((address_space(1)))
#define AIN(i) ((const float*)(GASP const float*)ldarg(i))
#define AOUT() ((float*)(GASP float*)ldarg(22))
#define AWS() ((unsigned char*)(GASP unsigned char*)ldarg(23))
#define WSP(off) ((bf16r*)(AWS() + (off)))

__global__ void __launch_bounds__(512) fwd_kernel(Args a) {
    extern __shared__ __attribute__((aligned(16))) unsigned char lds[];
    LAS unsigned char* ldsl = (LAS unsigned char*)lds;
    const int wave = __builtin_amdgcn_readfirstlane((int)threadIdx.x >> 6);
#define lane ((int)__builtin_amdgcn_mbcnt_hi(~0u, __builtin_amdgcn_mbcnt_lo(~0u, 0u)))
#define tid (wave * 64 + lane)
    const int G = gridDim.x, bx = blockIdx.x;
    const int gw = bx * 8 + wave, NGW = G * 8;
    const int lo = a.ph_lo, hi = a.ph_hi; int nbar = 0;
#define IN(k) (lo <= (k) && (k) < hi)
#define CBAR() do { asm volatile("s_waitcnt vmcnt(0)" ::: "memory"); ++nbar; __syncthreads(); \
            if (tid == 0) { unsigned* ctr = (unsigned*)AWS(); \
                __builtin_amdgcn_fence(__ATOMIC_RELEASE, "agent"); asm volatile("s_waitcnt vmcnt(0)" ::: "memory"); \
                __hip_atomic_fetch_add(ctr, 1u, __ATOMIC_RELAXED, __HIP_MEMORY_SCOPE_AGENT); \
                const unsigned target = (unsigned)nbar * (unsigned)G; \
                while (__hip_atomic_load(ctr, __ATOMIC_RELAXED, __HIP_MEMORY_SCOPE_AGENT) < target) __builtin_amdgcn_s_sleep(2); \
                __builtin_amdgcn_fence(__ATOMIC_ACQUIRE, "agent"); asm volatile("s_waitcnt vmcnt(0)" ::: "memory"); } \
            __syncthreads(); } while (0)
#define SEAM(k) do { if (IN(k) && IN((k) + 1)) { if ((k) == 0) { asm volatile("s_waitcnt vmcnt(0)" ::: "memory"); cg::this_grid().sync(); } else { CBAR(); } } } while (0)

    if (lo == 0 && hi > 1 && bx == 0 && tid == 0) __hip_atomic_store((unsigned*)AWS(), 0u, __ATOMIC_RELAXED, __HIP_MEMORY_SCOPE_AGENT);
    if (IN(0)) {
        unsigned char* const ws_ = AWS(); bf16r* const WIN = (bf16r*)(ws_ + WS_WIN); bf16r* const WO = (bf16r*)(ws_ + WS_WO); bf16r* const WQX = (bf16r*)(ws_ + WS_WQX); bf16r* const WKV = (bf16r*)(ws_ + WS_WKV); bf16r* const WOX = (bf16r*)(ws_ + WS_WOX); bf16r* const WGU = (bf16r*)(ws_ + WS_WGU); bf16r* const WDN = (bf16r*)(ws_ + WS_WDN); bf16r* const WPOOL = (bf16r*)(ws_ + WS_WPOOL); bf16r* const MN = (bf16r*)(ws_ + WS_MN); bf16r* const HN = (bf16r*)(ws_ + WS_HN);

        LAS float* scr = (LAS float*)(ldsl + wave * 16384);
        constexpr int I_IN = 32 * 128, I_SQ = 32 * 64, I_KV = 32 * 128, I_G = 32 * 176, I_DN = 88 * 64, I_P = 4 * 4 * 8;
        constexpr int NITEMS = I_IN + 3 * I_SQ + I_KV + 2 * I_G + I_DN + I_P;
        for (int it = gw; it < NITEMS; it += NGW) {
            int r = it;
            if (r < I_IN) { const int kb = r / 128, nb = r % 128; if (nb < 96) transpose_item(AIN(3), DIN, WIN, DM, 64 * kb, 32 * nb, 32 * nb, scr, lane); continue; } r -= I_IN;
            if (r < I_SQ) { const int kb = r / 64, nb = r % 64; transpose_item(AIN(11), DM, WO, DM, 64 * kb, 32 * nb, 32 * nb, scr, lane); continue; } r -= I_SQ;
            if (r < I_SQ) { continue; } r -= I_SQ;
            if (r < I_KV) { const int kb = r / 128, nb = r % 128; transpose_item(AIN(15), 2 * DM, WKV, DM, 64 * kb, 32 * nb, 32 * nb, scr, lane); continue; } r -= I_KV;
            if (r < I_SQ) { const int kb = r / 64, nb = r % 64; transpose_item(AIN(16), DM, WOX, DM, 64 * kb, 32 * nb, 32 * nb, scr, lane); continue; } r -= I_SQ;
            if (r < I_G) { const int kb = r / 176, nb = r % 176, n0 = 32 * nb; transpose_item(AIN(18), DFF, WGU, DM, 64 * kb, n0, 256 * (n0 >> 7) + (n0 & 127), scr, lane, nullptr, AIN(17)); continue; } r -= I_G;
            if (r < I_G) { const int kb = r / 176, nb = r % 176, n0 = 32 * nb; transpose_item(AIN(19), DFF, WGU, DM, 64 * kb, n0, 256 * (n0 >> 7) + 128 + (n0 & 127), scr, lane, nullptr, AIN(17)); continue; } r -= I_G;
            if (r < I_DN) { const int kb = r / 64, nb = r % 64; transpose_item(AIN(20), DM, WDN, DFF, 64 * kb, 32 * nb, 32 * nb, scr, lane); continue; } r -= I_DN;
            { const int gidx = r / 32, q = r % 32, kb = q / 8, nb = q % 8; transpose_item(AIN(9) + (size_t)gidx * 65536, 256, WPOOL + (size_t)gidx * 65536, 256, 64 * kb, 32 * nb, 32 * nb, scr, lane, AIN(10) + gidx * 256); }
        }
        { const float* win = AIN(3); bf16r* winu = (bf16r*)(ws_ + WS_WINU);
          for (int i = bx * 512 + tid; i < DM * 1024 / 8; i += G * 512) { const int k = i >> 7, j8 = (i & 127) * 8; const f32x4* sp = (const f32x4*)(win + (size_t)k * DIN + 3072 + j8);
              const f32x4 a0 = sp[0], a1 = sp[1]; v4u w; w.x = pk2(a0.x, a0.y); w.y = pk2(a0.z, a0.w); w.z = pk2(a1.x, a1.y); w.w = pk2(a1.z, a1.w); *(v4u*)(winu + (size_t)k * 1024 + j8) = w; } }
        { const f32x4* src = (const f32x4*)AIN(14); v4u* dst = (v4u*)WQX;
          const float* gxa = AIN(12);
          for (int i = bx * 512 + tid; i < DM * DM / 8; i += G * 512) { const float gk_ = gxa[i >> 8]; const f32x4 a0 = src[2 * i] * gk_, a1 = src[2 * i + 1] * gk_; v4u w; w.x = pk2(a0.x, a0.y); w.y = pk2(a0.z, a0.w); w.z = pk2(a1.x, a1.y); w.w = pk2(a1.z, a1.w); dst[i] = w; } }
        { const float* xin = AIN(0); const float* gin = AIN(2); for (int m = gw * 4; m < M; m += NGW * 4) rms_rows_f32_to_bf16<4>(xin, gin, HN, m, lane); }
        for (int m = gw; m < BATCH * MEM; m += NGW) rms_row_bf16(AIN(1) + (size_t)m * DM, AIN(13), MN + (size_t)m * DM, lane);
        __syncthreads();
    }
    SEAM(0);
    if (IN(1)) {
        unsigned char* const ws_ = AWS(); bf16r* const HN = (bf16r*)(ws_ + WS_HN); bf16r* const WIN = (bf16r*)(ws_ + WS_WIN); bf16r* const PROJ = (bf16r*)(ws_ + WS_PROJ);

        {
            pg8::Gemm gf{(bf16r*)(ws_ + WS_WPOOL), (bf16r*)(ws_ + WS_WINU), 256, 1024, 256, 1, 65536, 0, 256, 0}; pg8::BatchOrder Sf; Sf.init(256, DM, 4, G, bx);
            pg8::EpiBf16 Ef{WIN + (size_t)3072 * DM, DM, 1, (long)256 * DM, 0, nullptr, 0};
            pg8::gemm_phase<pg8::EpiBf16, pg8::BatchOrder, true>(ldsl, ldsl + XL_OFF, gf, Sf, Ef);
            CBAR();
        }
        pg8::Gemm g{HN, WIN, DM, DM, DM, 1, 0, 0, 0, 0}; pg8::StaticOrder S; S.init(M, DIN, G, bx);
        pg8::EpiProj E{PROJ, PROJ + (size_t)192 * 1024 * 1024 / 2};
        pg8::gemm_phase<pg8::EpiProj, pg8::StaticOrder, true>(ldsl, ldsl + XL_OFF, g, S, E);
    }
    SEAM(1);
    if (IN(1) && IN(2)) { for (int ps_ = 0; ps_ < PROBE_SEAMS; ++ps_) CBAR(); }
    if (IN(2)) {
        unsigned char* const ws_ = AWS(); bf16r* const PROJ = (bf16r*)(ws_ + WS_PROJ); bf16r* const POOLED = (bf16r*)(ws_ + WS_POOLED); bf16r* const O16 = (bf16r*)(ws_ + WS_O16);

        {
            constexpr int RUN = 32;
            const int ntask = (M / RUN) * 128;
            for (int task = bx * 512 + tid; task < ntask; task += G * 512) {
                const int c8 = task & 127, token0 = (task >> 7) * RUN, t0 = token0 & (SEQ - 1);
                const int wl = 2 << (c8 >> 5);
                const bf16r* up = PROJ + (size_t)192 * 1024 * 1024 / 2 + (size_t)token0 * 1024 + c8 * 8;
                bf16r* op = (bf16r*)(ws_ + WS_CONCAT) + (size_t)token0 * DM + 1024 + c8 * 8;
                float sacc[8];
#pragma unroll
                for (int e = 0; e < 8; ++e) sacc[e] = 0.f;
                for (int j = 1; j < wl; ++j) if (t0 - j >= 0) { const v4u w = *(const v4u*)(up - (size_t)j * 1024);
#pragma unroll
                    for (int e = 0; e < 4; ++e) { sacc[2 * e] += __builtin_bit_cast(float, w[e] << 16); sacc[2 * e + 1] += __builtin_bit_cast(float, w[e] & 0xffff0000u); } }
#pragma unroll 4
                for (int i = 0; i < RUN; ++i) {
                    const v4u w = *(const v4u*)(up + (size_t)i * 1024);
                    const int t = t0 + i; const bool full = (t + 1 >= wl);
                    const v4u wo = *(const v4u*)(up + (size_t)(full ? i - (wl - 1) : i) * 1024);
                    float u0[8];
#pragma unroll
                    for (int e = 0; e < 4; ++e) { u0[2 * e] = __builtin_bit_cast(float, w[e] << 16); u0[2 * e + 1] = __builtin_bit_cast(float, w[e] & 0xffff0000u); }
#pragma unroll
                    for (int e = 0; e < 8; ++e) sacc[e] += u0[e];
                    const float ic = 1.0f / (float)(full ? wl : t + 1);
                    v4u o;
#pragma unroll
                    for (int e = 0; e < 4; ++e) o[e] = pk2(sacc[2 * e] * ic - u0[2 * e], sacc[2 * e + 1] * ic - u0[2 * e + 1]);
                    *(v4u*)(op + (size_t)i * DM) = o;
                    if (full) {
#pragma unroll
                        for (int e = 0; e < 4; ++e) { sacc[2 * e] -= __builtin_bit_cast(float, wo[e] << 16); sacc[2 * e + 1] -= __builtin_bit_cast(float, wo[e] & 0xffff0000u); } }
                }
            }
        }
        __syncthreads();
        att2::attn_phase2((char*)lds, (const att::bf16*)PROJ, (att::bf16*)O16, G, bx, wave);
        __syncthreads();
    }
    SEAM(2);
    if (IN(3)) {
        unsigned char* const ws_ = AWS(); bf16r* const O16 = (bf16r*)(ws_ + WS_O16); bf16r* const CONCAT = (bf16r*)(ws_ + WS_CONCAT); bf16r* const POOLED = (bf16r*)(ws_ + WS_POOLED); bf16r* const WPOOL = (bf16r*)(ws_ + WS_WPOOL); bf16r* const MN = (bf16r*)(ws_ + WS_MN); bf16r* const WKV = (bf16r*)(ws_ + WS_WKV); bf16r* const KX = (bf16r*)(ws_ + WS_KX); bf16r* const VXT = (bf16r*)(ws_ + WS_VXT);

        {
            const float* lq1 = AIN(4); const float* lk1 = AIN(5); const float* lq2 = AIN(6); const float* lk2 = AIN(7); const float* subln = AIN(8);
            const float s1 = wave_sum(lq1[lane] * lk1[lane] + lq1[lane + 64] * lk1[lane + 64]);
            const float s2 = wave_sum(lq2[lane] * lk2[lane] + lq2[lane + 64] * lk2[lane + 64]);
            const float lam = __expf(s1) - __expf(s2) + LAM_INIT;
            const f32x4 sg = *((const f32x4*)subln + lane);
            for (int m = gw; m < M; m += NGW) {
                const bf16r* orow = O16 + (size_t)m * 2048; bf16r* crow_ = CONCAT + (size_t)m * 2048;
#pragma unroll
                for (int h = 0; h < 4; ++h) {
                    const v2u w1 = *(const v2u*)(orow + h * 512 + 4 * lane), w2 = *(const v2u*)(orow + h * 512 + 256 + 4 * lane);
                    float d[4];
                    d[0] = __builtin_bit_cast(float, w1.x << 16) - lam * __builtin_bit_cast(float, w2.x << 16);
                    d[1] = __builtin_bit_cast(float, w1.x & 0xffff0000u) - lam * __builtin_bit_cast(float, w2.x & 0xffff0000u);
                    d[2] = __builtin_bit_cast(float, w1.y << 16) - lam * __builtin_bit_cast(float, w2.y << 16);
                    d[3] = __builtin_bit_cast(float, w1.y & 0xffff0000u) - lam * __builtin_bit_cast(float, w2.y & 0xffff0000u);
                    const float ss = wave_sum((d[0] * d[0] + d[1] * d[1]) + (d[2] * d[2] + d[3] * d[3]));
                    const float rstd = rsqrtf(ss * (1.f / 256.f) + EPS) * (1.0f - LAM_INIT);
                    v2u o; o.x = pk2(d[0] * rstd * sg.x, d[1] * rstd * sg.y); o.y = pk2(d[2] * rstd * sg.z, d[3] * rstd * sg.w);
                    *(v2u*)(crow_ + h * 256 + 4 * lane) = o;
                }
            }
        }
        __syncthreads();
        {
            pg8::Gemm g{MN, WKV, DM, DM, DM, 1, 0, 0, 0, 0}; pg8::StaticOrder S; S.init(BATCH * MEM, 2 * DM, G, bx);
            pg8::EpiBf16 E{KX, 2 * DM, 1, 0, 0, nullptr, 0};
            pg8::gemm_phase<pg8::EpiBf16, pg8::StaticOrder, true>(ldsl, ldsl + XL_OFF, g, S, E);
        }
    }
    SEAM(3);
    if (IN(4)) {
        unsigned char* const ws_ = AWS(); bf16r* const CONCAT = (bf16r*)(ws_ + WS_CONCAT); bf16r* const WO = (bf16r*)(ws_ + WS_WO); float* const xres = AOUT();

        pg8::Gemm g{CONCAT, WO, DM, DM, DM, 1, 0, 0, 0, 0}; pg8::StaticOrder S; S.init(M, DM, G, bx);
        pg8::EpiResX<false, true> E{AIN(0), ws_ + WS_XB, DM, (float*)(ws_ + WS_SSP)};
        pg8::gemm_phase<pg8::EpiResX<false, true>, pg8::StaticOrder, true>(ldsl, ldsl + XL_OFF, g, S, E);
    }
    SEAM(4);
    if (IN(5)) {
        unsigned char* const ws_ = AWS(); bf16r* const HN = (bf16r*)(ws_ + WS_HN); float* const xres = AOUT();
        bf16r* const KV = (bf16r*)(ws_ + WS_KX); bf16r* const WQN = (bf16r*)(ws_ + WS_WQX); bf16r* const WOXt = (bf16r*)(ws_ + WS_WOX);
        __syncthreads();
        {   pg8::Gemm g{KV, WQN, 2 * DM, DM, 512, 4, (long)MEM * 2 * DM, 512, 0, 512}; pg8::BatchOrder S; S.init(MEM, DM, 8, G, bx);
            pg8::EpiBf16 E{(bf16r*)(ws_ + WS_WQK), DM, 4, (long)1024 * DM, (long)MEM * DM, nullptr, 0};
            pg8::gemm_phase<pg8::EpiBf16, pg8::BatchOrder, true>(ldsl, ldsl + XL_OFF, g, S, E); }
        {   pg8::Gemm g{WOXt, KV + 2048, DM, 2 * DM, 512, 4, 0, 512, (long)MEM * 2 * DM, 512}; pg8::BatchOrder S; S.init(DM, MEM, 8, G, G - 1 - bx);
            pg8::EpiBf16 E{(bf16r*)(ws_ + WS_VWT), 1024, 4, (long)DM * 1024, MEM, nullptr, 0};
            pg8::gemm_phase<pg8::EpiBf16, pg8::BatchOrder, true>(ldsl, ldsl + XL_OFF, g, S, E); }
    }
    SEAM(5);
    if (IN(6)) {
        unsigned char* const ws_ = AWS(); bf16r* const HN = (bf16r*)(ws_ + WS_HN); bf16r* const PSC = (bf16r*)(ws_ + WS_PSC);
        pg8::Gemm g{(const bf16r*)(ws_ + WS_XB), (bf16r*)(ws_ + WS_WQK), DM, DM, DM, 1, 0, 0, (long)1024 * DM, 0}; pg8::StaticOrderZ S; S.init(M, 1024, G, bx); S.zdiv = SEQ / 256;
        pg8::Unit u0; const int pm0 = S.next(0, u0) ? u0.pm : 0;
        load_row_scales(ldsl + XL_OFF, (const float*)(ws_ + WS_SSP), pm0, M / 256, tid);
        pg8::EpiSoftmax E{PSC, 0, 0.044194173824159216f * 1.4426950408889634f, 1024, pm0};
        pg8::gemm_phase<pg8::EpiSoftmax, pg8::StaticOrderZ, true>(ldsl, ldsl + XL_OFF, g, S, E);
    }
    SEAM(6);
    if (IN(9)) {
        unsigned char* const ws_ = AWS(); bf16r* const PSC = (bf16r*)(ws_ + WS_PSC);
        pg8::Gemm g{PSC, (bf16r*)(ws_ + WS_VWT), 1024, 1024, 1024, 1, 0, 0, (long)DM * 1024, 0}; pg8::StaticOrderZ S; S.init(M, DM, G, bx); S.zdiv = SEQ / 256;
        pg8::EpiResX<true, true> E{ws_ + WS_XB, ws_ + WS_XB, DM, (float*)(ws_ + WS_SSP) + (size_t)M * 32};
        pg8::gemm_phase<pg8::EpiResX<true, true>, pg8::StaticOrderZ, true>(ldsl, ldsl + XL_OFF, g, S, E);
    }
    SEAM(9);
    if (IN(11)) {
        unsigned char* const ws_ = AWS(); bf16r* const HN = (bf16r*)(ws_ + WS_HN); bf16r* const WGU = (bf16r*)(ws_ + WS_WGU); bf16r* const HID = (bf16r*)(ws_ + WS_HID);

        pg8::Gemm g{(const bf16r*)(ws_ + WS_XB), WGU, DM, DM, DM, 1, 0, 0, 0, 0}; pg8::StaticOrder S; S.init(M, 2 * DFF, G, bx);
        pg8::Unit u0; const int pm0 = S.next(0, u0) ? u0.pm : 0;
        load_row_scales(ldsl + XL_OFF, (const float*)(ws_ + WS_SSP) + (size_t)M * 32, pm0, M / 256, tid);
        pg8::EpiSwiGLU E{HID, DFF, pm0};
        pg8::gemm_phase<pg8::EpiSwiGLU, pg8::StaticOrder, true>(ldsl, ldsl + XL_OFF, g, S, E);
    }
    SEAM(11);
    if (IN(12)) {
        unsigned char* const ws_ = AWS(); bf16r* const HID = (bf16r*)(ws_ + WS_HID); bf16r* const WDN = (bf16r*)(ws_ + WS_WDN); float* const xres = AOUT();

        pg8::Gemm g{HID, WDN, DFF, DFF, DFF, 1, 0, 0, 0, 0}; pg8::StaticOrder S; S.init(M, DM, G, bx);
        pg8::EpiResX<true, true> E{ws_ + WS_XB, ws_ + WS_XB, DM, nullptr};
        pg8::gemm_phase<pg8::EpiResX<true, true>, pg8::StaticOrder, true>(ldsl, ldsl + XL_OFF, g, S, E);
    }
    SEAM(12);
    if (IN(13)) {
        unsigned char* const ws_ = AWS(); float* const xres = AOUT();
 { const float* gin = AIN(21); for (int m = gw * 4; m < M; m += NGW * 4) rms_rows_bf16<4, true>((const bf16r*)(ws_ + WS_XB), gin, xres, m, lane); } }
#undef IN
#undef SEAM
#undef lane
#undef tid
}

extern "C" void kernel_launch(void* const* d_in, const int* in_sizes, int n_in, void* d_out, int out_size, void* d_ws, size_t ws_size, hipStream_t stream) {
    static int grid = 0;
    if (grid == 0) {
        if (n_in != 22 || in_sizes[0] != M * DM || out_size != M * DM || ws_size < WS_END) {
            fprintf(stderr, "kernel_launch: unexpected shapes n_in %d in0 %d out %d ws %zu (need %zu)\n", n_in, n_in > 0 ? in_sizes[0] : -1, out_size, ws_size, (size_t)WS_END); grid = -1; return; }
        int dev = 0, cus = 0, per_cu = 0;
        (void)hipGetDevice(&dev); (void)hipDeviceGetAttribute(&cus, hipDeviceAttributeMultiprocessorCount, dev);
        if (hipFuncSetAttribute((const void*)fwd_kernel, hipFuncAttributeMaxDynamicSharedMemorySize, LDS_BYTES) != hipSuccess) { fprintf(stderr, "kernel_launch: hipFuncSetAttribute failed\n"); grid = -1; return; }
        if (hipOccupancyMaxActiveBlocksPerMultiprocessor(&per_cu, (const void*)fwd_kernel, 512, LDS_BYTES) != hipSuccess || per_cu < 1) { fprintf(stderr, "kernel_launch: occupancy query gave %d\n", per_cu); per_cu = 1; }
        (void)hipGetLastError();
        if (cus <= 0) cus = 256;
        grid = cus * per_cu;
        if (grid > 256) grid = 256;
    }
    if (grid < 0) return;
    Args a{};
    for (int i = 0; i < 22; ++i) a.in[i] = (const float*)d_in[i];
    a.out = (float*)d_out; a.ws = (unsigned char*)d_ws;
#if MK_PER_PHASE
    for (int p = 0; p < NPHASE; ++p) { a.ph_lo = p; a.ph_hi = p + 1; hipLaunchKernelGGL(fwd_kernel, dim3(grid), dim3(512), LDS_BYTES, stream, a); }
#else
    const int cuts[4] = {0, PROBE_DUP >= 0 ? PROBE_DUP + 1 : NPHASE, PROBE_DUP >= 0 ? PROBE_DUP + 1 : NPHASE, NPHASE};
    for (int li = 0; li < (PROBE_DUP >= 0 ? 3 : 1); ++li) {
        a.ph_lo = cuts[li]; a.ph_hi = cuts[li + 1];
        if (PROBE_DUP >= 0 && li == 1) { a.ph_lo = PROBE_DUP; a.ph_hi = PROBE_DUP + 1; }
        if (!(a.ph_lo == 0 && a.ph_hi > 1)) (void)hipMemsetAsync(d_ws, 0, 256, stream);
        void* args[] = {&a};
        hipError_t e = hipLaunchCooperativeKernel((const void*)fwd_kernel, dim3(grid), dim3(512), args, LDS_BYTES, stream);
        if (e != hipSuccess) fprintf(stderr, "cooperative launch failed: %s (grid %d)\n", hipGetErrorString(e), grid);
    }
#endif
}
```

```cpp
#include <hip/hip_runtime.h>
#include <hip/hip_bf16.h>
#include <hip/hip_cooperative_groups.h>
#include <cstdio>
#include <cstdint>
namespace cg = cooperative_groups;

#ifndef PROBE_DUP
#define PROBE_DUP -1
#endif
#ifndef PROBE_SEAMS
#define PROBE_SEAMS 0
#endif
#ifndef MK_PER_PHASE
#define MK_PER_PHASE 0
#endif

constexpr int BATCH = 2, SEQ = 16384, DM = 2048, MEM = 256, DIN = 4096, DFF = 5632;
constexpr int M = BATCH * SEQ;
constexpr float EPS = 1e-6f;
constexpr float LAM_INIT = 0.2f;

namespace pg8 {
#define PG8_LAS __attribute__((address_space(3)))
typedef unsigned short bf16_t;
typedef short bf16x8 __attribute__((ext_vector_type(8)));
typedef float f32x4 __attribute__((ext_vector_type(4)));
typedef unsigned u32x4 __attribute__((ext_vector_type(4)));
constexpr int BM = 256, BK = 64, HALF = 128, HTB = HALF * BK * 2, STAGE_BYTES = 8 * HTB, NXCD = 8, WGM = 8;

__host__ __device__ __forceinline__ int lds_byte(int r, int c) { const int st = (r >> 4) * 2 + (c >> 5), rr = r & 15, cc = c & 31, ob = rr * 64 + cc * 2; return st * 1024 + (ob ^ (((ob >> 9) & 1) << 5)); }
__host__ __device__ __forceinline__ void stage_rc(int b, int& R, int& C) { const int st = b / 1024, sb = b % 1024, swz = sb ^ (((sb >> 9) & 1) << 5); R = (st >> 1) * 16 + swz / 64; C = (st & 1) * 32 + (swz % 64) / 2; }
__host__ __device__ __forceinline__ int perm32(int rho) { const int n = rho >> 4, i = rho & 15; return 8 * (i >> 2) + 4 * n + (i & 3); }

struct Unit { int pm, pn, z; };
struct Gemm { const bf16_t* A; const bf16_t* Bt; int lda, ldb, K, ZH; long sAb, sAh, sBb, sBh; };

struct StaticOrder {
    int nM, nN, nwg, G, c;
    __device__ void init(int Mr, int N, int G_, int c_) { nM = Mr / BM; nN = N / BM; nwg = nM * nN; G = G_; c = c_; }
    __device__ bool next(int i, Unit& u) const {
        const long L = (long)i * G + c; if (L >= nwg) return false;
        int wgid = (int)L; { const int q = nwg / NXCD, r = nwg % NXCD, xcd = wgid % NXCD, off = wgid / NXCD; wgid = (xcd < r ? xcd * (q + 1) : r * (q + 1) + (xcd - r) * q) + off; }
        const int nig = WGM * nN, gid = wgid / nig, fm = gid * WGM, gsz = (nM - fm) < WGM ? (nM - fm) : WGM;
        u.pm = fm + ((wgid % nig) % gsz); u.pn = (wgid % nig) / gsz; u.z = 0; return true;
    }
};
struct StaticOrderZ : StaticOrder {
    int zdiv;
    __device__ bool next(int i, Unit& u) const { if (!StaticOrder::next(i, u)) return false; u.z = u.pm / zdiv; return true; }
};
struct BatchOrder {
    int nM, nN, nwg, G, c;
    __device__ void init(int Mr, int N, int Z, int G_, int c_) { nM = Mr / BM; nN = N / BM; nwg = nM * nN * Z; G = G_; c = c_; }
    __device__ bool next(int i, Unit& u) const {
        const long L = (long)i * G + c; if (L >= nwg) return false;
        int l = (int)L; u.pn = l % nN; l /= nN; u.pm = l % nM; u.z = l / nM; return true;
    }
};

__device__ __forceinline__ unsigned cvt_pk_bf16(float lo, float hi) { unsigned r; asm volatile("v_cvt_pk_bf16_f32 %0, %1, %2" : "=v"(r) : "v"(lo), "v"(hi)); return r; }

typedef f32x4 Acc[2][2][4][2];
__device__ __forceinline__ void row_scales8(float (&rs)[8], const PG8_LAS float* T, const float* ssp, int pm, int pm0, int rt) {
    const int dp = pm - pm0;
    if ((dp & 7) == 0 && (unsigned)dp < 32u) {
#pragma unroll
        for (int g = 0; g < 8; ++g) rs[g] = T[(dp >> 3) * 256 + (g >> 2) * HALF + (g & 3) * 16 + rt];
    } else {
#pragma unroll
        for (int g = 0; g < 8; ++g) { const f32x4* q = (const f32x4*)(ssp + (size_t)(pm * BM + (g >> 2) * HALF + (g & 3) * 16 + rt) * 32); float sum = 0.f;
#pragma unroll
            for (int j = 0; j < 8; ++j) { const f32x4 v = q[j]; sum += (v[0] + v[1]) + (v[2] + v[3]); }
            rs[g] = rsqrtf(sum * (1.f / 2048.f) + 1e-6f); }
    }
}

struct EpiBf16 {
    static constexpr bool PERM = true;
    bf16_t* O; int ldc, ZH; long sOb, sOh; const float* cscale; int nsc;
    __device__ __forceinline__ void operator()(Acc& acc, const Unit& u, int wr, int wc, int fr, int fq, PG8_LAS unsigned char*) const {
        const int row0 = u.pm * BM + wr * 64 + fr, col0 = u.pn * BM + wc * 32 + 8 * fq;
        bf16_t* base = O + (size_t)(u.z / ZH) * sOb + (size_t)(u.z % ZH) * sOh;
        f32x4 sv[2][2];
#pragma unroll
        for (int bj = 0; bj < 2; ++bj)
#pragma unroll
            for (int n = 0; n < 2; ++n) sv[bj][n] = cscale ? *(const f32x4*)(cscale + (size_t)u.z * nsc + col0 + bj * HALF + 4 * n) : (f32x4){1.f, 1.f, 1.f, 1.f};
#pragma unroll
        for (int ai = 0; ai < 2; ++ai)
#pragma unroll
            for (int m = 0; m < 4; ++m) { bf16_t* rowp = base + (size_t)(row0 + ai * HALF + m * 16) * ldc + col0;
#pragma unroll
                for (int bj = 0; bj < 2; ++bj) { f32x4 v0 = acc[ai][bj][m][0] * sv[bj][0], v1 = acc[ai][bj][m][1] * sv[bj][1];
                    u32x4 w; w.x = cvt_pk_bf16(v0[0], v0[1]); w.y = cvt_pk_bf16(v0[2], v0[3]); w.z = cvt_pk_bf16(v1[0], v1[1]); w.w = cvt_pk_bf16(v1[2], v1[3]);
                    *(u32x4*)(rowp + bj * HALF) = w; } }
    }
};
template <bool BASE_BF16, bool OUT_BF16> struct EpiResX {
    static constexpr bool PERM = true;
    const void* base; void* out; int ldc; float* ssp;
    __device__ __forceinline__ void operator()(Acc& acc, const Unit& u, int wr, int wc, int fr, int fq, PG8_LAS unsigned char*) const {
        const int col0 = u.pn * BM + wc * 32 + 8 * fq;
#pragma unroll
        for (int ai = 0; ai < 2; ++ai)
#pragma unroll
            for (int m = 0; m < 4; ++m) { const int r = ai * HALF + wr * 64 + m * 16 + fr; const size_t off = (size_t)(u.pm * BM + r) * ldc + col0;
                float q_ = 0.f;
                f32x4 bs[2][2];
#pragma unroll
                for (int bj = 0; bj < 2; ++bj) {
                    if constexpr (BASE_BF16) { const u32x4 w = *(const u32x4*)((const bf16_t*)base + off + bj * HALF);
                        bs[bj][0] = (f32x4){__builtin_bit_cast(float, w.x << 16), __builtin_bit_cast(float, w.x & 0xffff0000u), __builtin_bit_cast(float, w.y << 16), __builtin_bit_cast(float, w.y & 0xffff0000u)};
                        bs[bj][1] = (f32x4){__builtin_bit_cast(float, w.z << 16), __builtin_bit_cast(float, w.z & 0xffff0000u), __builtin_bit_cast(float, w.w << 16), __builtin_bit_cast(float, w.w & 0xffff0000u)}; }
                    else { bs[bj][0] = *(const f32x4*)((const float*)base + off + bj * HALF); bs[bj][1] = *(const f32x4*)((const float*)base + off + bj * HALF + 4); } }
#pragma unroll
                for (int bj = 0; bj < 2; ++bj) { const f32x4 v0 = bs[bj][0] + acc[ai][bj][m][0], v1 = bs[bj][1] + acc[ai][bj][m][1];
                    q_ += ((v0[0] * v0[0] + v0[1] * v0[1]) + (v0[2] * v0[2] + v0[3] * v0[3])) + ((v1[0] * v1[0] + v1[1] * v1[1]) + (v1[2] * v1[2] + v1[3] * v1[3]));
                    if constexpr (OUT_BF16) { u32x4 w; w.x = cvt_pk_bf16(v0[0], v0[1]); w.y = cvt_pk_bf16(v0[2], v0[3]); w.z = cvt_pk_bf16(v1[0], v1[1]); w.w = cvt_pk_bf16(v1[2], v1[3]);
                        *(u32x4*)((bf16_t*)out + off + bj * HALF) = w; }
                    else { *(f32x4*)((float*)out + off + bj * HALF) = v0; *(f32x4*)((float*)out + off + bj * HALF + 4) = v1; } }
                if (ssp) { q_ += __shfl_xor(q_, 16); q_ += __shfl_xor(q_, 32); if (fq == 0) ssp[(size_t)(u.pm * BM + r) * 32 + u.pn * 4 + wc] = q_; }
                asm volatile("" ::: "memory"); }
    }
};
struct EpiProj {
    static constexpr bool PERM = true;
    bf16_t* QKVH; bf16_t* U;
    __device__ __forceinline__ void operator()(Acc& acc, const Unit& u, int wr, int wc, int fr, int fq, PG8_LAS unsigned char*) const {
        const int row0 = u.pm * BM + wr * 64 + fr, b = (u.pm * BM) / SEQ, s0 = row0 - b * SEQ, cin = wc * 32 + 8 * fq;
#pragma unroll
        for (int ai = 0; ai < 2; ++ai)
#pragma unroll
            for (int m = 0; m < 4; ++m) {
#pragma unroll
                for (int bj = 0; bj < 2; ++bj) { const f32x4 v0 = acc[ai][bj][m][0], v1 = acc[ai][bj][m][1];
                    u32x4 w; w.x = cvt_pk_bf16(v0[0], v0[1]); w.y = cvt_pk_bf16(v0[2], v0[3]); w.z = cvt_pk_bf16(v1[0], v1[1]); w.w = cvt_pk_bf16(v1[2], v1[3]);
                    bf16_t* dst = (u.pn < 12) ? QKVH + ((size_t)(b * 24 + u.pn * 2 + bj) * SEQ + (s0 + ai * HALF + m * 16)) * 128 + cin
                                              : U + (size_t)(row0 + ai * HALF + m * 16) * 1024 + (u.pn - 12) * 256 + bj * HALF + cin;
                    *(u32x4*)dst = w; } }
    }
};
struct EpiResF32 {
    static constexpr bool PERM = false;
    const float* base; float* out; int ldc;
    __device__ __forceinline__ void operator()(Acc& acc, const Unit& u, int wr, int wc, int fr, int fq, PG8_LAS unsigned char*) const {
        const int col0 = u.pn * BM + wc * 32 + 4 * fq;
#pragma unroll
        for (int ai = 0; ai < 2; ++ai)
#pragma unroll
            for (int m = 0; m < 4; ++m) { const int r = ai * HALF + wr * 64 + m * 16 + fr; const size_t off = (size_t)(u.pm * BM + r) * ldc + col0;
                f32x4 bs[2][2];
#pragma unroll
                for (int bj = 0; bj < 2; ++bj)
#pragma unroll
                    for (int n = 0; n < 2; ++n) bs[bj][n] = *(const f32x4*)(base + off + bj * HALF + n * 16);
#pragma unroll
                for (int bj = 0; bj < 2; ++bj)
#pragma unroll
                    for (int n = 0; n < 2; ++n) *(f32x4*)(out + off + bj * HALF + n * 16) = bs[bj][n] + acc[ai][bj][m][n];
                asm volatile("" ::: "memory"); }
    }
};
struct EpiSwiGLU {
    static constexpr bool PERM = true;
    bf16_t* O; int ldc; int pm0; const float* ssp;
    __device__ __forceinline__ void operator()(Acc& acc, const Unit& u, int wr, int wc, int fr, int fq, PG8_LAS unsigned char* xl) const {
        const int row0 = u.pm * BM + wr * 64 + fr, col0 = u.pn * HALF + wc * 32 + 8 * fq;
        float rsv[8]; row_scales8(rsv, (const PG8_LAS float*)(xl + 8192), ssp, u.pm, pm0, wr * 64 + fr);
#pragma unroll
        for (int ai = 0; ai < 2; ++ai)
#pragma unroll
            for (int m = 0; m < 4; ++m) { bf16_t* rowp = O + (size_t)(row0 + ai * HALF + m * 16) * ldc + col0;
                float h[8];
#pragma unroll
                for (int n = 0; n < 2; ++n)
#pragma unroll
                    for (int e = 0; e < 4; ++e) { const float rs_ = rsv[ai * 4 + m]; const float gt = acc[ai][0][m][n][e] * rs_, up = acc[ai][1][m][n][e] * rs_;
                        const float sg = __builtin_amdgcn_rcpf(1.f + __builtin_amdgcn_exp2f(-1.4426950408889634f * gt));
                        h[n * 4 + e] = gt * sg * up; }
                u32x4 w; w.x = cvt_pk_bf16(h[0], h[1]); w.y = cvt_pk_bf16(h[2], h[3]); w.z = cvt_pk_bf16(h[4], h[5]); w.w = cvt_pk_bf16(h[6], h[7]);
                *(u32x4*)rowp = w; }
    }
};
struct EpiSoftmax {
    static constexpr bool PERM = true;
    bf16_t* O; long sOz; float sc2; int ldc; int pm0; const float* ssp;
    __device__ __forceinline__ void operator()(Acc& acc, const Unit& u, int wr, int wc, int fr, int fq, PG8_LAS unsigned char* xl) const {
        PG8_LAS float* MX = (PG8_LAS float*)xl;
        PG8_LAS float* SMv = (PG8_LAS float*)(xl + 4096);
        float rsv[8]; row_scales8(rsv, (const PG8_LAS float*)(xl + 8192), ssp, u.pm, pm0, wr * 64 + fr);
#pragma unroll
        for (int ai = 0; ai < 2; ++ai)
#pragma unroll
            for (int m = 0; m < 4; ++m) { float mx = -3.0e38f;
#pragma unroll
                for (int bj = 0; bj < 2; ++bj)
#pragma unroll
                    for (int n = 0; n < 2; ++n) { f32x4 s = acc[ai][bj][m][n] * (sc2 * rsv[ai * 4 + m]); acc[ai][bj][m][n] = s; mx = fmaxf(mx, fmaxf(fmaxf(s[0], s[1]), fmaxf(s[2], s[3]))); }
                mx = fmaxf(mx, __shfl_xor(mx, 16)); mx = fmaxf(mx, __shfl_xor(mx, 32));
                if (fq == 0) MX[(ai * HALF + wr * 64 + m * 16 + fr) * 4 + wc] = mx; }
        asm volatile("s_waitcnt lgkmcnt(0)" ::: "memory"); __builtin_amdgcn_s_barrier(); asm volatile("" ::: "memory");
#pragma unroll
        for (int ai = 0; ai < 2; ++ai)
#pragma unroll
            for (int m = 0; m < 4; ++m) { const int r = ai * HALF + wr * 64 + m * 16 + fr;
                const f32x4 q = *(const PG8_LAS f32x4*)(MX + r * 4); const float rm = fmaxf(fmaxf(q[0], q[1]), fmaxf(q[2], q[3]));
                float sm = 0.f;
#pragma unroll
                for (int bj = 0; bj < 2; ++bj)
#pragma unroll
                    for (int n = 0; n < 2; ++n) { f32x4 s = acc[ai][bj][m][n];
#pragma unroll
                        for (int e = 0; e < 4; ++e) { s[e] = __builtin_amdgcn_exp2f(s[e] - rm); sm += s[e]; }
                        acc[ai][bj][m][n] = s; }
                sm += __shfl_xor(sm, 16); sm += __shfl_xor(sm, 32);
                if (fq == 0) SMv[r * 4 + wc] = sm; }
        asm volatile("s_waitcnt lgkmcnt(0)" ::: "memory"); __builtin_amdgcn_s_barrier(); asm volatile("" ::: "memory");
        const int row0 = u.pm * BM + wr * 64 + fr, col0 = wc * 32 + 8 * fq;
        bf16_t* base = O + (size_t)u.z * sOz;
#pragma unroll
        for (int ai = 0; ai < 2; ++ai)
#pragma unroll
            for (int m = 0; m < 4; ++m) { const int r = ai * HALF + wr * 64 + m * 16 + fr;
                const f32x4 q = *(const PG8_LAS f32x4*)(SMv + r * 4); const float inv = 1.0f / ((q[0] + q[1]) + (q[2] + q[3]));
                bf16_t* rowp = base + (size_t)(row0 + ai * HALF + m * 16) * ldc + u.pn * BM + col0;
#pragma unroll
                for (int bj = 0; bj < 2; ++bj) { const f32x4 v0 = acc[ai][bj][m][0] * inv, v1 = acc[ai][bj][m][1] * inv;
                    u32x4 w; w.x = cvt_pk_bf16(v0[0], v0[1]); w.y = cvt_pk_bf16(v0[2], v0[3]); w.z = cvt_pk_bf16(v1[0], v1[1]); w.w = cvt_pk_bf16(v1[2], v1[3]);
                    *(u32x4*)(rowp + bj * HALF) = w; } }
    }
};

template <class Epi, class Sched, bool ALIGN_EPI>
__device__ __forceinline__ void gemm_phase(PG8_LAS unsigned char* lds, PG8_LAS unsigned char* xl, const Gemm g, const Sched& S, const Epi& E) {
    const int tid = threadIdx.x, wid = __builtin_amdgcn_readfirstlane(tid >> 6), lane = tid & 63, wr = wid >> 2, wc = wid & 3, fr = lane & 15, fq = lane >> 4;
    const int K = g.K, nt = K / BK;
    unsigned voffA[2], voffB[2];
#pragma unroll
    for (int i = 0; i < 2; ++i) { int R, C; stage_rc(tid * 16 + i * 8192, R, C); const int Rb = Epi::PERM ? ((R & ~31) + perm32(R & 31)) : R;
        voffA[i] = (unsigned)(R * g.lda + C) * 2u; voffB[i] = (unsigned)(Rb * g.ldb + C) * 2u; }
    const size_t kstep = (size_t)(BK * 2);
    const size_t hstepA = (size_t)HALF * g.lda * 2, hstepB = (size_t)HALF * g.ldb * 2;
    const unsigned ldsw = (unsigned)wid * 1024u;
    const int aoff = lds_byte(wr * 64 + fr, fq * 8), boff = lds_byte(wc * 32 + fr, fq * 8);
#define PG8_APTR(u_) ((const char*)g.A + 2 * ((size_t)((u_).z / g.ZH) * g.sAb + (size_t)((u_).z % g.ZH) * g.sAh) + (size_t)(u_).pm * 2 * hstepA)
#define PG8_BPTR(u_) ((const char*)g.Bt + 2 * ((size_t)((u_).z / g.ZH) * g.sBb + (size_t)((u_).z % g.ZH) * g.sBh) + (size_t)(u_).pn * 2 * hstepB)
#define PG8_SA(b, h) (((b) * 2 + (h)) * HTB)
#define PG8_SB(b, h) ((4 + (b) * 2 + (h)) * HTB)
#define PG8_STAGE(bufoff, gbase, voff) do { _Pragma("unroll") for (int _i = 0; _i < 2; ++_i) \
        __builtin_amdgcn_global_load_lds((const unsigned*)((const char*)(gbase) + (voff)[_i]), (PG8_LAS unsigned*)(lds + (bufoff) + ldsw + _i * 8192), 16, 0, 0); } while (0)
#define PG8_LDA(dst, b, h) do { _Pragma("unroll") for (int m = 0; m < 4; ++m) _Pragma("unroll") for (int k = 0; k < 2; ++k) dst[m][k] = *(const PG8_LAS bf16x8*)(lds + PG8_SA(b, h) + aoff + m * 2048 + k * 1024); } while (0)
#define PG8_LDB(dst, b, h) do { _Pragma("unroll") for (int n = 0; n < 2; ++n) _Pragma("unroll") for (int k = 0; k < 2; ++k) dst[n][k] = *(const PG8_LAS bf16x8*)(lds + PG8_SB(b, h) + boff + n * 2048 + k * 1024); } while (0)
#define PG8_MMA(ai, bj, At, Bt) do { __builtin_amdgcn_s_setprio(1); _Pragma("unroll") for (int m = 0; m < 4; ++m) _Pragma("unroll") for (int n = 0; n < 2; ++n) _Pragma("unroll") for (int k = 0; k < 2; ++k) \
        acc[ai][bj][m][n] = __builtin_amdgcn_mfma_f32_16x16x32_bf16(Bt[n][k], At[m][k], acc[ai][bj][m][n], 0, 0, 0); __builtin_amdgcn_s_setprio(0); } while (0)
#define PG8_WAIT_V(n) asm volatile("s_waitcnt vmcnt(" #n ")" ::: "memory")
#define PG8_WAIT_L(n) asm volatile("s_waitcnt lgkmcnt(" #n ")" ::: "memory")
#define PG8_BAR __builtin_amdgcn_s_barrier()
#define PG8_SCHED __builtin_amdgcn_sched_barrier(0)
    Unit cur, nxt; int ui = 0;
    if (!S.next(0, cur)) return;
    Acc acc;
#pragma unroll
    for (int a = 0; a < 2; ++a)
#pragma unroll
        for (int b = 0; b < 2; ++b)
#pragma unroll
            for (int m = 0; m < 4; ++m)
#pragma unroll
                for (int n = 0; n < 2; ++n) acc[a][b][m][n] = (f32x4){0.f, 0.f, 0.f, 0.f};
    bf16x8 At[4][2], B0[2][2], B1[2][2];
    const char* cA = PG8_APTR(cur); const char* cB = PG8_BPTR(cur);
    PG8_STAGE(PG8_SB(0, 0), cB, voffB); PG8_STAGE(PG8_SB(0, 1), cB + hstepB, voffB); PG8_STAGE(PG8_SA(0, 0), cA, voffA); PG8_STAGE(PG8_SA(0, 1), cA + hstepA, voffA);
    if (wr == 1) PG8_BAR;
    PG8_WAIT_V(2); PG8_BAR;
    PG8_STAGE(PG8_SB(1, 0), cB + kstep, voffB); PG8_STAGE(PG8_SA(1, 0), cA + kstep, voffA); PG8_STAGE(PG8_SB(1, 1), cB + hstepB + kstep, voffB);
    PG8_WAIT_V(6); PG8_BAR;
    for (;;) {
        const bool has_next = S.next(ui + 1, nxt);
        const char* nA = has_next ? PG8_APTR(nxt) : cA; const char* nB = has_next ? PG8_BPTR(nxt) : cB;
        for (int t = 0; t < nt; t += 2) {
            const bool last = (t == nt - 2);
            const char* a1 = cA + (size_t)(t + 1) * kstep;
            const char* a2 = last ? nA : cA + (size_t)(t + 2) * kstep; const char* b2 = last ? nB : cB + (size_t)(t + 2) * kstep;
            const char* a3 = a2 + kstep; const char* b3 = b2 + kstep;
            PG8_LDB(B0, 0, 0); PG8_LDB(B1, 0, 1); PG8_SCHED; PG8_LDA(At, 0, 0); PG8_STAGE(PG8_SA(1, 1), a1 + hstepA, voffA);
            PG8_WAIT_V(8); PG8_WAIT_L(0); PG8_BAR; PG8_MMA(0, 0, At, B0); PG8_MMA(0, 1, At, B1); PG8_BAR; PG8_SCHED;
            PG8_LDA(At, 0, 1); PG8_STAGE(PG8_SB(0, 0), b2, voffB); PG8_STAGE(PG8_SB(0, 1), b2 + hstepB, voffB); PG8_STAGE(PG8_SA(0, 0), a2, voffA);
            PG8_WAIT_V(8); PG8_WAIT_L(0); PG8_BAR; PG8_MMA(1, 0, At, B0); PG8_MMA(1, 1, At, B1); PG8_BAR; PG8_SCHED;
            PG8_LDB(B0, 1, 0); PG8_LDB(B1, 1, 1); PG8_SCHED; PG8_LDA(At, 1, 0); PG8_STAGE(PG8_SA(0, 1), a2 + hstepA, voffA);
            PG8_WAIT_V(8); PG8_WAIT_L(0); PG8_BAR; PG8_MMA(0, 0, At, B0); PG8_MMA(0, 1, At, B1); PG8_BAR; PG8_SCHED;
            PG8_LDA(At, 1, 1); PG8_STAGE(PG8_SB(1, 0), b3, voffB); PG8_STAGE(PG8_SB(1, 1), b3 + hstepB, voffB); PG8_STAGE(PG8_SA(1, 0), a3, voffA);
            PG8_WAIT_V(8); PG8_WAIT_L(0); PG8_BAR; PG8_MMA(1, 0, At, B0); PG8_MMA(1, 1, At, B1); PG8_BAR; PG8_SCHED;
        }
        if constexpr (ALIGN_EPI) { if (wr == 0) PG8_BAR; }
        E(acc, cur, wr, wc, fr, fq, xl);
        if (!has_next) break;
#pragma unroll
        for (int a = 0; a < 2; ++a)
#pragma unroll
            for (int b = 0; b < 2; ++b)
#pragma unroll
                for (int m = 0; m < 4; ++m)
#pragma unroll
                    for (int n = 0; n < 2; ++n) acc[a][b][m][n] = (f32x4){0.f, 0.f, 0.f, 0.f};
        cur = nxt; cA = nA; cB = nB; ++ui;
        if constexpr (ALIGN_EPI) { if (wr == 1) PG8_BAR; }
    }
    PG8_WAIT_V(0);
    if constexpr (!ALIGN_EPI) { if (wr == 0) PG8_BAR; }
    PG8_BAR;
#undef PG8_APTR
#undef PG8_BPTR
#undef PG8_SA
#undef PG8_SB
#undef PG8_STAGE
#undef PG8_LDA
#undef PG8_LDB
#undef PG8_MMA
#undef PG8_WAIT_V
#undef PG8_WAIT_L
#undef PG8_BAR
#undef PG8_SCHED
}
}

namespace att {
constexpr int D = 128;
constexpr int PIN = DIN;
constexpr int POUT = 2048;
constexpr float SCALE = 0.08838834764831845f;
constexpr float THR = 8.f;
constexpr int NW = 8, QBLK = 32, KVBLK = 64, QB = NW * QBLK;
constexpr int SHM_V = KVBLK * D * 2, SHM_K = KVBLK * D * 2;
constexpr int LDS_BYTES = 2 * SHM_V + 2 * SHM_K + NW * 64 * 4;
using bf16 = __hip_bfloat16;
typedef short bf16x8 __attribute__((ext_vector_type(8)));
typedef short s16x4 __attribute__((ext_vector_type(4)));
typedef float f32x16 __attribute__((ext_vector_type(16)));
typedef float f32x4 __attribute__((ext_vector_type(4)));
typedef unsigned u32x4 __attribute__((ext_vector_type(4)));

#define KSWZ(row, colB) ((row) * 256 + ((colB) ^ (((row) & 7) << 4)))
#define SBAR() __builtin_amdgcn_sched_barrier(0)
__device__ __forceinline__ int v_st(int k, int c) { const int kk = (k & ~0xC) | ((k & 4) << 1) | ((k & 8) >> 1); return ((kk >> 3) * 4 + (c >> 5)) * 512 + ((kk & 7) * 32 + (c & 31)) * 2; }
__device__ __forceinline__ int v_rd_base(int lane) { return ((lane & 3) << 3) | (((lane >> 2) & 3) << 6) | (((lane >> 4) & 1) << 5) | (((lane >> 5) & 1) << 8); }
constexpr int v_rd_off(int d0, int ks, int half) { return d0 * 512 + ks * 4096 + half * 2048; }
__device__ __forceinline__ int crow(int r, int hi) { return (r & 3) + 8 * (r >> 2) + 4 * hi; }
__device__ __forceinline__ unsigned cvtpk(float lo, float hi) { unsigned r; asm volatile("v_cvt_pk_bf16_f32 %0, %1, %2" : "=v"(r) : "v"(lo), "v"(hi)); return r; }
__device__ __forceinline__ bf16x8 load8(const bf16* p) { return *reinterpret_cast<const bf16x8*>(p); }
__device__ __forceinline__ void mask_tile(f32x16& p0, f32x16& p1, int dq, unsigned W) {
    const float NEG = -__builtin_inff();
#pragma unroll
    for (int r = 0; r < 16; ++r) {
        const int c = (r & 3) + 8 * (r >> 2);
        if ((unsigned)(dq - c) >= W) p0[r] = NEG;
        if ((unsigned)(dq - c - 32) >= W) p1[r] = NEG;
    }
}
__device__ __forceinline__ void partialSM(f32x16& p0, f32x16& p1, float& m_reg, float& mn, float& alpha) {
    float pmax = p0[0]; for (int r = 1; r < 16; ++r) pmax = fmaxf(pmax, p0[r]); for (int r = 0; r < 16; ++r) pmax = fmaxf(pmax, p1[r]);
    { auto rr = __builtin_amdgcn_permlane32_swap(__float_as_uint(pmax), __float_as_uint(pmax), false, false);
      pmax = fmaxf(__uint_as_float(rr[0]), __uint_as_float(rr[1])); }
    constexpr float C2 = 1.4426950408889634f * SCALE;
    if (__builtin_expect(__all((pmax - m_reg) * SCALE <= THR), 1)) { mn = m_reg; alpha = 1.f; }
    else { mn = fmaxf(m_reg, pmax); alpha = __builtin_amdgcn_exp2f((m_reg - mn) * C2); m_reg = mn; }
    const float mnL = -mn * C2;
    for (int r = 0; r < 16; ++r) p0[r] = fmaf(p0[r], C2, mnL); for (int r = 0; r < 16; ++r) p1[r] = fmaf(p1[r], C2, mnL);
    for (int r = 0; r < 16; ++r) p0[r] = __builtin_amdgcn_exp2f(p0[r]);
}
__device__ __forceinline__ void finishSM(f32x16& p0, f32x16& p1, float alpha, float& l_reg, bf16x8& pa0, bf16x8& pa1, bf16x8& pa2, bf16x8& pa3) {
    for (int r = 0; r < 16; ++r) p1[r] = __builtin_amdgcn_exp2f(p1[r]);
    float ps = 0; for (int r = 0; r < 16; ++r) ps += p0[r]; for (int r = 0; r < 16; ++r) ps += p1[r];
    { auto rr = __builtin_amdgcn_permlane32_swap(__float_as_uint(ps), __float_as_uint(ps), false, false);
      ps = __uint_as_float(rr[0]) + __uint_as_float(rr[1]); }
    l_reg = l_reg * alpha + ps;
#define PK4(P, B_, OUT) do { unsigned a0 = cvtpk(P[B_+0], P[B_+1]), a1 = cvtpk(P[B_+2], P[B_+3]);                          \
        unsigned b0 = cvtpk(P[B_+4], P[B_+5]), b1 = cvtpk(P[B_+6], P[B_+7]);                                             \
        auto r0 = __builtin_amdgcn_permlane32_swap(a0, b0, false, false); auto r1 = __builtin_amdgcn_permlane32_swap(a1, b1, false, false); \
        u32x4 w = {r0[0], r1[0], r0[1], r1[1]}; OUT = *reinterpret_cast<bf16x8*>(&w); } while (0)
    PK4(p0, 0, pa0); PK4(p0, 8, pa1); PK4(p1, 0, pa2); PK4(p1, 8, pa3);
#undef PK4
}
template <int KB>
__device__ __forceinline__ void qkt(f32x16& p0, f32x16& p1, const char* K_lds, int r32, int hi, const bf16x8* qr) {
    p0 = f32x16{}; p1 = f32x16{};
    const char* kb[4];
#pragma unroll
    for (int dd = 0; dd < 4; ++dd) kb[dd] = K_lds + KB * SHM_K + KSWZ(r32, (dd * 16 + hi * 8) * 2);
#pragma unroll
    for (int d0 = 0; d0 < 8; ++d0) { const char* a = kb[d0 & 3] + (d0 >> 2) * 128;
        bf16x8 b0 = *reinterpret_cast<const bf16x8*>(a);
        bf16x8 b1 = *reinterpret_cast<const bf16x8*>(a + 32 * 256);
        p0 = __builtin_amdgcn_mfma_f32_32x32x16_bf16(b0, qr[d0], p0, 0, 0, 0);
        p1 = __builtin_amdgcn_mfma_f32_32x32x16_bf16(b1, qr[d0], p1, 0, 0, 0); }
}
template <int VB>
__device__ __forceinline__ void pv_tile(f32x16* o, int vb0, bf16x8 pa0, bf16x8 pa1, bf16x8 pa2, bf16x8 pa3) {
#define TRRD(dst, off) asm volatile("ds_read_b64_tr_b16 %0, %1 offset:%2" : "=&v"(dst) : "v"(vb0), "i"(off) : "memory")
#define PV_D0(d0) do { s16x4 l0, l1, l2, l3, h0, h1, h2, h3; constexpr int b_ = VB * SHM_V + v_rd_off(d0, 0, 0); \
        TRRD(l0, b_); TRRD(h0, b_ + 2048); TRRD(l1, b_ + 4096); TRRD(h1, b_ + 6144); TRRD(l2, b_ + 8192); TRRD(h2, b_ + 10240); TRRD(l3, b_ + 12288); TRRD(h3, b_ + 14336); \
        asm volatile("s_waitcnt lgkmcnt(0)" ::: "memory"); SBAR();   \
        o[d0] = __builtin_amdgcn_mfma_f32_32x32x16_bf16(pa0, (bf16x8){l0[0], l0[1], l0[2], l0[3], h0[0], h0[1], h0[2], h0[3]}, o[d0], 0, 0, 0);   \
        o[d0] = __builtin_amdgcn_mfma_f32_32x32x16_bf16(pa1, (bf16x8){l1[0], l1[1], l1[2], l1[3], h1[0], h1[1], h1[2], h1[3]}, o[d0], 0, 0, 0);   \
        o[d0] = __builtin_amdgcn_mfma_f32_32x32x16_bf16(pa2, (bf16x8){l2[0], l2[1], l2[2], l2[3], h2[0], h2[1], h2[2], h2[3]}, o[d0], 0, 0, 0);   \
        o[d0] = __builtin_amdgcn_mfma_f32_32x32x16_bf16(pa3, (bf16x8){l3[0], l3[1], l3[2], l3[3], h3[0], h3[1], h3[2], h3[3]}, o[d0], 0, 0, 0); } while (0)
    PV_D0(0); PV_D0(1); PV_D0(2); PV_D0(3);
#undef PV_D0
#undef TRRD
}

struct BlockRef { const bf16* Q; const bf16* K; const bf16* V; bf16* O; int P0; };
struct Seam { bf16x8 qr[8]; bf16x8 st_v0, st_v1, st_k0, st_k1; };
#define ROW(p, k0, rr) ((p) + (size_t)((k0) + (rr)) * PIN + sc)
#define VMW() asm volatile("s_waitcnt vmcnt(0)" ::: "memory")
#define VMWN(n) asm volatile("s_waitcnt vmcnt(%0)" :: "i"(n) : "memory")
#define SLOAD_H(Kp, Vp, k0) do { S.st_v0 = load8(ROW(Vp, k0, sr)); S.st_v1 = load8(ROW(Vp, k0, 32 + sr));              \
                         S.st_k0 = load8(ROW(Kp, k0, sr)); S.st_k1 = load8(ROW(Kp, k0, 32 + sr)); } while (0)
#define SWRITE_HK(bf) do { *(bf16x8*)(K_lds + (bf) * SHM_K + kws) = S.st_k0; *(bf16x8*)(K_lds + (bf) * SHM_K + kws + 32 * 256) = S.st_k1; } while (0)
#define SWRITE_HV(bf) do { *(bf16x8*)(V_lds + (bf) * SHM_V + vst0) = S.st_v0; *(bf16x8*)(V_lds + (bf) * SHM_V + vst1) = S.st_v1; } while (0)
#define SWRITE_H(bf) do { SWRITE_HV(bf); SWRITE_HK(bf); } while (0)
__device__ __forceinline__ void causal_prime(const BlockRef& cur, char* lds, Seam& S) {
    const int tid = threadIdx.x, wid = __builtin_amdgcn_readfirstlane(tid >> 6), lane = tid & 63, r32 = lane & 31, hi = lane >> 5;
    const int sr = tid >> 4, sc = (tid & 15) * 8, kws = KSWZ(sr, sc * 2); char* K_lds = lds + 2 * SHM_V;
    const int kb0 = 0;
    for (int d0 = 0; d0 < 8; ++d0) S.qr[d0] = load8(cur.Q + (size_t)(wid * QBLK + r32) * PIN + d0 * 16 + hi * 8);
    SLOAD_H(cur.K, cur.V, kb0); VMW(); SWRITE_HK(0);
    __syncthreads();
}
__device__ __forceinline__ void causal_block(const BlockRef& cur, const BlockRef& nxt, int skv, char* lds, Seam& S) {
    const int W = 1 << 30;
    const int tid = threadIdx.x, wid = __builtin_amdgcn_readfirstlane(tid >> 6), lane = tid & 63, r32 = lane & 31, hi = lane >> 5;
    const int j_lo = 0;
    int j_hi = (cur.P0 + QB - 1) / KVBLK + 1; if (j_hi > skv / KVBLK) j_hi = skv / KVBLK;
    const int NT = j_hi - j_lo;
    const int kbn = 0;
    const int qlo = cur.P0 + wid * QBLK, qm = qlo + r32 - 4 * hi;
    char* V_lds = lds; char* K_lds = lds + 2 * SHM_V;
    float* ws = (float*)(lds + 2 * SHM_V + 2 * SHM_K) + wid * 64; float* li_l = ws, * al_l = ws + 32;
    float m_reg = -1e30f, l_reg = 0; f32x16 o[4] = {};
    const int sr = tid >> 4, sc = (tid & 15) * 8, vst0 = v_st(sr, sc), vst1 = v_st(32 + sr, sc), kws = KSWZ(sr, sc * 2);
    const int vb0 = (int)(uintptr_t)V_lds + v_rd_base(lane);
    const bf16* Kh = cur.K; const bf16* Vh = cur.V;
#define RESC(a) do { if (__any((a) < 1.f)) { if (hi == 0) al_l[r32] = (a); asm volatile("s_waitcnt lgkmcnt(0)" ::: "memory");              \
                     for (int d_ = 0; d_ < 4; ++d_) for (int r = 0; r < 16; ++r) o[d_][r] *= al_l[crow(r, hi)]; } } while (0)
#define KBASE(t) ((j_lo + (t)) * KVBLK)
#define MASKT(P0_, P1_, t) do { const int kb_ = KBASE(t); if (kb_ + KVBLK - 1 > qlo) mask_tile(P0_, P1_, qm - kb_, (unsigned)W); } while (0)
    constexpr int NQL = 8;
#define SEAM_K0() do { VMWN(NQL); SWRITE_HK(0); SBAR(); } while (0)
    f32x16 pA0, pA1, pB0, pB1; float mnA, mnB, alA, alB; bf16x8 pa0, pa1, pa2, pa3;
    SWRITE_HV(0); SBAR();
    if (NT > 1) { SLOAD_H(Kh, Vh, KBASE(1)); }
    SBAR(); qkt<0>(pA0, pA1, K_lds, r32, hi, S.qr);
    MASKT(pA0, pA1, 0); partialSM(pA0, pA1, m_reg, mnA, alA);
    if (NT > 1) { VMW(); SWRITE_H(1); }
    __syncthreads();
#define HALF_STEP(PX0, PX1, mnX, alX, PY0, PY1, alY, t, KB, VB, SB) do {                                                      \
        SBAR(); qkt<KB>(PX0, PX1, K_lds, r32, hi, S.qr);                                                                      \
        finishSM(PY0, PY1, alY, l_reg, pa0, pa1, pa2, pa3); SBAR();                                                           \
        if ((t) + 1 < NT) { SLOAD_H(Kh, Vh, KBASE((t) + 1)); SBAR(); }                                                        \
        pv_tile<VB>(o, vb0, pa0, pa1, pa2, pa3); MASKT(PX0, PX1, (t)); partialSM(PX0, PX1, m_reg, mnX, alX);                  \
        __syncthreads();                                                                                                      \
        if ((t) + 1 < NT) { VMW(); SWRITE_H(SB); }                                                                            \
        RESC(alX); __syncthreads(); } while (0)
    for (int t = 1; t + 1 < NT; t += 2) {
        HALF_STEP(pB0, pB1, mnB, alB, pA0, pA1, alA, t, 1, 0, 0);
        HALF_STEP(pA0, pA1, mnA, alA, pB0, pB1, alB, t + 1, 0, 1, 1);
    }
    const bool even = (NT & 1) == 0;
    if (even) { SBAR(); qkt<1>(pB0, pB1, K_lds, r32, hi, S.qr); SBAR(); }
    SLOAD_H(nxt.K, nxt.V, kbn); SBAR();
#pragma unroll
    for (int d0 = 0; d0 < 8; ++d0) S.qr[d0] = load8(nxt.Q + (size_t)(wid * QBLK + r32) * PIN + d0 * 16 + hi * 8);
    SBAR();
    finishSM(pA0, pA1, alA, l_reg, pa0, pa1, pa2, pa3); SBAR();
    pv_tile<0>(o, vb0, pa0, pa1, pa2, pa3);
    if (even) { MASKT(pB0, pB1, NT - 1); partialSM(pB0, pB1, m_reg, mnB, alB); __syncthreads(); RESC(alB);
        finishSM(pB0, pB1, alB, l_reg, pa0, pa1, pa2, pa3); SBAR(); pv_tile<1>(o, vb0, pa0, pa1, pa2, pa3); }
    SBAR(); SEAM_K0();
    if (hi == 0) li_l[r32] = l_reg; asm volatile("s_waitcnt lgkmcnt(0)" ::: "memory");
    float rli[16];
#pragma unroll
    for (int r = 0; r < 16; ++r) rli[r] = __builtin_amdgcn_rcpf(li_l[crow(r, hi)]);
    bf16* Ow = cur.O + (size_t)(wid * QBLK) * POUT;
#pragma unroll
    for (int r = 0; r < 16; ++r) { const int orow = crow(r, hi);
#pragma unroll
        for (int d0 = 0; d0 < 4; ++d0) { const float v = o[d0][r] * rli[r];
            const float vn = __shfl_xor(v, 1);
            if ((r32 & 1) == 0) *(unsigned*)(Ow + (size_t)orow * POUT + d0 * 32 + r32) = cvtpk(v, vn); } }
    __syncthreads();
#undef RESC
#undef KBASE
#undef MASKT
#undef SEAM_K0
#undef HALF_STEP
}
#undef ROW
#undef VMW
#undef VMWN
#undef SLOAD_H
#undef SWRITE_HK
#undef SWRITE_HV
#undef SWRITE_H
#undef KSWZ
#undef SBAR

__device__ __forceinline__ BlockRef make_ref(int L, int pass, const bf16* PROJ, bf16* O16) {
    const int xcd = L & 7, kk = L >> 3, p = xcd * 4 + (kk >> 5), x = kk & 31;
    const int qb = pass ? 63 - x : x;
    const int b = p >> 4, h = (p >> 2) & 3, m = (p >> 1) & 1, vh = p & 1;
    const size_t rb = (size_t)b * SEQ;
    BlockRef r;
    r.Q = PROJ + (rb + (size_t)qb * QB) * PIN + (h * 2 + m) * 128;
    r.K = PROJ + rb * PIN + 1024 + (h * 2 + m) * 128;
    r.V = PROJ + rb * PIN + 2048 + h * 256 + vh * 128;
    r.O = O16 + (rb + (size_t)qb * QB) * POUT + (p & 15) * 128;
    r.P0 = qb * QB;
    return r;
}
__device__ __forceinline__ void attn_phase(char* lds, const bf16* PROJ, bf16* O16, int G, int w) {
    constexpr int total = 1024;
    int L = w; if (L >= total) return;
    int pass = 0;
    BlockRef cur = make_ref(L, 0, PROJ, O16);
    Seam S;
    causal_prime(cur, lds, S);
    for (;;) {
        const bool more_pass = pass == 0, more_item = L + G < total, last = !more_pass && !more_item;
        int passn, Ln;
        if (more_pass) { passn = 1; Ln = L; } else { passn = 0; Ln = more_item ? L + G : L; }
        const BlockRef nxt = last ? cur : make_ref(Ln, passn, PROJ, O16);
        causal_block(cur, nxt, SEQ, lds, S);
        if (last) break;
        cur = nxt; pass = passn; L = Ln;
    }
}
}


namespace att2 {
using namespace att;
constexpr int QB2 = 128;
constexpr int PH = 128;
constexpr long HSTR = (long)SEQ * PH;
constexpr int L_V = 0, L_K = 4 * SHM_V, L_WSF = L_K + 2 * SHM_K, L_XM = L_WSF + 2048, L_XP = L_XM + 2048, L_XL = L_XP + 32768, L_END = L_XL + 1024;
#define KSWZ2(row, colB) ((row) * 256 + ((colB) ^ (((row) & 7) << 4)))
#define SBAR2() __builtin_amdgcn_sched_barrier(0)
struct BlockRef2 { const bf16* Q; const bf16* K; const bf16* V; bf16* O; int P0; };

__device__ __forceinline__ void block2(const BlockRef2& cur, char* lds, int wave) {
    const int lane = (int)__builtin_amdgcn_mbcnt_hi(~0u, __builtin_amdgcn_mbcnt_lo(~0u, 0u)), r32 = lane & 31, hi = lane >> 5, tid = wave * 64 + lane;
    const int rg = wave & 3, c = wave >> 2, pw = wave ^ 4;
    const int NT = (cur.P0 + QB2 - 1) / KVBLK + 1;
    const int qlo = cur.P0 + rg * QBLK, qm = qlo + r32 - 4 * hi;
    char* V_lds = lds + L_V; char* K_lds = lds + L_K;
    float* wsf = (float*)(lds + L_WSF) + wave * 64; float* li_l = wsf; float* al_l = wsf + 32;
    float* xm = (float*)(lds + L_XM);
    char* xp = lds + L_XP;
    float* xl = (float*)(lds + L_XL);
    const int sr = tid >> 4, sc = (tid & 15) * 8, vst0 = v_st(sr, sc), vst1 = v_st(32 + sr, sc), kws = KSWZ2(sr, sc * 2);
    const int vb0 = (int)(uintptr_t)V_lds + c * SHM_V + v_rd_base(lane);
    const bf16* Kh = cur.K; const bf16* Vh = cur.V;
    bf16x8 qr[8];
#pragma unroll
    for (int d0 = 0; d0 < 8; ++d0) qr[d0] = *reinterpret_cast<const bf16x8*>((const char*)(cur.Q + (size_t)(rg * QBLK) * PH) + (unsigned)(r32 * PH + hi * 8) * 2u + d0 * 32);
    bf16x8 sk0, sk1, sv00, sv01, sv10, sv11;
    unsigned voff = (unsigned)(sr * PH + sc) * 2u; asm volatile("" : "+v"(voff));
#define LD16(base_, byteoff_) (*reinterpret_cast<const bf16x8*>((const char*)(base_) + voff + (byteoff_)))
#define KLOAD(k0) do { const bf16* kb0_ = Kh + (size_t)(k0) * PH; const bf16* kb1_ = Kh + (size_t)((k0) + 32) * PH; sk0 = LD16(kb0_, 0); sk1 = LD16(kb1_, 0); } while (0)
#define VLOAD(k0) do { const bf16* vb0_ = Vh + (size_t)(k0) * PH; const bf16* vb1_ = Vh + (size_t)((k0) + 32) * PH; \
                       sv00 = LD16(vb0_, 0); sv01 = LD16(vb1_, 0); sv10 = LD16(vb0_ + HSTR, 0); sv11 = LD16(vb1_ + HSTR, 0); } while (0)
#define KWRITE(bf) do { *(bf16x8*)(K_lds + (bf) * SHM_K + kws) = sk0; *(bf16x8*)(K_lds + (bf) * SHM_K + kws + 32 * 256) = sk1; } while (0)
#define VWRITE(bf) do { *(bf16x8*)(V_lds + ((bf) * 2) * SHM_V + vst0) = sv00; *(bf16x8*)(V_lds + ((bf) * 2) * SHM_V + vst1) = sv01; \
                        *(bf16x8*)(V_lds + ((bf) * 2 + 1) * SHM_V + vst0) = sv10; *(bf16x8*)(V_lds + ((bf) * 2 + 1) * SHM_V + vst1) = sv11; } while (0)
    KLOAD(0); VLOAD(0); KWRITE(0); VWRITE(0);
    KLOAD(KVBLK); VLOAD(KVBLK); KWRITE(1); VWRITE(1);
    if (NT > 2) { KLOAD(2 * KVBLK); VLOAD(2 * KVBLK); }
    float m_reg = -1e30f, l_reg = 0.f; f32x16 o[4] = {};
    f32x16 pA, pB; float alA = 1.f, alB = 1.f; bf16x8 f0, f1;
    constexpr float C2 = 1.4426950408889634f * SCALE;
#define QKT2(P, KB) do { P = f32x16{}; const char* kq_ = K_lds + (KB) * SHM_K + c * (32 * 256); \
        _Pragma("unroll") for (int d0 = 0; d0 < 8; ++d0) { const bf16x8 b_ = *reinterpret_cast<const bf16x8*>(kq_ + KSWZ2(r32, (((d0) & 3) * 16 + hi * 8) * 2) + ((d0) >> 2) * 128); \
            P = __builtin_amdgcn_mfma_f32_32x32x16_bf16(b_, qr[d0], P, 0, 0, 0); } } while (0)
#define MASKMAX(P, t, par) do { const int kb_ = (t) * KVBLK + 32 * c; \
        if (kb_ + 31 > qlo) { const int dq_ = qm - kb_; const float NEG_ = -__builtin_inff(); \
            _Pragma("unroll") for (int r = 0; r < 16; ++r) { if (dq_ - ((r & 3) + 8 * (r >> 2)) < 0) P[r] = NEG_; } } \
        float pm_ = P[0]; _Pragma("unroll") for (int r = 1; r < 16; ++r) pm_ = fmaxf(pm_, P[r]); \
        { auto rr = __builtin_amdgcn_permlane32_swap(__float_as_uint(pm_), __float_as_uint(pm_), false, false); pm_ = fmaxf(__uint_as_float(rr[0]), __uint_as_float(rr[1])); } \
        pmx = pm_; if (hi == 0) xm[((par) * 8 + wave) * 32 + r32] = pm_; } while (0)
#define SOFTMAX(P, par, alX) do { const float pmax_ = fmaxf(pmx, xm[((par) * 8 + pw) * 32 + r32]); float mn_; \
        if (__builtin_expect(__all((pmax_ - m_reg) * SCALE <= THR), 1)) { mn_ = m_reg; alX = 1.f; } \
        else { mn_ = fmaxf(m_reg, pmax_); alX = __builtin_amdgcn_exp2f((m_reg - mn_) * C2); m_reg = mn_; } \
        const float mnL_ = -mn_ * C2; \
        _Pragma("unroll") for (int r = 0; r < 16; ++r) P[r] = __builtin_amdgcn_exp2f(fmaf(P[r], C2, mnL_)); } while (0)
#define PK4B(P, B_, OUT) do { unsigned a0 = cvtpk(P[B_+0], P[B_+1]), a1 = cvtpk(P[B_+2], P[B_+3]); unsigned b0 = cvtpk(P[B_+4], P[B_+5]), b1 = cvtpk(P[B_+6], P[B_+7]); \
        auto r0 = __builtin_amdgcn_permlane32_swap(a0, b0, false, false); auto r1 = __builtin_amdgcn_permlane32_swap(a1, b1, false, false); \
        u32x4 w = {r0[0], r1[0], r0[1], r1[1]}; OUT = *reinterpret_cast<bf16x8*>(&w); } while (0)
#define FINISH(P, alY, par) do { float ps_ = 0; _Pragma("unroll") for (int r = 0; r < 16; ++r) ps_ += P[r]; \
        { auto rr = __builtin_amdgcn_permlane32_swap(__float_as_uint(ps_), __float_as_uint(ps_), false, false); ps_ = __uint_as_float(rr[0]) + __uint_as_float(rr[1]); } \
        l_reg = l_reg * alY + ps_; PK4B(P, 0, f0); PK4B(P, 8, f1); \
        *(bf16x8*)(xp + (((par) * 8 + wave) * 2 + 0) * 1024 + lane * 16) = f0; *(bf16x8*)(xp + (((par) * 8 + wave) * 2 + 1) * 1024 + lane * 16) = f1; } while (0)
#define TRRD2(dst, off) asm volatile("ds_read_b64_tr_b16 %0, %1 offset:%2" : "=&v"(dst) : "v"(vb0), "i"(off) : "memory")
#define PV2_D0(VB, d0) do { s16x4 l0, l1, l2, l3, h0, h1, h2, h3; constexpr int b_ = (VB) * 2 * SHM_V + v_rd_off(d0, 0, 0); \
        TRRD2(l0, b_); TRRD2(h0, b_ + 2048); TRRD2(l1, b_ + 4096); TRRD2(h1, b_ + 6144); TRRD2(l2, b_ + 8192); TRRD2(h2, b_ + 10240); TRRD2(l3, b_ + 12288); TRRD2(h3, b_ + 14336); \
        asm volatile("s_waitcnt lgkmcnt(0)" ::: "memory"); SBAR2(); __builtin_amdgcn_s_setprio(1);  \
        o[d0] = __builtin_amdgcn_mfma_f32_32x32x16_bf16(pa0, (bf16x8){l0[0], l0[1], l0[2], l0[3], h0[0], h0[1], h0[2], h0[3]}, o[d0], 0, 0, 0);   \
        o[d0] = __builtin_amdgcn_mfma_f32_32x32x16_bf16(pa1, (bf16x8){l1[0], l1[1], l1[2], l1[3], h1[0], h1[1], h1[2], h1[3]}, o[d0], 0, 0, 0);   \
        o[d0] = __builtin_amdgcn_mfma_f32_32x32x16_bf16(pa2, (bf16x8){l2[0], l2[1], l2[2], l2[3], h2[0], h2[1], h2[2], h2[3]}, o[d0], 0, 0, 0);   \
        o[d0] = __builtin_amdgcn_mfma_f32_32x32x16_bf16(pa3, (bf16x8){l3[0], l3[1], l3[2], l3[3], h3[0], h3[1], h3[2], h3[3]}, o[d0], 0, 0, 0); __builtin_amdgcn_s_setprio(0); } while (0)
#define PVALL(VB, par) do { const bf16x8 g0_ = *(const bf16x8*)(xp + (((par) * 8 + pw) * 2 + 0) * 1024 + lane * 16), g1_ = *(const bf16x8*)(xp + (((par) * 8 + pw) * 2 + 1) * 1024 + lane * 16); \
        const bf16x8 pa0 = c ? g0_ : f0, pa1 = c ? g1_ : f1, pa2 = c ? f0 : g0_, pa3 = c ? f1 : g1_; \
        PV2_D0(VB, 0); PV2_D0(VB, 1); PV2_D0(VB, 2); PV2_D0(VB, 3); } while (0)
#define RESC2(a) do { if (__any((a) < 1.f)) { if (hi == 0) al_l[r32] = (a); asm volatile("s_waitcnt lgkmcnt(0)" ::: "memory");              \
                     for (int d_ = 0; d_ < 4; ++d_) for (int r = 0; r < 16; ++r) o[d_][r] *= al_l[crow(r, hi)]; } } while (0)
#define QKT2F(PX, KB, PY, alY, par) do { const char* kq_ = K_lds + (KB) * SHM_K + c * (32 * 256); bf16x8 kf_[8]; \
        _Pragma("unroll") for (int d0 = 0; d0 < 8; ++d0) kf_[d0] = *reinterpret_cast<const bf16x8*>(kq_ + KSWZ2(r32, (((d0) & 3) * 16 + hi * 8) * 2) + ((d0) >> 2) * 128); \
        PX = f32x16{}; float ps_ = 0.f; SBAR2(); __builtin_amdgcn_s_setprio(1); \
        PX = __builtin_amdgcn_mfma_f32_32x32x16_bf16(kf_[0], qr[0], PX, 0, 0, 0); SBAR2(); \
        _Pragma("unroll") for (int r = 0; r < 8; ++r) ps_ += PY[r]; SBAR2(); \
        PX = __builtin_amdgcn_mfma_f32_32x32x16_bf16(kf_[1], qr[1], PX, 0, 0, 0); SBAR2(); \
        _Pragma("unroll") for (int r = 8; r < 16; ++r) ps_ += PY[r]; \
        { auto rr = __builtin_amdgcn_permlane32_swap(__float_as_uint(ps_), __float_as_uint(ps_), false, false); ps_ = __uint_as_float(rr[0]) + __uint_as_float(rr[1]); } \
        l_reg = l_reg * alY + ps_; SBAR2(); \
        PX = __builtin_amdgcn_mfma_f32_32x32x16_bf16(kf_[2], qr[2], PX, 0, 0, 0); SBAR2(); \
        PK4B(PY, 0, f0); *(bf16x8*)(xp + (((par) * 8 + wave) * 2 + 0) * 1024 + lane * 16) = f0; SBAR2(); \
        PX = __builtin_amdgcn_mfma_f32_32x32x16_bf16(kf_[3], qr[3], PX, 0, 0, 0); SBAR2(); \
        PK4B(PY, 8, f1); *(bf16x8*)(xp + (((par) * 8 + wave) * 2 + 1) * 1024 + lane * 16) = f1; SBAR2(); \
        PX = __builtin_amdgcn_mfma_f32_32x32x16_bf16(kf_[4], qr[4], PX, 0, 0, 0); \
        PX = __builtin_amdgcn_mfma_f32_32x32x16_bf16(kf_[5], qr[5], PX, 0, 0, 0); \
        PX = __builtin_amdgcn_mfma_f32_32x32x16_bf16(kf_[6], qr[6], PX, 0, 0, 0); \
        PX = __builtin_amdgcn_mfma_f32_32x32x16_bf16(kf_[7], qr[7], PX, 0, 0, 0); __builtin_amdgcn_s_setprio(0); SBAR2(); } while (0)
#define SM_DECIDE(par, alX) do { const float pmax_ = fmaxf(pmx, xm[((par) * 8 + pw) * 32 + r32]); float mn_; \
        if (__builtin_expect(__all((pmax_ - m_reg) * SCALE <= THR), 1)) { mn_ = m_reg; alX = 1.f; } \
        else { mn_ = fmaxf(m_reg, pmax_); alX = __builtin_amdgcn_exp2f((m_reg - mn_) * C2); m_reg = mn_; } \
        mnL = -mn_ * C2; } while (0)
#define SM_EXP4(P, B_) do { _Pragma("unroll") for (int r = (B_); r < (B_) + 4; ++r) P[r] = __builtin_amdgcn_exp2f(fmaf(P[r], C2, mnL)); } while (0)
#define PVSM(VB, par, PX, parX, alX) do { const bf16x8 g0_ = *(const bf16x8*)(xp + (((par) * 8 + pw) * 2 + 0) * 1024 + lane * 16), g1_ = *(const bf16x8*)(xp + (((par) * 8 + pw) * 2 + 1) * 1024 + lane * 16); \
        SM_DECIDE(parX, alX); \
        const bf16x8 pa0 = c ? g0_ : f0, pa1 = c ? g1_ : f1, pa2 = c ? f0 : g0_, pa3 = c ? f1 : g1_; SBAR2(); \
        PV2_D0(VB, 0); SBAR2(); SM_EXP4(PX, 0); SBAR2(); PV2_D0(VB, 1); SBAR2(); SM_EXP4(PX, 4); SBAR2(); \
        PV2_D0(VB, 2); SBAR2(); SM_EXP4(PX, 8); SBAR2(); PV2_D0(VB, 3); SBAR2(); SM_EXP4(PX, 12); SBAR2(); } while (0)
    float pmx, mnL;
    __syncthreads();
    QKT2(pA, 0); MASKMAX(pA, 0, 0);
    __syncthreads();
    SOFTMAX(pA, 0, alA);
#define STEP2(PX, alX, PY, alY, t, KB, VB) do { \
        SBAR2(); QKT2F(PX, KB, PY, alY, VB); \
        MASKMAX(PX, t, KB); \
        __syncthreads(); \
        if ((t) + 1 < NT) { KWRITE(VB); if ((t) + 2 < NT) KLOAD(((t) + 2) * KVBLK); } \
        PVSM(VB, VB, PX, KB, alX); \
        __syncthreads(); \
        if ((t) + 1 < NT) { VWRITE(VB); if ((t) + 2 < NT) VLOAD(((t) + 2) * KVBLK); } \
        RESC2(alX); } while (0)
    for (int t = 1; t + 1 < NT; t += 2) {
        STEP2(pB, alB, pA, alA, t, 1, 0);
        STEP2(pA, alA, pB, alB, t + 1, 0, 1);
    }
    STEP2(pB, alB, pA, alA, NT - 1, 1, 0);
    FINISH(pB, alB, 1);
    if (hi == 0) xl[wave * 32 + r32] = l_reg;
    __syncthreads();
    PVALL(1, 1);
    l_reg += xl[pw * 32 + r32];
    if (hi == 0) li_l[r32] = l_reg; asm volatile("s_waitcnt lgkmcnt(0)" ::: "memory");
    float rli[16];
#pragma unroll
    for (int r = 0; r < 16; ++r) rli[r] = __builtin_amdgcn_rcpf(li_l[crow(r, hi)]);
    { char* stg = lds + (wave < 4 ? L_V + wave * 8192 : L_K + (wave - 4) * 8192);
      unsigned soff = (unsigned)(4 * hi * 256 + r32 * 2); asm volatile("" : "+v"(soff));
#pragma unroll
      for (int r = 0; r < 16; ++r) { const unsigned orow = (unsigned)((r & 3) + 8 * (r >> 2));
#pragma unroll
          for (int d0 = 0; d0 < 4; ++d0) *(bf16*)(stg + soff + orow * 256u + d0 * 64u) = __float2bfloat16(o[d0][r] * rli[r]); }
      asm volatile("s_waitcnt lgkmcnt(0)" ::: "memory");
      char* Ow = (char*)(cur.O + (size_t)(rg * QBLK) * POUT + c * 128);
      unsigned roff = (unsigned)((lane >> 4) * 256 + (lane & 15) * 16), goff = (unsigned)((lane >> 4) * (POUT * 2) + (lane & 15) * 16); asm volatile("" : "+v"(roff), "+v"(goff));
#pragma unroll
      for (int i = 0; i < 8; ++i) { const u32x4 v = *(const u32x4*)(stg + roff + i * 1024u); *(u32x4*)(Ow + goff + (unsigned)i * (4u * POUT * 2u)) = v; } }
    __syncthreads();
#undef LD16
#undef KLOAD
#undef VLOAD
#undef KWRITE
#undef VWRITE
#undef QKT2
#undef MASKMAX
#undef SOFTMAX
#undef PK4B
#undef FINISH
#undef TRRD2
#undef PV2_D0
#undef PVALL
#undef RESC2
#undef STEP2
#undef QKT2F
#undef SM_DECIDE
#undef SM_EXP4
#undef PVSM
}
__device__ __forceinline__ BlockRef2 make_ref2(int L, int pass, const bf16* PROJ, bf16* O16) {
    const int xcd = L & 7, kk = L >> 3, p = xcd * 2 + (kk & 1), x = kk >> 1;
    const int qb = pass ? 127 - x : x;
    const int b = p >> 3, h = (p >> 1) & 3, m = p & 1;
    const size_t rb = (size_t)b * SEQ;
    BlockRef2 r;
    const bf16* hb = PROJ + (size_t)b * 24 * HSTR;
    r.Q = hb + (size_t)(h * 2 + m) * HSTR + (size_t)qb * QB2 * PH;
    r.K = hb + (size_t)(8 + h * 2 + m) * HSTR;
    r.V = hb + (size_t)(16 + h * 2) * HSTR;
    r.O = O16 + (rb + (size_t)qb * QB2) * POUT + h * 512 + m * 256;
    r.P0 = qb * QB2;
    return r;
}
__device__ __forceinline__ void attn_phase2(char* lds, const bf16* PROJ, bf16* O16, int G, int w, int wave) {
    for (int L = w; L < 1024; L += G)
        for (int pass = 0; pass < 2; ++pass) { const BlockRef2 cur = make_ref2(L, pass, PROJ, O16); block2(cur, lds, wave); }
}
#undef KSWZ2
#undef SBAR2
}

constexpr size_t MiB = 1u << 20;
constexpr size_t WS_WIN = 1 * MiB;
constexpr size_t WS_WO = 17 * MiB;
constexpr size_t WS_WQX = 25 * MiB;
constexpr size_t WS_WKV = 33 * MiB;
constexpr size_t WS_WOX = 49 * MiB;
constexpr size_t WS_WGU = 57 * MiB;
constexpr size_t WS_WDN = 101 * MiB;
constexpr size_t WS_WPOOL = 123 * MiB;
constexpr size_t WS_MN = 124 * MiB;
constexpr size_t WS_KX = 126 * MiB;
constexpr size_t WS_VXT = 128 * MiB;
constexpr size_t WS_HN = 144 * MiB;
constexpr size_t WS_PROJ = 272 * MiB;
constexpr size_t WS_O16 = 528 * MiB;
constexpr size_t WS_POOLED = 656 * MiB;
constexpr size_t WS_CONCAT = 720 * MiB;
constexpr size_t WS_QX = 272 * MiB;
constexpr size_t WS_PSC = 400 * MiB;
constexpr size_t WS_OX = 528 * MiB;
constexpr size_t WS_HID = 272 * MiB;
constexpr size_t WS_XB = 848 * MiB;
constexpr size_t WS_WQK = 130 * MiB;
constexpr size_t WS_WINU = 138 * MiB;
constexpr size_t WS_SSP = 656 * MiB;
constexpr size_t WS_VWT = 976 * MiB;
constexpr size_t WS_END = 984 * MiB;

constexpr int LDS_BYTES = 147456;
constexpr int XL_OFF = 131072;
constexpr int NPHASE = 14;

typedef unsigned short bf16r;
typedef float f32x4 __attribute__((ext_vector_type(4)));
typedef unsigned v4u __attribute__((ext_vector_type(4)));
typedef unsigned v2u __attribute__((ext_vector_type(2)));
#define LAS __attribute__((address_space(3)))

__device__ __forceinline__ unsigned f2bf(float f) { unsigned u = __builtin_bit_cast(unsigned, f); return (u + 0x7fffu + ((u >> 16) & 1u)) >> 16; }
__device__ __forceinline__ unsigned pk2(float lo, float hi) { return f2bf(lo) | (f2bf(hi) << 16); }
__device__ __forceinline__ float bf2f(unsigned short b) { return __builtin_bit_cast(float, (unsigned)b << 16); }
__device__ __forceinline__ float wave_sum(float v) {
#pragma unroll
    for (int o = 1; o < 64; o <<= 1) v += __shfl_xor(v, o);
    return v;
}

__device__ __forceinline__ void transpose_item(const float* W, int N, bf16r* WT, int ldt, int k0, int n0, int drow0, LAS float* scr, int lane, const float* gn = nullptr, const float* gk = nullptr) {
    const float gg = gn ? gn[n0 + (lane & 31)] : 1.f;
#pragma unroll 8
    for (int i = 0; i < 32; ++i) { const int kk = 2 * i + (lane >> 5); const float g2 = gk ? gk[k0 + kk] : 1.f; scr[kk * 33 + (lane & 31)] = W[(size_t)(k0 + kk) * N + n0 + (lane & 31)] * (gg * g2); }
    asm volatile("s_waitcnt lgkmcnt(0)" ::: "memory");
    const int c = lane & 7;
#pragma unroll
    for (int j = 0; j < 4; ++j) { const int n = (lane >> 3) + 8 * j; const LAS float* s = scr + (8 * c) * 33 + n;
        v4u o; o.x = pk2(s[0 * 33], s[1 * 33]); o.y = pk2(s[2 * 33], s[3 * 33]); o.z = pk2(s[4 * 33], s[5 * 33]); o.w = pk2(s[6 * 33], s[7 * 33]);
        *(v4u*)(WT + (size_t)(drow0 + n) * ldt + k0 + 8 * c) = o; }
    asm volatile("s_waitcnt lgkmcnt(0)" ::: "memory");
}
__device__ __forceinline__ void rms_row_bf16(const float* xrow, const float* g, bf16r* orow, int lane) {
    const f32x4* xr = (const f32x4*)xrow + lane; const f32x4* gr = (const f32x4*)g + lane;
    f32x4 v[8]; float s = 0.f;
#pragma unroll
    for (int j = 0; j < 8; ++j) { v[j] = xr[64 * j]; s += (v[j].x * v[j].x + v[j].y * v[j].y) + (v[j].z * v[j].z + v[j].w * v[j].w); }
    const float rstd = rsqrtf(wave_sum(s) * (1.f / DM) + EPS);
    v2u* o8 = (v2u*)orow + lane;
#pragma unroll
    for (int j = 0; j < 8; ++j) { const f32x4 gg = gr[64 * j]; v2u w; w.x = pk2(v[j].x * rstd * gg.x, v[j].y * rstd * gg.y); w.y = pk2(v[j].z * rstd * gg.z, v[j].w * rstd * gg.w); o8[64 * j] = w; }
}
__device__ __forceinline__ void rms_rowb_bf16(const bf16r* xrow, const float* g, bf16r* orow, int lane) {
    const v4u* xr = (const v4u*)xrow + lane; const f32x4* gr = (const f32x4*)g + 2 * lane;
    float v[4][8]; float s = 0.f;
#pragma unroll
    for (int j = 0; j < 4; ++j) { const v4u w = xr[64 * j];
#pragma unroll
        for (int e = 0; e < 4; ++e) { v[j][2 * e] = __builtin_bit_cast(float, w[e] << 16); v[j][2 * e + 1] = __builtin_bit_cast(float, w[e] & 0xffff0000u); }
#pragma unroll
        for (int e = 0; e < 8; ++e) s += v[j][e] * v[j][e]; }
    const float rstd = rsqrtf(wave_sum(s) * (1.f / DM) + EPS);
    v4u* o8 = (v4u*)orow + lane;
#pragma unroll
    for (int j = 0; j < 4; ++j) { const f32x4 g0 = gr[128 * j], g1 = gr[128 * j + 1]; v4u w;
        w.x = pk2(v[j][0] * rstd * g0.x, v[j][1] * rstd * g0.y); w.y = pk2(v[j][2] * rstd * g0.z, v[j][3] * rstd * g0.w);
        w.z = pk2(v[j][4] * rstd * g1.x, v[j][5] * rstd * g1.y); w.w = pk2(v[j][6] * rstd * g1.z, v[j][7] * rstd * g1.w); o8[64 * j] = w; }
}
__device__ __forceinline__ void rms_rowb_f32(const bf16r* xrow, const float* g, float* orow, int lane) {
    const v4u* xr = (const v4u*)xrow + lane; const f32x4* gr = (const f32x4*)g + 2 * lane;
    float v[4][8]; float s = 0.f;
#pragma unroll
    for (int j = 0; j < 4; ++j) { const v4u w = xr[64 * j];
#pragma unroll
        for (int e = 0; e < 4; ++e) { v[j][2 * e] = __builtin_bit_cast(float, w[e] << 16); v[j][2 * e + 1] = __builtin_bit_cast(float, w[e] & 0xffff0000u); }
#pragma unroll
        for (int e = 0; e < 8; ++e) s += v[j][e] * v[j][e]; }
    const float rstd = rsqrtf(wave_sum(s) * (1.f / DM) + EPS);
    f32x4* o4 = (f32x4*)orow + 2 * lane;
#pragma unroll
    for (int j = 0; j < 4; ++j) { const f32x4 g0 = gr[128 * j], g1 = gr[128 * j + 1];
        o4[128 * j] = (f32x4){v[j][0] * rstd * g0.x, v[j][1] * rstd * g0.y, v[j][2] * rstd * g0.z, v[j][3] * rstd * g0.w};
        o4[128 * j + 1] = (f32x4){v[j][4] * rstd * g1.x, v[j][5] * rstd * g1.y, v[j][6] * rstd * g1.z, v[j][7] * rstd * g1.w}; }
}
template <int R> __device__ __forceinline__ void rms_rows_f32_to_bf16(const float* __restrict__ X, const float* __restrict__ g, bf16r* __restrict__ O, int m0, int lane) {
    f32x4 v[R][8]; float ss[R];
#pragma unroll
    for (int r = 0; r < R; ++r) { const f32x4* xr = (const f32x4*)(X + (size_t)(m0 + r) * DM) + lane;
#pragma unroll
        for (int j = 0; j < 8; ++j) v[r][j] = xr[64 * j]; }
#pragma unroll
    for (int r = 0; r < R; ++r) { float s = 0.f;
#pragma unroll
        for (int j = 0; j < 8; ++j) s += (v[r][j].x * v[r][j].x + v[r][j].y * v[r][j].y) + (v[r][j].z * v[r][j].z + v[r][j].w * v[r][j].w);
        ss[r] = s; }
#pragma unroll
    for (int o = 1; o < 64; o <<= 1) {
#pragma unroll
        for (int r = 0; r < R; ++r) ss[r] += __shfl_xor(ss[r], o); }
    const f32x4* gr = (const f32x4*)g + lane;
#pragma unroll
    for (int j = 0; j < 8; ++j) { const f32x4 gg = gr[64 * j];
#pragma unroll
        for (int r = 0; r < R; ++r) { const float rstd = rsqrtf(ss[r] * (1.f / DM) + EPS); v2u w;
            w.x = pk2(v[r][j].x * rstd * gg.x, v[r][j].y * rstd * gg.y); w.y = pk2(v[r][j].z * rstd * gg.z, v[r][j].w * rstd * gg.w);
            ((v2u*)(O + (size_t)(m0 + r) * DM) + lane)[64 * j] = w; } }
}
template <int R, bool OUT_F32> __device__ __forceinline__ void rms_rows_bf16(const bf16r* __restrict__ X, const float* __restrict__ g, void* __restrict__ O, int m0, int lane) {
    v4u w[R][4]; float ss[R];
#pragma unroll
    for (int r = 0; r < R; ++r) { const v4u* xr = (const v4u*)(X + (size_t)(m0 + r) * DM) + lane;
#pragma unroll
        for (int j = 0; j < 4; ++j) w[r][j] = xr[64 * j]; }
#pragma unroll
    for (int r = 0; r < R; ++r) { float s = 0.f;
#pragma unroll
        for (int j = 0; j < 4; ++j)
#pragma unroll
            for (int e = 0; e < 4; ++e) { const float a = __builtin_bit_cast(float, w[r][j][e] << 16), b = __builtin_bit_cast(float, w[r][j][e] & 0xffff0000u); s += a * a + b * b; }
        ss[r] = s; }
#pragma unroll
    for (int o = 1; o < 64; o <<= 1) {
#pragma unroll
        for (int r = 0; r < R; ++r) ss[r] += __shfl_xor(ss[r], o); }
    const f32x4* gr = (const f32x4*)g + 2 * lane;
#pragma unroll
    for (int j = 0; j < 4; ++j) { const f32x4 g0 = gr[128 * j], g1 = gr[128 * j + 1];
#pragma unroll
        for (int r = 0; r < R; ++r) { const float rstd = rsqrtf(ss[r] * (1.f / DM) + EPS); float v[8];
#pragma unroll
            for (int e = 0; e < 4; ++e) { v[2 * e] = __builtin_bit_cast(float, w[r][j][e] << 16) * rstd; v[2 * e + 1] = __builtin_bit_cast(float, w[r][j][e] & 0xffff0000u) * rstd; }
            if constexpr (OUT_F32) { f32x4* o4 = (f32x4*)((float*)O + (size_t)(m0 + r) * DM) + 2 * lane;
                o4[128 * j] = (f32x4){v[0] * g0.x, v[1] * g0.y, v[2] * g0.z, v[3] * g0.w}; o4[128 * j + 1] = (f32x4){v[4] * g1.x, v[5] * g1.y, v[6] * g1.z, v[7] * g1.w}; }
            else { v4u q; q.x = pk2(v[0] * g0.x, v[1] * g0.y); q.y = pk2(v[2] * g0.z, v[3] * g0.w); q.z = pk2(v[4] * g1.x, v[5] * g1.y); q.w = pk2(v[6] * g1.z, v[7] * g1.w);
                ((v4u*)((bf16r*)O + (size_t)(m0 + r) * DM) + lane)[64 * j] = q; } } }
}
__device__ __forceinline__ void rms_row_f32_inplace(float* xrow, const float* g, int lane) {
    f32x4* xr = (f32x4*)xrow + lane; const f32x4* gr = (const f32x4*)g + lane;
    f32x4 v[8]; float s = 0.f;
#pragma unroll
    for (int j = 0; j < 8; ++j) { v[j] = xr[64 * j]; s += (v[j].x * v[j].x + v[j].y * v[j].y) + (v[j].z * v[j].z + v[j].w * v[j].w); }
    const float rstd = rsqrtf(wave_sum(s) * (1.f / DM) + EPS);
#pragma unroll
    for (int j = 0; j < 8; ++j) { const f32x4 gg = gr[64 * j]; xr[64 * j] = (f32x4){v[j].x * rstd * gg.x, v[j].y * rstd * gg.y, v[j].z * rstd * gg.z, v[j].w * rstd * gg.w}; }
}

__device__ __forceinline__ void load_row_scales(LAS unsigned char* xl, const float* ssp, int pm0, int nM, int t) {
    LAS float* T = (LAS float*)(xl + 8192);
    for (int i = t; i < 1024; i += 512) { const int pm = pm0 + 8 * (i >> 8); float sum = 0.f;
        if (pm < nM) { const f32x4* q = (const f32x4*)(ssp + (size_t)(pm * 256 + (i & 255)) * 32);
#pragma unroll
            for (int j = 0; j < 8; ++j) { const f32x4 v = q[j]; sum += (v.x + v.y) + (v.z + v.w); } }
        T[i] = rsqrtf(sum * (1.f / DM) + EPS); }
    __syncthreads();
}
struct Args { const float* in[22]; float* out; unsigned char* ws; int ph_lo, ph_hi; };
typedef const __attribute__((address_space(4))) unsigned long long* karg_t;
__device__ __forceinline__ unsigned long long ldarg(int i) { karg_t p = (karg_t)__builtin_amdgcn_kernarg_segment_ptr(); asm volatile("" : "+s"(p) :: "memory"); return p[i]; }
#define GASP __attribute__((address_space(1)))
#define AIN(i) ((const float*)(GASP const float*)ldarg(i))
#define AOUT() ((float*)(GASP float*)ldarg(22))
#define AWS() ((unsigned char*)(GASP unsigned char*)ldarg(23))
#define WSP(off) ((bf16r*)(AWS() + (off)))

__global__ void __launch_bounds__(512) fwd_kernel(Args a) {
    extern __shared__ __attribute__((aligned(16))) unsigned char lds[];
    LAS unsigned char* ldsl = (LAS unsigned char*)lds;
    const int wave = __builtin_amdgcn_readfirstlane((int)threadIdx.x >> 6);
#define lane ((int)__builtin_amdgcn_mbcnt_hi(~0u, __builtin_amdgcn_mbcnt_lo(~0u, 0u)))
#define tid (wave * 64 + lane)
    const int G = gridDim.x, bx = blockIdx.x;
    const int gw = bx * 8 + wave, NGW = G * 8;
    const int lo = a.ph_lo, hi = a.ph_hi; int nbar = 0;
#define IN(k) (lo <= (k) && (k) < hi)
#define CBAR() do { asm volatile("s_waitcnt vmcnt(0)" ::: "memory"); ++nbar; __syncthreads(); \
            if (tid == 0) { unsigned* ctr = (unsigned*)AWS(); \
                __builtin_amdgcn_fence(__ATOMIC_RELEASE, "agent"); asm volatile("s_waitcnt vmcnt(0)" ::: "memory"); \
                __hip_atomic_fetch_add(ctr, 1u, __ATOMIC_RELAXED, __HIP_MEMORY_SCOPE_AGENT); \
                const unsigned target = (unsigned)nbar * (unsigned)G; \
                while (__hip_atomic_load(ctr, __ATOMIC_RELAXED, __HIP_MEMORY_SCOPE_AGENT) < target) __builtin_amdgcn_s_sleep(2); \
                __builtin_amdgcn_fence(__ATOMIC_ACQUIRE, "agent"); asm volatile("s_waitcnt vmcnt(0)" ::: "memory"); } \
            __syncthreads(); } while (0)
#define SEAM(k) do { if (IN(k) && IN((k) + 1)) { if ((k) == 0) { asm volatile("s_waitcnt vmcnt(0)" ::: "memory"); cg::this_grid().sync(); } else { CBAR(); } } } while (0)

    if (lo == 0 && hi > 1 && bx == 0 && tid == 0) __hip_atomic_store((unsigned*)AWS(), 0u, __ATOMIC_RELAXED, __HIP_MEMORY_SCOPE_AGENT);
    if (IN(0)) {
        unsigned char* const ws_ = AWS(); bf16r* const WIN = (bf16r*)(ws_ + WS_WIN); bf16r* const WO = (bf16r*)(ws_ + WS_WO); bf16r* const WQX = (bf16r*)(ws_ + WS_WQX); bf16r* const WKV = (bf16r*)(ws_ + WS_WKV); bf16r* const WOX = (bf16r*)(ws_ + WS_WOX); bf16r* const WGU = (bf16r*)(ws_ + WS_WGU); bf16r* const WDN = (bf16r*)(ws_ + WS_WDN); bf16r* const WPOOL = (bf16r*)(ws_ + WS_WPOOL); bf16r* const MN = (bf16r*)(ws_ + WS_MN); bf16r* const HN = (bf16r*)(ws_ + WS_HN);

        LAS float* scr = (LAS float*)(ldsl + wave * 16384);
        constexpr int I_IN = 32 * 128, I_SQ = 32 * 64, I_KV = 32 * 128, I_G = 32 * 176, I_DN = 88 * 64, I_P = 4 * 4 * 8;
        constexpr int NITEMS = I_IN + 3 * I_SQ + I_KV + 2 * I_G + I_DN + I_P;
        for (int it = gw; it < NITEMS; it += NGW) {
            int r = it;
            if (r < I_IN) { const int kb = r / 128, nb = r % 128; if (nb < 96) transpose_item(AIN(3), DIN, WIN, DM, 64 * kb, 32 * nb, 32 * nb, scr, lane); continue; } r -= I_IN;
            if (r < I_SQ) { const int kb = r / 64, nb = r % 64; transpose_item(AIN(11), DM, WO, DM, 64 * kb, 32 * nb, 32 * nb, scr, lane); continue; } r -= I_SQ;
            if (r < I_SQ) { continue; } r -= I_SQ;
            if (r < I_KV) { const int kb = r / 128, nb = r % 128; transpose_item(AIN(15), 2 * DM, WKV, DM, 64 * kb, 32 * nb, 32 * nb, scr, lane); continue; } r -= I_KV;
            if (r < I_SQ) { const int kb = r / 64, nb = r % 64; transpose_item(AIN(16), DM, WOX, DM, 64 * kb, 32 * nb, 32 * nb, scr, lane); continue; } r -= I_SQ;
            if (r < I_G) { const int kb = r / 176, nb = r % 176, n0 = 32 * nb; transpose_item(AIN(18), DFF, WGU, DM, 64 * kb, n0, 256 * (n0 >> 7) + (n0 & 127), scr, lane, nullptr, AIN(17)); continue; } r -= I_G;
            if (r < I_G) { const int kb = r / 176, nb = r % 176, n0 = 32 * nb; transpose_item(AIN(19), DFF, WGU, DM, 64 * kb, n0, 256 * (n0 >> 7) + 128 + (n0 & 127), scr, lane, nullptr, AIN(17)); continue; } r -= I_G;
            if (r < I_DN) { const int kb = r / 64, nb = r % 64; transpose_item(AIN(20), DM, WDN, DFF, 64 * kb, 32 * nb, 32 * nb, scr, lane); continue; } r -= I_DN;
            { const int gidx = r / 32, q = r % 32, kb = q / 8, nb = q % 8; transpose_item(AIN(9) + (size_t)gidx * 65536, 256, WPOOL + (size_t)gidx * 65536, 256, 64 * kb, 32 * nb, 32 * nb, scr, lane, AIN(10) + gidx * 256); }
        }
        { const float* win = AIN(3); bf16r* winu = (bf16r*)(ws_ + WS_WINU);
          for (int i = bx * 512 + tid; i < DM * 1024 / 8; i += G * 512) { const int k = i >> 7, j8 = (i & 127) * 8; const f32x4* sp = (const f32x4*)(win + (size_t)k * DIN + 3072 + j8);
              const f32x4 a0 = sp[0], a1 = sp[1]; v4u w; w.x = pk2(a0.x, a0.y); w.y = pk2(a0.z, a0.w); w.z = pk2(a1.x, a1.y); w.w = pk2(a1.z, a1.w); *(v4u*)(winu + (size_t)k * 1024 + j8) = w; } }
        { const f32x4* src = (const f32x4*)AIN(14); v4u* dst = (v4u*)WQX;
          const float* gxa = AIN(12);
          for (int i = bx * 512 + tid; i < DM * DM / 8; i += G * 512) { const float gk_ = gxa[i >> 8]; const f32x4 a0 = src[2 * i] * gk_, a1 = src[2 * i + 1] * gk_; v4u w; w.x = pk2(a0.x, a0.y); w.y = pk2(a0.z, a0.w); w.z = pk2(a1.x, a1.y); w.w = pk2(a1.z, a1.w); dst[i] = w; } }
        { const float* xin = AIN(0); const float* gin = AIN(2); for (int m = gw * 4; m < M; m += NGW * 4) rms_rows_f32_to_bf16<4>(xin, gin, HN, m, lane); }
        for (int m = gw; m < BATCH * MEM; m += NGW) rms_row_bf16(AIN(1) + (size_t)m * DM, AIN(13), MN + (size_t)m * DM, lane);
        __syncthreads();
    }
    SEAM(0);
    if (IN(1)) {
        unsigned char* const ws_ = AWS(); bf16r* const HN = (bf16r*)(ws_ + WS_HN); bf16r* const WIN = (bf16r*)(ws_ + WS_WIN); bf16r* const PROJ = (bf16r*)(ws_ + WS_PROJ);

        {
            pg8::Gemm gf{(bf16r*)(ws_ + WS_WPOOL), (bf16r*)(ws_ + WS_WINU), 256, 1024, 256, 1, 65536, 0, 256, 0}; pg8::BatchOrder Sf; Sf.init(256, DM, 4, G, bx);
            pg8::EpiBf16 Ef{WIN + (size_t)3072 * DM, DM, 1, (long)256 * DM, 0, nullptr, 0};
            pg8::gemm_phase<pg8::EpiBf16, pg8::BatchOrder, true>(ldsl, ldsl + XL_OFF, gf, Sf, Ef);
            CBAR();
        }
        pg8::Gemm g{HN, WIN, DM, DM, DM, 1, 0, 0, 0, 0}; pg8::StaticOrder S; S.init(M, DIN, G, bx);
        pg8::EpiProj E{PROJ, PROJ + (size_t)192 * 1024 * 1024 / 2};
        pg8::gemm_phase<pg8::EpiProj, pg8::StaticOrder, true>(ldsl, ldsl + XL_OFF, g, S, E);
    }
    SEAM(1);
    if (IN(1) && IN(2)) { for (int ps_ = 0; ps_ < PROBE_SEAMS; ++ps_) CBAR(); }
    if (IN(2)) {
        unsigned char* const ws_ = AWS(); bf16r* const PROJ = (bf16r*)(ws_ + WS_PROJ); bf16r* const POOLED = (bf16r*)(ws_ + WS_POOLED); bf16r* const O16 = (bf16r*)(ws_ + WS_O16);

        {
            constexpr int RUN = 32;
            const int ntask = (M / RUN) * 128;
            for (int task = bx * 512 + tid; task < ntask; task += G * 512) {
                const int c8 = task & 127, token0 = (task >> 7) * RUN, t0 = token0 & (SEQ - 1);
                const int wl = 2 << (c8 >> 5);
                const bf16r* up = PROJ + (size_t)192 * 1024 * 1024 / 2 + (size_t)token0 * 1024 + c8 * 8;
                bf16r* op = (bf16r*)(ws_ + WS_CONCAT) + (size_t)token0 * DM + 1024 + c8 * 8;
                float sacc[8];
#pragma unroll
                for (int e = 0; e < 8; ++e) sacc[e] = 0.f;
                for (int j = 1; j < wl; ++j) if (t0 - j >= 0) { const v4u w = *(const v4u*)(up - (size_t)j * 1024);
#pragma unroll
                    for (int e = 0; e < 4; ++e) { sacc[2 * e] += __builtin_bit_cast(float, w[e] << 16); sacc[2 * e + 1] += __builtin_bit_cast(float, w[e] & 0xffff0000u); } }
#pragma unroll 4
                for (int i = 0; i < RUN; ++i) {
                    const v4u w = *(const v4u*)(up + (size_t)i * 1024);
                    const int t = t0 + i; const bool full = (t + 1 >= wl);
                    const v4u wo = *(const v4u*)(up + (size_t)(full ? i - (wl - 1) : i) * 1024);
                    float u0[8];
#pragma unroll
                    for (int e = 0; e < 4; ++e) { u0[2 * e] = __builtin_bit_cast(float, w[e] << 16); u0[2 * e + 1] = __builtin_bit_cast(float, w[e] & 0xffff0000u); }
#pragma unroll
                    for (int e = 0; e < 8; ++e) sacc[e] += u0[e];
                    const float ic = 1.0f / (float)(full ? wl : t + 1);
                    v4u o;
#pragma unroll
                    for (int e = 0; e < 4; ++e) o[e] = pk2(sacc[2 * e] * ic - u0[2 * e], sacc[2 * e + 1] * ic - u0[2 * e + 1]);
                    *(v4u*)(op + (size_t)i * DM) = o;
                    if (full) {
#pragma unroll
                        for (int e = 0; e < 4; ++e) { sacc[2 * e] -= __builtin_bit_cast(float, wo[e] << 16); sacc[2 * e + 1] -= __builtin_bit_cast(float, wo[e] & 0xffff0000u); } }
                }
            }
        }
        __syncthreads();
        att2::attn_phase2((char*)lds, (const att::bf16*)PROJ, (att::bf16*)O16, G, bx, wave);
        __syncthreads();
    }
    SEAM(2);
    if (IN(3)) {
        unsigned char* const ws_ = AWS(); bf16r* const O16 = (bf16r*)(ws_ + WS_O16); bf16r* const CONCAT = (bf16r*)(ws_ + WS_CONCAT); bf16r* const POOLED = (bf16r*)(ws_ + WS_POOLED); bf16r* const WPOOL = (bf16r*)(ws_ + WS_WPOOL); bf16r* const MN = (bf16r*)(ws_ + WS_MN); bf16r* const WKV = (bf16r*)(ws_ + WS_WKV); bf16r* const KX = (bf16r*)(ws_ + WS_KX); bf16r* const VXT = (bf16r*)(ws_ + WS_VXT);

        {
            const float* lq1 = AIN(4); const float* lk1 = AIN(5); const float* lq2 = AIN(6); const float* lk2 = AIN(7); const float* subln = AIN(8);
            const float s1 = wave_sum(lq1[lane] * lk1[lane] + lq1[lane + 64] * lk1[lane + 64]);
            const float s2 = wave_sum(lq2[lane] * lk2[lane] + lq2[lane + 64] * lk2[lane + 64]);
            const float lam = __expf(s1) - __expf(s2) + LAM_INIT;
            const f32x4 sg = *((const f32x4*)subln + lane);
            for (int m = gw; m < M; m += NGW) {
                const bf16r* orow = O16 + (size_t)m * 2048; bf16r* crow_ = CONCAT + (size_t)m * 2048;
#pragma unroll
                for (int h = 0; h < 4; ++h) {
                    const v2u w1 = *(const v2u*)(orow + h * 512 + 4 * lane), w2 = *(const v2u*)(orow + h * 512 + 256 + 4 * lane);
                    float d[4];
                    d[0] = __builtin_bit_cast(float, w1.x << 16) - lam * __builtin_bit_cast(float, w2.x << 16);
                    d[1] = __builtin_bit_cast(float, w1.x & 0xffff0000u) - lam * __builtin_bit_cast(float, w2.x & 0xffff0000u);
                    d[2] = __builtin_bit_cast(float, w1.y << 16) - lam * __builtin_bit_cast(float, w2.y << 16);
                    d[3] = __builtin_bit_cast(float, w1.y & 0xffff0000u) - lam * __builtin_bit_cast(float, w2.y & 0xffff0000u);
                    const float ss = wave_sum((d[0] * d[0] + d[1] * d[1]) + (d[2] * d[2] + d[3] * d[3]));
                    const float rstd = rsqrtf(ss * (1.f / 256.f) + EPS) * (1.0f - LAM_INIT);
                    v2u o; o.x = pk2(d[0] * rstd * sg.x, d[1] * rstd * sg.y); o.y = pk2(d[2] * rstd * sg.z, d[3] * rstd * sg.w);
                    *(v2u*)(crow_ + h * 256 + 4 * lane) = o;
                }
            }
        }
        __syncthreads();
        {
            pg8::Gemm g{MN, WKV, DM, DM, DM, 1, 0, 0, 0, 0}; pg8::StaticOrder S; S.init(BATCH * MEM, 2 * DM, G, bx);
            pg8::EpiBf16 E{KX, 2 * DM, 1, 0, 0, nullptr, 0};
            pg8::gemm_phase<pg8::EpiBf16, pg8::StaticOrder, true>(ldsl, ldsl + XL_OFF, g, S, E);
        }
    }
    SEAM(3);
    if (IN(4)) {
        unsigned char* const ws_ = AWS(); bf16r* const CONCAT = (bf16r*)(ws_ + WS_CONCAT); bf16r* const WO = (bf16r*)(ws_ + WS_WO); float* const xres = AOUT();

        pg8::Gemm g{CONCAT, WO, DM, DM, DM, 1, 0, 0, 0, 0}; pg8::StaticOrder S; S.init(M, DM, G, bx);
        pg8::EpiResX<false, true> E{AIN(0), ws_ + WS_XB, DM, (float*)(ws_ + WS_SSP)};
        pg8::gemm_phase<pg8::EpiResX<false, true>, pg8::StaticOrder, true>(ldsl, ldsl + XL_OFF, g, S, E);
    }
    SEAM(4);
    if (IN(5)) {
        unsigned char* const ws_ = AWS(); bf16r* const HN = (bf16r*)(ws_ + WS_HN); float* const xres = AOUT();
        bf16r* const KV = (bf16r*)(ws_ + WS_KX); bf16r* const WQN = (bf16r*)(ws_ + WS_WQX); bf16r* const WOXt = (bf16r*)(ws_ + WS_WOX);
        __syncthreads();
        {   pg8::Gemm g{KV, WQN, 2 * DM, DM, 512, 4, (long)MEM * 2 * DM, 512, 0, 512}; pg8::BatchOrder S; S.init(MEM, DM, 8, G, bx);
            pg8::EpiBf16 E{(bf16r*)(ws_ + WS_WQK), DM, 4, (long)1024 * DM, (long)MEM * DM, nullptr, 0};
            pg8::gemm_phase<pg8::EpiBf16, pg8::BatchOrder, true>(ldsl, ldsl + XL_OFF, g, S, E); }
        {   pg8::Gemm g{WOXt, KV + 2048, DM, 2 * DM, 512, 4, 0, 512, (long)MEM * 2 * DM, 512}; pg8::BatchOrder S; S.init(DM, MEM, 8, G, G - 1 - bx);
            pg8::EpiBf16 E{(bf16r*)(ws_ + WS_VWT), 1024, 4, (long)DM * 1024, MEM, nullptr, 0};
            pg8::gemm_phase<pg8::EpiBf16, pg8::BatchOrder, true>(ldsl, ldsl + XL_OFF, g, S, E); }
    }
    SEAM(5);
    if (IN(6)) {
        unsigned char* const ws_ = AWS(); bf16r* const HN = (bf16r*)(ws_ + WS_HN); bf16r* const PSC = (bf16r*)(ws_ + WS_PSC);
        pg8::Gemm g{(const bf16r*)(ws_ + WS_XB), (bf16r*)(ws_ + WS_WQK), DM, DM, DM, 1, 0, 0, (long)1024 * DM, 0}; pg8::StaticOrderZ S; S.init(M, 1024, G, bx); S.zdiv = SEQ / 256;
        pg8::Unit u0; const int pm0 = S.next(0, u0) ? u0.pm : 0;
        load_row_scales(ldsl + XL_OFF, (const float*)(ws_ + WS_SSP), pm0, M / 256, tid);
        pg8::EpiSoftmax E{PSC, 0, 0.044194173824159216f * 1.4426950408889634f, 1024, pm0, (const float*)(ws_ + WS_SSP)};
        pg8::gemm_phase<pg8::EpiSoftmax, pg8::StaticOrderZ, true>(ldsl, ldsl + XL_OFF, g, S, E);
    }
    SEAM(6);
    if (IN(9)) {
        unsigned char* const ws_ = AWS(); bf16r* const PSC = (bf16r*)(ws_ + WS_PSC);
        pg8::Gemm g{PSC, (bf16r*)(ws_ + WS_VWT), 1024, 1024, 1024, 1, 0, 0, (long)DM * 1024, 0}; pg8::StaticOrderZ S; S.init(M, DM, G, bx); S.zdiv = SEQ / 256;
        pg8::EpiResX<true, true> E{ws_ + WS_XB, ws_ + WS_XB, DM, (float*)(ws_ + WS_SSP) + (size_t)M * 32};
        pg8::gemm_phase<pg8::EpiResX<true, true>, pg8::StaticOrderZ, true>(ldsl, ldsl + XL_OFF, g, S, E);
    }
    SEAM(9);
    if (IN(11)) {
        unsigned char* const ws_ = AWS(); bf16r* const HN = (bf16r*)(ws_ + WS_HN); bf16r* const WGU = (bf16r*)(ws_ + WS_WGU); bf16r* const HID = (bf16r*)(ws_ + WS_HID);

        pg8::Gemm g{(const bf16r*)(ws_ + WS_XB), WGU, DM, DM, DM, 1, 0, 0, 0, 0}; pg8::StaticOrder S; S.init(M, 2 * DFF, G, bx);
        pg8::Unit u0; const int pm0 = S.next(0, u0) ? u0.pm : 0;
        load_row_scales(ldsl + XL_OFF, (const float*)(ws_ + WS_SSP) + (size_t)M * 32, pm0, M / 256, tid);
        pg8::EpiSwiGLU E{HID, DFF, pm0, (const float*)(ws_ + WS_SSP) + (size_t)M * 32};
        pg8::gemm_phase<pg8::EpiSwiGLU, pg8::StaticOrder, true>(ldsl, ldsl + XL_OFF, g, S, E);
    }
    SEAM(11);
    if (IN(12)) {
        unsigned char* const ws_ = AWS(); bf16r* const HID = (bf16r*)(ws_ + WS_HID); bf16r* const WDN = (bf16r*)(ws_ + WS_WDN); float* const xres = AOUT();

        pg8::Gemm g{HID, WDN, DFF, DFF, DFF, 1, 0, 0, 0, 0}; pg8::StaticOrder S; S.init(M, DM, G, bx);
        pg8::EpiResX<true, true> E{ws_ + WS_XB, ws_ + WS_XB, DM, nullptr};
        pg8::gemm_phase<pg8::EpiResX<true, true>, pg8::StaticOrder, true>(ldsl, ldsl + XL_OFF, g, S, E);
    }
    SEAM(12);
    if (IN(13)) {
        unsigned char* const ws_ = AWS(); float* const xres = AOUT();
 { const float* gin = AIN(21); for (int m = gw * 4; m < M; m += NGW * 4) rms_rows_bf16<4, true>((const bf16r*)(ws_ + WS_XB), gin, xres, m, lane); } }
#undef IN
#undef SEAM
#undef lane
#undef tid
}

extern "C" void kernel_launch(void* const* d_in, const int* in_sizes, int n_in, void* d_out, int out_size, void* d_ws, size_t ws_size, hipStream_t stream) {
    static int grid = 0;
    if (grid == 0) {
        if (n_in != 22 || in_sizes[0] != M * DM || out_size != M * DM || ws_size < WS_END) {
            fprintf(stderr, "kernel_launch: unexpected shapes n_in %d in0 %d out %d ws %zu (need %zu)\n", n_in, n_in > 0 ? in_sizes[0] : -1, out_size, ws_size, (size_t)WS_END); grid = -1; return; }
        int dev = 0, cus = 0, per_cu = 0;
        (void)hipGetDevice(&dev); (void)hipDeviceGetAttribute(&cus, hipDeviceAttributeMultiprocessorCount, dev);
        if (hipFuncSetAttribute((const void*)fwd_kernel, hipFuncAttributeMaxDynamicSharedMemorySize, LDS_BYTES) != hipSuccess) { fprintf(stderr, "kernel_launch: hipFuncSetAttribute failed\n"); grid = -1; return; }
        if (hipOccupancyMaxActiveBlocksPerMultiprocessor(&per_cu, (const void*)fwd_kernel, 512, LDS_BYTES) != hipSuccess || per_cu < 1) { fprintf(stderr, "kernel_launch: occupancy query gave %d\n", per_cu); per_cu = 1; }
        (void)hipGetLastError();
        if (cus <= 0) cus = 256;
        grid = cus * per_cu;
        if (grid > 256) grid = 256;
    }
    if (grid < 0) return;
    Args a{};
    for (int i = 0; i < 22; ++i) a.in[i] = (const float*)d_in[i];
    a.out = (float*)d_out; a.ws = (unsigned char*)d_ws;
#if MK_PER_PHASE
    for (int p = 0; p < NPHASE; ++p) { a.ph_lo = p; a.ph_hi = p + 1; hipLaunchKernelGGL(fwd_kernel, dim3(grid), dim3(512), LDS_BYTES, stream, a); }
#else
    const int cuts[4] = {0, PROBE_DUP >= 0 ? PROBE_DUP + 1 : NPHASE, PROBE_DUP >= 0 ? PROBE_DUP + 1 : NPHASE, NPHASE};
    for (int li = 0; li < (PROBE_DUP >= 0 ? 3 : 1); ++li) {
        a.ph_lo = cuts[li]; a.ph_hi = cuts[li + 1];
        if (PROBE_DUP >= 0 && li == 1) { a.ph_lo = PROBE_DUP; a.ph_hi = PROBE_DUP + 1; }
        if (!(a.ph_lo == 0 && a.ph_hi > 1)) (void)hipMemsetAsync(d_ws, 0, 256, stream);
        void* args[] = {&a};
        hipError_t e = hipLaunchCooperativeKernel((const void*)fwd_kernel, dim3(grid), dim3(512), args, LDS_BYTES, stream);
        if (e != hipSuccess) fprintf(stderr, "cooperative launch failed: %s (grid %d)\n", hipGetErrorString(e), grid);
    }
#endif
}
```
